# Optimizing an MI355X kernel written in HIP

```python
import jax
import jax.numpy as jnp
from jax import lax
import numpy as np

D_MODEL = 1024
BATCH = 16
SEQ = 2048
DEPTH = 1

MIX_WIDTH = D_MODEL
ATTN_WIDTH = MIX_WIDTH // 2
ATTN_HEAD_DIM = 64
ATTN_HEADS = ATTN_WIDTH // ATTN_HEAD_DIM
DILATED_PATTERNS = ((128, 1), (512, 4), (2048, 16))
MLSTM_WIDTH = MIX_WIDTH - ATTN_WIDTH
MLSTM_HEADS = 4
MLSTM_HEAD_DIM = MLSTM_WIDTH // MLSTM_HEADS
MLSTM_CONV = 4
MLSTM_CHUNK = 128
PEER_HEADS = 8
PEER_N_KEYS = 128
PEER_N_EXPERTS = PEER_N_KEYS * PEER_N_KEYS
PEER_KEY_DIM = 256
PEER_TOPK = 16
PEER_TOKEN_BLOCK = 128
DEEPNORM_ALPHA = (2.0 * DEPTH) ** 0.25
DEEPNORM_BETA = (8.0 * DEPTH) ** -0.25
LN_EPS = 1e-5
IN_SIZES = (ATTN_WIDTH, ATTN_WIDTH, ATTN_WIDTH, MLSTM_WIDTH, MLSTM_WIDTH, MLSTM_WIDTH, 2 * MLSTM_HEADS)
IN_COLS = sum(IN_SIZES)
SPLIT_POINTS = tuple(int(s) for s in np.cumsum(IN_SIZES)[:-1])

kernel_name = "hymba_dilated_mlstm_peer_deepnorm"


def _layer_norm(x, g, b):
    xf = x.astype(jnp.float32)
    mu = jnp.mean(xf, axis=-1, keepdims=True)
    var = jnp.mean(jnp.square(xf - mu), axis=-1, keepdims=True)
    y = (xf - mu) * lax.rsqrt(var + LN_EPS)
    return (y * g.astype(jnp.float32) + b.astype(jnp.float32)).astype(x.dtype)


def _dilated_branch(q, k, v, window, dilation):
    B, S, H, E = q.shape
    steps = window // dilation
    L = S // dilation
    n_blk = -(-L // steps)
    pad = n_blk * steps - L

    def to_sub(t):
        return t.reshape(B, L, dilation, H, E).transpose(0, 2, 3, 1, 4)

    qb = jnp.pad(to_sub(q), ((0, 0), (0, 0), (0, 0), (0, pad), (0, 0))).reshape(B, dilation, H, n_blk, steps, E)
    kp = jnp.pad(to_sub(k), ((0, 0), (0, 0), (0, 0), (steps, pad), (0, 0))).reshape(B, dilation, H, n_blk + 1, steps, E)
    vp = jnp.pad(to_sub(v), ((0, 0), (0, 0), (0, 0), (steps, pad), (0, 0))).reshape(B, dilation, H, n_blk + 1, steps, E)
    kb = jnp.concatenate([kp[:, :, :, :-1], kp[:, :, :, 1:]], axis=4)
    vb = jnp.concatenate([vp[:, :, :, :-1], vp[:, :, :, 1:]], axis=4)
    s = jnp.einsum('bghnqe,bghnke->bghnqk', qb, kb) * (E ** -0.5)
    qpos = jnp.arange(n_blk)[:, None] * steps + jnp.arange(steps)[None, :]
    kpos = jnp.arange(n_blk)[:, None] * steps - steps + jnp.arange(2 * steps)[None, :]
    dist = qpos[:, :, None] - kpos[:, None, :]
    mask = (dist >= 0) & (dist <= steps) & (kpos[:, None, :] >= 0)
    s = jnp.where(mask, s, -jnp.inf)
    m = jnp.max(s, axis=-1)
    p = jnp.exp(s - m[..., None])
    l = jnp.sum(p, axis=-1)
    acc = jnp.einsum('bghnqk,bghnke->bghnqe', p, vb)

    def from_sub(t):
        rest = t.shape[5:]
        t = t.reshape((B, dilation, H, n_blk * steps) + rest)[:, :, :, :L]
        perm = (0, 3, 1, 2) + tuple(range(4, 4 + len(rest)))
        return t.transpose(perm).reshape((B, S, H) + rest)

    return from_sub(acc), from_sub(m), from_sub(l)


def _dilated_attention(q, k, v):
    branches = [_dilated_branch(q, k, v, w, d) for (w, d) in DILATED_PATTERNS]
    m_all = jnp.max(jnp.stack([b[1] for b in branches]), axis=0)
    num = 0.0
    den = 0.0
    for acc, m, l in branches:
        e = jnp.exp(m - m_all)
        num = num + acc * e[..., None]
        den = den + l * e
    return num / den[..., None]


def _mlstm_chunkwise(q, k, v, i_pre, logf):
    B, S, H, E = q.shape
    NC = S // MLSTM_CHUNK
    CH = MLSTM_CHUNK

    def chunks(t):
        return t.reshape(B, NC, CH, H, E).transpose(1, 0, 3, 2, 4)

    def gchunks(t):
        return t.reshape(B, NC, CH, H).transpose(1, 0, 3, 2)

    bcum = jnp.cumsum(gchunks(logf), axis=-1)
    tril = jnp.tril(jnp.ones((CH, CH), dtype=bool))

    def step(carry, xs):
        C, n, m = carry
        qc, kc, vc, ic, bc = xs
        dlog = jnp.where(tril, bc[..., :, None] - bc[..., None, :] + ic[..., None, :], -jnp.inf)
        m_inter = bc + m[..., None]
        m_t = jnp.maximum(m_inter, jnp.max(dlog, axis=-1))
        w_inter = jnp.exp(m_inter - m_t)
        P = jnp.exp(dlog - m_t[..., None]) * jnp.einsum('bhte,bhse->bhts', qc, kc)
        num = w_inter[..., None] * jnp.einsum('bhvk,bhtk->bhtv', C, qc) + jnp.einsum('bhts,bhsv->bhtv', P, vc)
        den = w_inter * jnp.einsum('bhtk,bhk->bht', qc, n) + jnp.sum(P, axis=-1)
        h = num / jnp.maximum(jnp.abs(den), jnp.exp(-m_t))[..., None]
        bL = bc[..., -1]
        g = bL[..., None] - bc + ic
        m_new = jnp.maximum(bL + m, jnp.max(g, axis=-1))
        a = jnp.exp(bL + m - m_new)
        wk = jnp.exp(g - m_new[..., None])
        C_new = a[..., None, None] * C + jnp.einsum('bhs,bhsv,bhsk->bhvk', wk, vc, kc)
        n_new = a[..., None] * n + jnp.einsum('bhs,bhsk->bhk', wk, kc)
        return (C_new, n_new, m_new), h

    init = (jnp.zeros((B, H, E, E), jnp.float32), jnp.zeros((B, H, E), jnp.float32), jnp.zeros((B, H), jnp.float32))
    _, hs = lax.scan(step, init, (chunks(q), chunks(k), chunks(v), gchunks(i_pre), bcum))
    return hs.transpose(1, 0, 3, 2, 4).reshape(B, S, H, E)


def _mlstm_mixer(x_m, v_m, o_m, gates, conv_w, conv_b, w_mq, w_mk, b_igate, b_fgate, mh_norm_g):
    B, S, _ = x_m.shape
    H, E = MLSTM_HEADS, MLSTM_HEAD_DIM
    xc = lax.conv_general_dilated(x_m, conv_w[:, None, :], window_strides=(1,), padding=((MLSTM_CONV - 1, 0),),
                                  dimension_numbers=('NWC', 'WIO', 'NWC'), feature_group_count=MLSTM_WIDTH) + conv_b
    xc = jax.nn.silu(xc).reshape(B, S, H, E)
    q = jnp.einsum('bshe,hef->bshf', xc, w_mq).astype(jnp.float32) * (E ** -0.5)
    k = jnp.einsum('bshe,hef->bshf', xc, w_mk).astype(jnp.float32)
    v = v_m.reshape(B, S, H, E).astype(jnp.float32)
    g = gates.astype(jnp.float32)
    i_pre = g[..., :H] + b_igate.astype(jnp.float32)
    logf = jax.nn.log_sigmoid(g[..., H:] + b_fgate.astype(jnp.float32))
    ht = _mlstm_chunkwise(q, k, v, i_pre, logf)
    mu = jnp.mean(ht, axis=-1, keepdims=True)
    var = jnp.mean(jnp.square(ht - mu), axis=-1, keepdims=True)
    hn = ((ht - mu) * lax.rsqrt(var + LN_EPS)).reshape(B, S, MLSTM_WIDTH) * mh_norm_g.astype(jnp.float32)
    out = jax.nn.sigmoid(o_m.astype(jnp.float32)) * hn
    return out.astype(x_m.dtype)


def _token_mixing(h, w_in, conv_w, conv_b, w_mq, w_mk, b_igate, b_fgate, mh_norm_g, w_out):
    B, S, _ = h.shape
    proj = h @ w_in
    q_a, k_a, v_a, x_m, v_m, o_m, gates = jnp.split(proj, SPLIT_POINTS, axis=-1)
    shp = (B, S, ATTN_HEADS, ATTN_HEAD_DIM)
    attn = _dilated_attention(q_a.reshape(shp).astype(jnp.float32), k_a.reshape(shp).astype(jnp.float32),
                              v_a.reshape(shp).astype(jnp.float32))
    attn = attn.reshape(B, S, ATTN_WIDTH).astype(h.dtype)
    mlstm = _mlstm_mixer(x_m, v_m, o_m, gates, conv_w, conv_b, w_mq, w_mk, b_igate, b_fgate, mh_norm_g)
    return jnp.concatenate([attn, mlstm], axis=-1) @ w_out


def _peer(h, w_query, sub_keys, w_down, w_up):
    B, S, D = h.shape
    T = B * S
    xt = h.reshape(T, D)
    qry = (xt @ w_query).reshape(T, PEER_HEADS, 2, PEER_KEY_DIM // 2).astype(jnp.float32)
    sc = jnp.einsum('thpc,hpkc->thpk', qry, sub_keys.astype(jnp.float32))
    v1, i1 = lax.top_k(sc[:, :, 0], PEER_TOPK)
    v2, i2 = lax.top_k(sc[:, :, 1], PEER_TOPK)
    cand = (v1[..., :, None] + v2[..., None, :]).reshape(T, PEER_HEADS, PEER_TOPK * PEER_TOPK)
    cidx = (i1[..., :, None] * PEER_N_KEYS + i2[..., None, :]).reshape(T, PEER_HEADS, PEER_TOPK * PEER_TOPK)
    best, pos = lax.top_k(cand, PEER_TOPK)
    eidx = jnp.take_along_axis(cidx, pos, axis=-1).reshape(T, PEER_HEADS * PEER_TOPK)
    gate = jax.nn.softmax(best, axis=-1).reshape(T, PEER_HEADS * PEER_TOPK)
    NB = T // PEER_TOKEN_BLOCK

    def expert_block(args):
        xb, ib, gb = args
        u = w_down[ib]
        a = jnp.einsum('tkd,td->tk', u, xb).astype(jnp.float32)
        a = jax.nn.gelu(a, approximate=False) * gb
        vsel = w_up[ib]
        return jnp.einsum('tk,tkd->td', a.astype(vsel.dtype), vsel)

    out = lax.map(expert_block, (xt.reshape(NB, PEER_TOKEN_BLOCK, D),
                                 eidx.reshape(NB, PEER_TOKEN_BLOCK, -1),
                                 gate.reshape(NB, PEER_TOKEN_BLOCK, -1)))
    return out.reshape(B, S, D).astype(h.dtype)


def setup_inputs(seed: int = 0) -> dict:
    key = jax.random.key(seed)
    ks = jax.random.split(key, 24)
    D = D_MODEL
    H, E = MLSTM_HEADS, MLSTM_HEAD_DIM
    nrm = jax.random.normal
    std = D ** -0.5
    x = nrm(ks[0], (BATCH, SEQ, D), jnp.float32)
    w_qk = nrm(ks[1], (DEPTH, D, 2 * ATTN_WIDTH)) * std
    w_va = nrm(ks[2], (DEPTH, D, ATTN_WIDTH)) * std * DEEPNORM_BETA
    w_xm = nrm(ks[3], (DEPTH, D, MLSTM_WIDTH)) * std
    w_vm = nrm(ks[4], (DEPTH, D, MLSTM_WIDTH)) * std * DEEPNORM_BETA
    w_om = nrm(ks[5], (DEPTH, D, MLSTM_WIDTH)) * std
    w_gt = nrm(ks[6], (DEPTH, D, 2 * H)) * std * 0.1
    w_in = jnp.concatenate([w_qk, w_va, w_xm, w_vm, w_om, w_gt], axis=-1)
    conv_w = nrm(ks[7], (DEPTH, MLSTM_CONV, MLSTM_WIDTH)) * (MLSTM_CONV ** -0.5)
    conv_b = nrm(ks[8], (DEPTH, MLSTM_WIDTH)) * 0.02
    w_mq = nrm(ks[9], (DEPTH, H, E, E)) * (E ** -0.5)
    w_mk = nrm(ks[10], (DEPTH, H, E, E)) * (E ** -0.5)
    b_igate = nrm(ks[11], (DEPTH, H)) * 0.1
    b_fgate = jnp.linspace(3.0, 6.0, H)[None, :] + nrm(ks[12], (DEPTH, H)) * 0.1
    mh_norm_g = 1.0 + 0.02 * nrm(ks[13], (DEPTH, MLSTM_WIDTH))
    w_out = nrm(ks[14], (DEPTH, MIX_WIDTH, D)) * (MIX_WIDTH ** -0.5) * DEEPNORM_BETA
    ln1_g = 1.0 + 0.02 * nrm(ks[15], (DEPTH, D))
    ln1_b = 0.02 * nrm(ks[16], (DEPTH, D))
    peer_w_query = nrm(ks[17], (DEPTH, D, PEER_HEADS * PEER_KEY_DIM)) * std
    peer_sub_keys = nrm(ks[18], (DEPTH, PEER_HEADS, 2, PEER_N_KEYS, PEER_KEY_DIM // 2)) * ((PEER_KEY_DIM // 2) ** -0.5)
    peer_w_down = nrm(ks[19], (DEPTH, PEER_N_EXPERTS, D)) * std
    peer_w_up = nrm(ks[20], (DEPTH, PEER_N_EXPERTS, D)) * DEEPNORM_BETA
    ln2_g = 1.0 + 0.02 * nrm(ks[21], (DEPTH, D))
    ln2_b = 0.02 * nrm(ks[22], (DEPTH, D))
    return {"x": x, "w_in": w_in, "conv_w": conv_w, "conv_b": conv_b, "w_mq": w_mq, "w_mk": w_mk,
            "b_igate": b_igate, "b_fgate": b_fgate, "mh_norm_g": mh_norm_g, "w_out": w_out,
            "ln1_g": ln1_g, "ln1_b": ln1_b, "peer_w_query": peer_w_query, "peer_sub_keys": peer_sub_keys,
            "peer_w_down": peer_w_down, "peer_w_up": peer_w_up, "ln2_g": ln2_g, "ln2_b": ln2_b}


def reference(x, w_in, conv_w, conv_b, w_mq, w_mk, b_igate, b_fgate, mh_norm_g, w_out, ln1_g, ln1_b,
              peer_w_query, peer_sub_keys, peer_w_down, peer_w_up, ln2_g, ln2_b):
    h = x
    for l in range(DEPTH):
        mix = _token_mixing(h, w_in[l], conv_w[l], conv_b[l], w_mq[l], w_mk[l], b_igate[l], b_fgate[l],
                            mh_norm_g[l], w_out[l])
        h = _layer_norm(DEEPNORM_ALPHA * h + mix, ln1_g[l], ln1_b[l])
        ffn = _peer(h, peer_w_query[l], peer_sub_keys[l], peer_w_down[l], peer_w_up[l])
        h = _layer_norm(DEEPNORM_ALPHA * h + ffn, ln2_g[l], ln2_b[l])
    return h
```

```cpp
#include <hip/hip_runtime.h>
#include <cstdio>
#include <cstdint>
#include <cmath>

typedef unsigned short bf16;
constexpr int B_ = 16, S_ = 2048, D_ = 1024, T_ = B_ * S_;
constexpr int INC = 3080, NPROJ = 3072;
constexpr int C_QA = 0, C_KA = 512, C_VA = 1024, C_XM = 1536, C_VM = 2048, C_OM = 2560;
constexpr float ALPHA = 1.189207115002721f;
constexpr float LN_EPS = 1e-5f;
constexpr size_t MiB = 1u << 20;

__device__ __forceinline__ float bf2f(bf16 v) { return __uint_as_float((unsigned)v << 16); }
__device__ __forceinline__ bf16 f2bf(float f) { unsigned u = __float_as_uint(f); return (bf16)((u + 0x7fffu + ((u >> 16) & 1u)) >> 16); }
__device__ __forceinline__ float wave_sum(float v) {
#pragma unroll
    for (int o = 1; o < 64; o <<= 1) v += __shfl_xor(v, o);
    return v;
}
__device__ __forceinline__ float wave_max(float v) {
#pragma unroll
    for (int o = 1; o < 64; o <<= 1) v = fmaxf(v, __shfl_xor(v, o));
    return v;
}
__device__ __forceinline__ float dot_bf16row(const float* q  , const bf16* row, int n) {
    float acc = 0.f;
    for (int e = 0; e < n; e += 8) {
        const uint4 w = *(const uint4*)(row + e);
        acc += q[e + 0] * __uint_as_float(w.x << 16) + q[e + 1] * __uint_as_float(w.x & 0xffff0000u);
        acc += q[e + 2] * __uint_as_float(w.y << 16) + q[e + 3] * __uint_as_float(w.y & 0xffff0000u);
        acc += q[e + 4] * __uint_as_float(w.z << 16) + q[e + 5] * __uint_as_float(w.z & 0xffff0000u);
        acc += q[e + 6] * __uint_as_float(w.w << 16) + q[e + 7] * __uint_as_float(w.w & 0xffff0000u);
    }
    return acc;
}

struct GemmArgs {
    const void* A; const float* Bw; int N, ldb, K;
    bf16* obf; int ldo;
    float* of32; const float* xres;
    float* ipre; float* logf; const float* big; const float* bfg;
};
template <int MODE>
__global__ __launch_bounds__(256) void ngemm(GemmArgs g) {
    __shared__ float As[16][68], Bs[16][68];
    const int tid = threadIdx.x, tx = tid & 15, ty = tid >> 4;
    const int m0 = blockIdx.y * 64, n0 = blockIdx.x * 64;
    float acc[4][4] = {};
    for (int k0 = 0; k0 < g.K; k0 += 16) {
        {
            const int r = tid >> 2, kk = (tid & 3) * 4;
            float a0, a1, a2, a3;
            if (MODE == 0) { const float4 v = *(const float4*)((const float*)g.A + (size_t)(m0 + r) * g.K + k0 + kk); a0 = v.x; a1 = v.y; a2 = v.z; a3 = v.w; }
            else { const uint2 v = *(const uint2*)((const bf16*)g.A + (size_t)(m0 + r) * g.K + k0 + kk); a0 = __uint_as_float(v.x << 16); a1 = __uint_as_float(v.x & 0xffff0000u); a2 = __uint_as_float(v.y << 16); a3 = __uint_as_float(v.y & 0xffff0000u); }
            As[kk + 0][r] = a0; As[kk + 1][r] = a1; As[kk + 2][r] = a2; As[kk + 3][r] = a3;
        }
        {
            const int kk = tid >> 4, nn = (tid & 15) * 4;
            float4 v = {0.f, 0.f, 0.f, 0.f};
            if (n0 + nn < g.N) v = *(const float4*)(g.Bw + (size_t)(k0 + kk) * g.ldb + n0 + nn);
            Bs[kk][nn + 0] = v.x; Bs[kk][nn + 1] = v.y; Bs[kk][nn + 2] = v.z; Bs[kk][nn + 3] = v.w;
        }
        __syncthreads();
#pragma unroll
        for (int kk = 0; kk < 16; ++kk) {
            float a[4], b[4];
#pragma unroll
            for (int i = 0; i < 4; ++i) { a[i] = As[kk][ty * 4 + i]; b[i] = Bs[kk][tx * 4 + i]; }
#pragma unroll
            for (int i = 0; i < 4; ++i)
#pragma unroll
                for (int j = 0; j < 4; ++j) acc[i][j] += a[i] * b[j];
        }
        __syncthreads();
    }
#pragma unroll
    for (int i = 0; i < 4; ++i) {
        const int r = m0 + ty * 4 + i;
#pragma unroll
        for (int j = 0; j < 4; ++j) {
            const int c = n0 + tx * 4 + j; if (c >= g.N) continue;
            const float v = acc[i][j];
            if (MODE == 0) {
                if (c < NPROJ) g.obf[(size_t)r * g.ldo + c] = f2bf(v);
                else { const int gc = c - NPROJ;
                    if (gc < 4) g.ipre[(size_t)r * 4 + gc] = v + g.big[gc];
                    else { const float z = v + g.bfg[gc - 4]; g.logf[(size_t)r * 4 + gc - 4] = fminf(z, 0.f) - log1pf(expf(-fabsf(z))); } }
            } else if (MODE == 1) { g.of32[(size_t)r * D_ + c] = ALPHA * g.xres[(size_t)r * D_ + c] + v; }
            else { g.obf[(size_t)r * g.ldo + c] = f2bf(v); }
        }
    }
}

__global__ __launch_bounds__(512) void nattn(const bf16* proj, bf16* concat) {
    const int bt = blockIdx.x, b = bt / S_, t = bt % S_, h = threadIdx.x >> 6, lane = threadIdx.x & 63;
    __shared__ float qs[8][64]; __shared__ float ps[8][448];
    qs[h][lane] = bf2f(proj[(size_t)bt * NPROJ + C_QA + h * 64 + lane]) * 0.125f;
    __syncthreads();
    float sc[7]; float mx = -INFINITY;
#pragma unroll
    for (int r = 0; r < 7; ++r) {
        const int idx = r * 64 + lane; float s = -INFINITY;
        if (idx < 387) { const int br = idx / 129, j = idx % 129, d = br == 0 ? 1 : (br == 1 ? 4 : 16), tk = t - j * d;
            if (tk >= 0) s = dot_bf16row(qs[h], proj + (size_t)(b * S_ + tk) * NPROJ + C_KA + h * 64, 64); }
        sc[r] = s; mx = fmaxf(mx, s);
    }
    mx = wave_max(mx);
    float l = 0.f;
#pragma unroll
    for (int r = 0; r < 7; ++r) { const float p = (sc[r] == -INFINITY) ? 0.f : expf(sc[r] - mx); l += p; ps[h][r * 64 + lane] = p; }
    l = wave_sum(l);
    __syncthreads();
    float o = 0.f;
    for (int idx = 0; idx < 387; ++idx) {
        const float p = ps[h][idx];
        if (p != 0.f) { const int br = idx / 129, j = idx % 129, d = br == 0 ? 1 : (br == 1 ? 4 : 16), tk = t - j * d;
            o += p * bf2f(proj[(size_t)(b * S_ + tk) * NPROJ + C_VA + h * 64 + lane]); }
    }
    concat[(size_t)bt * D_ + h * 64 + lane] = f2bf(o / l);
}

__global__ __launch_bounds__(128) void nml_qk(const bf16* proj, const float* conv_w, const float* conv_b, const float* w_mq, const float* w_mk, bf16* mq, bf16* mk) {
    const int id = blockIdx.x, h = id & 3, bt = id >> 2, t = bt % S_, e = threadIdx.x, c = h * 128 + e;
    __shared__ float xc[128];
    float acc = conv_b[c];
#pragma unroll
    for (int w = 0; w < 4; ++w) { const int tt = t - 3 + w; if (tt >= 0) acc += conv_w[w * 512 + c] * bf2f(proj[(size_t)(bt - 3 + w) * NPROJ + C_XM + c]); }
    xc[e] = acc / (1.f + expf(-acc));
    __syncthreads();
    float q = 0.f, k = 0.f;
    for (int e2 = 0; e2 < 128; ++e2) { const float x = xc[e2]; q += x * w_mq[(size_t)(h * 128 + e2) * 128 + e]; k += x * w_mk[(size_t)(h * 128 + e2) * 128 + e]; }
    mq[(size_t)bt * 512 + c] = f2bf(q * 0.08838834764831845f); mk[(size_t)bt * 512 + c] = f2bf(k);
}
__global__ void nml_prefix(const float* ipre, const float* logf, float* aArr, float* Marr, float* Farr) {
    const int id = threadIdx.x; if (id >= 64) return; const int b = id >> 2, h = id & 3;
    float F = 0.f, M = 0.f;
    for (int t = 0; t < S_; ++t) { const size_t i = (size_t)(b * S_ + t) * 4 + h; F += logf[i]; const float a = ipre[i] - F; M = fmaxf(M, a); aArr[i] = a; Marr[i] = M; Farr[i] = F; }
}
__global__ __launch_bounds__(256) void nml_out(const bf16* proj, const bf16* mq, const bf16* mk, const float* aArr, const float* Marr, const float* Farr, const float* mh_g, bf16* concat) {
    const int bt = blockIdx.x, b = bt / S_, t = bt % S_, h = threadIdx.x >> 6, lane = threadIdx.x & 63;
    __shared__ float qs[4][128]; __shared__ float cs[4][64];
    qs[h][lane] = bf2f(mq[(size_t)bt * 512 + h * 128 + lane]); qs[h][lane + 64] = bf2f(mq[(size_t)bt * 512 + h * 128 + lane + 64]);
    const float Mt = Marr[(size_t)bt * 4 + h], Ft = Farr[(size_t)bt * 4 + h];
    float num0 = 0.f, num1 = 0.f, den = 0.f;
    __syncthreads();
    for (int s0 = 0; s0 <= t; s0 += 64) {
        const int s = s0 + lane; float c = 0.f;
        if (s <= t) { const size_t r = (size_t)b * S_ + s; const float w = expf(aArr[r * 4 + h] - Mt); c = w * dot_bf16row(qs[h], mk + r * 512 + h * 128, 128); }
        den += c; cs[h][lane] = c;
        __syncthreads();
        const int n = min(64, t - s0 + 1);
        for (int j = 0; j < n; ++j) { const float cj = cs[h][j]; const bf16* vr = proj + (size_t)(b * S_ + s0 + j) * NPROJ + C_VM + h * 128; num0 += cj * bf2f(vr[lane]); num1 += cj * bf2f(vr[lane + 64]); }
        __syncthreads();
    }
    den = wave_sum(den);
    const float dn = fmaxf(fabsf(den), expf(-(Ft + Mt)));
    const float h0 = num0 / dn, h1 = num1 / dn;
    const float mu = wave_sum(h0 + h1) * (1.f / 128.f);
    const float var = wave_sum((h0 - mu) * (h0 - mu) + (h1 - mu) * (h1 - mu)) * (1.f / 128.f);
    const float rstd = 1.f / sqrtf(var + LN_EPS);
    const bf16* orow = proj + (size_t)bt * NPROJ + C_OM + h * 128;
    const float o0 = bf2f(orow[lane]), o1 = bf2f(orow[lane + 64]);
    concat[(size_t)bt * D_ + 512 + h * 128 + lane] = f2bf((h0 - mu) * rstd * mh_g[h * 128 + lane] / (1.f + expf(-o0)));
    concat[(size_t)bt * D_ + 512 + h * 128 + lane + 64] = f2bf((h1 - mu) * rstd * mh_g[h * 128 + lane + 64] / (1.f + expf(-o1)));
}

__global__ __launch_bounds__(256) void nln(float* y, const float* g, const float* bb, bf16* ob) {
    const int row = blockIdx.x * 4 + (threadIdx.x >> 6), lane = threadIdx.x & 63;
    float4* p = (float4*)(y + (size_t)row * D_) + lane; float4 v[4]; float s = 0.f;
#pragma unroll
    for (int j = 0; j < 4; ++j) { v[j] = p[64 * j]; s += v[j].x + v[j].y + v[j].z + v[j].w; }
    const float mu = wave_sum(s) * (1.f / D_); float q = 0.f;
#pragma unroll
    for (int j = 0; j < 4; ++j) { v[j].x -= mu; v[j].y -= mu; v[j].z -= mu; v[j].w -= mu; q += v[j].x * v[j].x + v[j].y * v[j].y + v[j].z * v[j].z + v[j].w * v[j].w; }
    const float rstd = 1.f / sqrtf(wave_sum(q) * (1.f / D_) + LN_EPS);
#pragma unroll
    for (int j = 0; j < 4; ++j) { const int c = (64 * j + lane) * 4; const float4 gg = *(const float4*)(g + c), b4 = *(const float4*)(bb + c);
        float4 o; o.x = v[j].x * rstd * gg.x + b4.x; o.y = v[j].y * rstd * gg.y + b4.y; o.z = v[j].z * rstd * gg.z + b4.z; o.w = v[j].w * rstd * gg.w + b4.w;
        p[64 * j] = o;
        if (ob) { uint2 w; w.x = (unsigned)f2bf(o.x) | ((unsigned)f2bf(o.y) << 16); w.y = (unsigned)f2bf(o.z) | ((unsigned)f2bf(o.w) << 16); *(uint2*)(ob + (size_t)row * D_ + c) = w; } }
}

__device__ __forceinline__ void wave_argmax(float& v, int& i) {
#pragma unroll
    for (int o = 1; o < 64; o <<= 1) { const float ov = __shfl_xor(v, o); const int oi = __shfl_xor(i, o); if (ov > v || (ov == v && oi < i)) { v = ov; i = oi; } }
}
__global__ __launch_bounds__(256) void nroute(const bf16* qry, const float* sub_keys, int* eidx, float* gate) {
    const int wv = threadIdx.x >> 6, lane = threadIdx.x & 63, th = blockIdx.x * 4 + wv, t = th >> 3, h = th & 7;
    __shared__ float qs[4][128]; __shared__ float tv[4][2][16]; __shared__ int ti[4][2][16];
    for (int p = 0; p < 2; ++p) {
        qs[wv][lane] = bf2f(qry[(size_t)t * 2048 + h * 256 + p * 128 + lane]); qs[wv][lane + 64] = bf2f(qry[(size_t)t * 2048 + h * 256 + p * 128 + lane + 64]);
        __syncthreads();
        float s0 = 0.f, s1 = 0.f;
        { const float* k0 = sub_keys + ((size_t)(h * 2 + p) * 128 + lane) * 128; const float* k1 = k0 + 64 * 128;
            for (int c = 0; c < 128; c += 4) { const float4 a = *(const float4*)(k0 + c), b = *(const float4*)(k1 + c); const float* q = qs[wv] + c;
                s0 += q[0] * a.x + q[1] * a.y + q[2] * a.z + q[3] * a.w; s1 += q[0] * b.x + q[1] * b.y + q[2] * b.z + q[3] * b.w; } }
        for (int r = 0; r < 16; ++r) {
            float v; int i; if (s0 >= s1) { v = s0; i = lane; } else { v = s1; i = lane + 64; }
            wave_argmax(v, i);
            if (lane == 0) { tv[wv][p][r] = v; ti[wv][p][r] = i; }
            if (i == lane) s0 = -INFINITY; if (i == lane + 64) s1 = -INFINITY;
        }
        __syncthreads();
    }
    float c[4];
#pragma unroll
    for (int n = 0; n < 4; ++n) { const int f = lane * 4 + n; c[n] = tv[wv][0][f >> 4] + tv[wv][1][f & 15]; }
    float best[16]; int pos[16];
#pragma unroll
    for (int r = 0; r < 16; ++r) {
        float v = c[0]; int i = lane * 4;
#pragma unroll
        for (int n = 1; n < 4; ++n) if (c[n] > v) { v = c[n]; i = lane * 4 + n; }
        wave_argmax(v, i);
        best[r] = v; pos[r] = i;
#pragma unroll
        for (int n = 0; n < 4; ++n) if (i == lane * 4 + n) c[n] = -INFINITY;
    }
    float den = 0.f;
#pragma unroll
    for (int r = 0; r < 16; ++r) den += expf(best[r] - best[0]);
    if (lane < 16) {
        float bv = 0.f; int pp = 0;
#pragma unroll
        for (int r = 0; r < 16; ++r) if (lane == r) { bv = best[r]; pp = pos[r]; }
        eidx[(size_t)t * 128 + h * 16 + lane] = ti[wv][0][pp >> 4] * 128 + ti[wv][1][pp & 15];
        gate[(size_t)t * 128 + h * 16 + lane] = expf(bv - best[0]) / den;
    }
}

__global__ __launch_bounds__(256) void nexperts(float* hio  , const int* eidx, const float* gate, const float* w_down, const float* w_up, const float* g2, const float* b2) {
    const int t = blockIdx.x, tid = threadIdx.x, wv = tid >> 6, lane = tid & 63;
    __shared__ float xs[1024]; __shared__ float as_[128]; __shared__ int es[128]; __shared__ float red[8];
    float* row = hio + (size_t)t * D_;
    *(float4*)(xs + tid * 4) = *(const float4*)(row + tid * 4);
    if (tid < 128) es[tid] = eidx[(size_t)t * 128 + tid];
    __syncthreads();
    for (int k = wv; k < 128; k += 4) {
        const float* wr = w_down + (size_t)es[k] * D_; float acc = 0.f;
#pragma unroll
        for (int j = 0; j < 4; ++j) { const float4 w = *(const float4*)(wr + (64 * j + lane) * 4); const float* x = xs + (64 * j + lane) * 4; acc += w.x * x[0] + w.y * x[1] + w.z * x[2] + w.w * x[3]; }
        acc = wave_sum(acc);
        if (lane == 0) as_[k] = 0.5f * acc * (1.f + erff(acc * 0.7071067811865476f)) * gate[(size_t)t * 128 + k];
    }
    __syncthreads();
    float4 o = {0.f, 0.f, 0.f, 0.f};
    for (int k = 0; k < 128; ++k) { const float a = as_[k]; const float4 w = *(const float4*)(w_up + (size_t)es[k] * D_ + tid * 4); o.x += a * w.x; o.y += a * w.y; o.z += a * w.z; o.w += a * w.w; }
    const float* x = xs + tid * 4;
    o.x += ALPHA * x[0]; o.y += ALPHA * x[1]; o.z += ALPHA * x[2]; o.w += ALPHA * x[3];
    float s = wave_sum(o.x + o.y + o.z + o.w); if (lane == 0) red[wv] = s; __syncthreads();
    const float mu = (red[0] + red[1] + red[2] + red[3]) * (1.f / D_);
    o.x -= mu; o.y -= mu; o.z -= mu; o.w -= mu;
    float q = wave_sum(o.x * o.x + o.y * o.y + o.z * o.z + o.w * o.w); if (lane == 0) red[4 + wv] = q; __syncthreads();
    const float rstd = 1.f / sqrtf((red[4] + red[5] + red[6] + red[7]) * (1.f / D_) + LN_EPS);
    const float4 gg = *(const float4*)(g2 + tid * 4), bb = *(const float4*)(b2 + tid * 4);
    float4 r; r.x = o.x * rstd * gg.x + bb.x; r.y = o.y * rstd * gg.y + bb.y; r.z = o.z * rstd * gg.z + bb.z; r.w = o.w * rstd * gg.w + bb.w;
    *(float4*)(row + tid * 4) = r;
}

constexpr size_t WS_PROJ = 16 * MiB;
constexpr size_t WS_GATE = 210 * MiB;
constexpr size_t WS_MQ = 216 * MiB, WS_MK = 248 * MiB;
constexpr size_t WS_CONCAT = 280 * MiB;
constexpr size_t WS_HB = 344 * MiB;
constexpr size_t WS_QRY = 16 * MiB;
constexpr size_t WS_EIDX = 408 * MiB, WS_GATEV = 424 * MiB;
constexpr size_t WS_END = 440 * MiB;

extern "C" void kernel_launch(void* const* d_in, const int* in_sizes, int n_in, void* d_out, int out_size, void* d_ws, size_t ws_size, hipStream_t stream) {
    if (n_in != 18 || out_size != T_ * D_ || ws_size < WS_END) { fprintf(stderr, "kernel_launch: unexpected sizes n_in %d out %d ws %zu\n", n_in, out_size, ws_size); return; }
    const float* x = (const float*)d_in[0]; const float* w_in = (const float*)d_in[1]; const float* conv_w = (const float*)d_in[2]; const float* conv_b = (const float*)d_in[3];
    const float* w_mq = (const float*)d_in[4]; const float* w_mk = (const float*)d_in[5]; const float* b_ig = (const float*)d_in[6]; const float* b_fg = (const float*)d_in[7];
    const float* mh_g = (const float*)d_in[8]; const float* w_out = (const float*)d_in[9]; const float* ln1_g = (const float*)d_in[10]; const float* ln1_b = (const float*)d_in[11];
    const float* w_query = (const float*)d_in[12]; const float* sub_keys = (const float*)d_in[13]; const float* w_down = (const float*)d_in[14]; const float* w_up = (const float*)d_in[15];
    const float* ln2_g = (const float*)d_in[16]; const float* ln2_b = (const float*)d_in[17];
    unsigned char* ws = (unsigned char*)d_ws; float* out = (float*)d_out;
    bf16* proj = (bf16*)(ws + WS_PROJ); float* ipre = (float*)(ws + WS_GATE); float* logf = ipre + (size_t)T_ * 4; float* aArr = logf + (size_t)T_ * 4; float* Marr = aArr + (size_t)T_ * 4; float* Farr = Marr + (size_t)T_ * 4;
    bf16* mq = (bf16*)(ws + WS_MQ); bf16* mk = (bf16*)(ws + WS_MK); bf16* concat = (bf16*)(ws + WS_CONCAT); bf16* hb = (bf16*)(ws + WS_HB); bf16* qry = (bf16*)(ws + WS_QRY);
    int* eidx = (int*)(ws + WS_EIDX); float* gate = (float*)(ws + WS_GATEV);

    { GemmArgs g{}; g.A = x; g.Bw = w_in; g.N = INC; g.ldb = INC; g.K = D_; g.obf = proj; g.ldo = NPROJ; g.ipre = ipre; g.logf = logf; g.big = b_ig; g.bfg = b_fg;
      ngemm<0><<<dim3((INC + 63) / 64, T_ / 64), 256, 0, stream>>>(g); }
    nattn<<<T_, 512, 0, stream>>>(proj, concat);
    nml_qk<<<T_ * 4, 128, 0, stream>>>(proj, conv_w, conv_b, w_mq, w_mk, mq, mk);
    nml_prefix<<<1, 64, 0, stream>>>(ipre, logf, aArr, Marr, Farr);
    nml_out<<<T_, 256, 0, stream>>>(proj, mq, mk, aArr, Marr, Farr, mh_g, concat);
    { GemmArgs g{}; g.A = concat; g.Bw = w_out; g.N = D_; g.ldb = D_; g.K = D_; g.of32 = out; g.xres = x;
      ngemm<1><<<dim3(D_ / 64, T_ / 64), 256, 0, stream>>>(g); }
    nln<<<T_ / 4, 256, 0, stream>>>(out, ln1_g, ln1_b, hb);
    { GemmArgs g{}; g.A = hb; g.Bw = w_query; g.N = 2048; g.ldb = 2048; g.K = D_; g.obf = qry; g.ldo = 2048;
      ngemm<2><<<dim3(2048 / 64, T_ / 64), 256, 0, stream>>>(g); }
    nroute<<<T_ * 8 / 4, 256, 0, stream>>>(qry, sub_keys, eidx, gate);
    nexperts<<<T_, 256, 0, stream>>>(out, eidx, gate, w_down, w_up, ln2_g, ln2_b);
}
```

```cpp
#include <hip/hip_runtime.h>
#include <cstdio>
#include <cstdint>
#include <cmath>
namespace pg8 {
#define PG8_LAS __attribute__((address_space(3)))
typedef unsigned short bf16_t;
typedef short bf16x8 __attribute__((ext_vector_type(8)));
typedef float f32x4 __attribute__((ext_vector_type(4)));
typedef unsigned u32x4 __attribute__((ext_vector_type(4)));
typedef int i32x4 __attribute__((ext_vector_type(4)));
constexpr int BM = 256, BK = 64, HALF = 128, HTB = HALF * BK * 2  , STAGE_BYTES = 8 * HTB, NXCD = 8, WGM = 8;

__host__ __device__ __forceinline__ int lds_byte(int r, int c) { const int st = (r >> 4) * 2 + (c >> 5), rr = r & 15, cc = c & 31, ob = rr * 64 + cc * 2; return st * 1024 + (ob ^ (((ob >> 9) & 1) << 5)); }
__host__ __device__ __forceinline__ void stage_rc(int b, int& R, int& C) { const int st = b / 1024, sb = b % 1024, swz = sb ^ (((sb >> 9) & 1) << 5); R = (st >> 1) * 16 + swz / 64; C = (st & 1) * 32 + (swz % 64) / 2; }
__host__ __device__ __forceinline__ int perm32(int rho) { const int n = rho >> 4, i = rho & 15; return 8 * (i >> 2) + 4 * n + (i & 3); }

struct Unit { int pm, pn; };
struct Gemm { const bf16_t* A; const bf16_t* Bt; int M, N, K; };

struct StaticOrder {
    int nM, nN, nwg, G, c;
    __host__ __device__ void init(int M, int N, int G_, int c_) { nM = M / BM; nN = N / BM; nwg = nM * nN; G = G_; c = c_; }
    __host__ __device__ bool next(int i, Unit& u) const {
        const long L = (long)i * G + c; if (L >= nwg) return false;
        int wgid = (int)L; { const int q = nwg / NXCD, r = nwg % NXCD, xcd = wgid % NXCD, off = wgid / NXCD; wgid = (xcd < r ? xcd * (q + 1) : r * (q + 1) + (xcd - r) * q) + off; }
        const int nig = WGM * nN, gid = wgid / nig, fm = gid * WGM, gsz = (nM - fm) < WGM ? (nM - fm) : WGM;
        u.pm = fm + ((wgid % nig) % gsz); u.pn = (wgid % nig) / gsz; return true;
    }
    __device__ __forceinline__ void a_ready(const Unit&) const {}
    __device__ __forceinline__ void done(const Unit&) const {}
};

__device__ __forceinline__ unsigned cvt_pk_bf16(float lo, float hi) { unsigned r; asm volatile("v_cvt_pk_bf16_f32 %0, %1, %2" : "=v"(r) : "v"(lo), "v"(hi)); return r; }
typedef float f32x2 __attribute__((ext_vector_type(2)));
__device__ __forceinline__ f32x2 gelu_pk(f32x2 v) {
    const f32x2 av = __builtin_elementwise_abs(v), d = av * 0.2316418882f + 1.0f;
    f32x2 t; t.x = __builtin_amdgcn_rcpf(d.x); t.y = __builtin_amdgcn_rcpf(d.y);
    f32x2 q = t * 0.5307027145f + (-0.7265760135f); q = q * t + 0.7107068705f; q = q * t + (-0.142248368f); q = q * t + 0.127414796f; q = q * t;
    const f32x2 s = (v * v) * (-0.72134752044f);
    f32x2 e; e.x = __builtin_amdgcn_exp2f(s.x); e.y = __builtin_amdgcn_exp2f(s.y);
    const f32x2 m = v * (q * e), r = v - m;
    f32x2 o; o.x = v.x < 0.f ? m.x : r.x; o.y = v.y < 0.f ? m.y : r.y; return o;
}

template <int ACT  > struct EpiBf16 {
    static constexpr bool PERM = true, AFTER_DRAIN = false, I8 = false; static_assert(ACT == 0 || ACT == 1, "EpiBf16: ACT is 0 (none) or 1 (gelu_pk)");
    bf16_t* O; int ldc; const float* bias; int split_cols; size_t split_stride; float scale0;
    __device__ __forceinline__ void operator()(const f32x4 (&acc)[2][2][4][2], const Unit& u, int wr, int wc, int fr, int fq) const {
        const int row0 = u.pm * BM + wr * 64 + fr; int colt = u.pn * BM; bf16_t* base = O;
        float sc = 1.f; if (split_cols) { const int t = colt / split_cols; base += (size_t)t * split_stride; colt -= t * split_cols; if (t == 0) sc = scale0; }
        const int col0 = colt + wc * 32 + 8 * fq, bcol0 = u.pn * BM + wc * 32 + 8 * fq;
        f32x4 bv[2][2];
#pragma unroll
        for (int bj = 0; bj < 2; ++bj)
#pragma unroll
            for (int n = 0; n < 2; ++n) bv[bj][n] = bias ? *(const f32x4*)(bias + bcol0 + bj * HALF + 4 * n) : (f32x4){0.f, 0.f, 0.f, 0.f};
#pragma unroll
        for (int ai = 0; ai < 2; ++ai)
#pragma unroll
            for (int m = 0; m < 4; ++m) { bf16_t* rowp = base + (size_t)(row0 + ai * HALF + m * 16) * ldc + col0;
#pragma unroll
                for (int bj = 0; bj < 2; ++bj) { f32x4 v0 = acc[ai][bj][m][0] + bv[bj][0], v1 = acc[ai][bj][m][1] + bv[bj][1];
                    if (ACT == 1) { f32x2 a = gelu_pk((f32x2){v0[0], v0[1]}), b = gelu_pk((f32x2){v0[2], v0[3]}), c = gelu_pk((f32x2){v1[0], v1[1]}), d = gelu_pk((f32x2){v1[2], v1[3]});
                        v0 = (f32x4){a.x, a.y, b.x, b.y}; v1 = (f32x4){c.x, c.y, d.x, d.y}; }
                    v0 = v0 * sc; v1 = v1 * sc; u32x4 w; w.x = cvt_pk_bf16(v0[0], v0[1]); w.y = cvt_pk_bf16(v0[2], v0[3]); w.z = cvt_pk_bf16(v1[0], v1[1]); w.w = cvt_pk_bf16(v1[2], v1[3]);
                    *(u32x4*)(rowp + bj * HALF) = w; } }
    }
};
struct EpiResBf16 {
    static constexpr bool PERM = true, AFTER_DRAIN = false, I8 = false;
    const float* xres; bf16_t* out; float alpha;
    __device__ __forceinline__ void operator()(const f32x4 (&acc)[2][2][4][2], const Unit& u, int wr, int wc, int fr, int fq) const {
        const int col0 = u.pn * BM + wc * 32 + 8 * fq;
#pragma unroll
        for (int ai = 0; ai < 2; ++ai)
#pragma unroll
            for (int m = 0; m < 4; ++m) { const size_t off = (size_t)(u.pm * BM + ai * HALF + wr * 64 + m * 16 + fr) * 1024 + col0;
#pragma unroll
                for (int bj = 0; bj < 2; ++bj) { const f32x4 x0 = *(const f32x4*)(xres + off + bj * HALF), x1 = *(const f32x4*)(xres + off + bj * HALF + 4);
                    const f32x4 v0 = x0 * alpha + acc[ai][bj][m][0], v1 = x1 * alpha + acc[ai][bj][m][1];
                    u32x4 w; w.x = cvt_pk_bf16(v0[0], v0[1]); w.y = cvt_pk_bf16(v0[2], v0[3]); w.z = cvt_pk_bf16(v1[0], v1[1]); w.w = cvt_pk_bf16(v1[2], v1[3]);
                    *(u32x4*)(out + off + bj * HALF) = w; } }
    }
};
struct EpiI8Bf16 {
    static constexpr bool PERM = true, AFTER_DRAIN = false, I8 = true;
    bf16_t* O; int ldc; const float* sa; const float* sb;
    __device__ __forceinline__ void operator()(const i32x4 (&acc)[2][2][4][2], const Unit& u, int wr, int wc, int fr, int fq) const {
        const int row0 = u.pm * BM + wr * 64 + fr, col0 = u.pn * BM + wc * 32 + 8 * fq;
        f32x4 sbv[2][2];
#pragma unroll
        for (int bj = 0; bj < 2; ++bj)
#pragma unroll
            for (int n = 0; n < 2; ++n) sbv[bj][n] = *(const f32x4*)(sb + col0 + bj * HALF + 4 * n);
#pragma unroll
        for (int ai = 0; ai < 2; ++ai)
#pragma unroll
            for (int m = 0; m < 4; ++m) { const int r = row0 + ai * HALF + m * 16; const float sr = sa[r]; bf16_t* rowp = O + (size_t)r * ldc + col0;
#pragma unroll
                for (int bj = 0; bj < 2; ++bj) { const i32x4 a0 = acc[ai][bj][m][0], a1 = acc[ai][bj][m][1];
                    const f32x4 v0 = (f32x4){(float)a0[0], (float)a0[1], (float)a0[2], (float)a0[3]} * sbv[bj][0] * sr, v1 = (f32x4){(float)a1[0], (float)a1[1], (float)a1[2], (float)a1[3]} * sbv[bj][1] * sr;
                    u32x4 w; w.x = cvt_pk_bf16(v0[0], v0[1]); w.y = cvt_pk_bf16(v0[2], v0[3]); w.z = cvt_pk_bf16(v1[0], v1[1]); w.w = cvt_pk_bf16(v1[2], v1[3]);
                    *(u32x4*)(rowp + bj * HALF) = w; } }
    }
};
__device__ __forceinline__ f32x4 mma16(bf16x8 a, bf16x8 b, f32x4 c) { return __builtin_amdgcn_mfma_f32_16x16x32_bf16(a, b, c, 0, 0, 0); }
__device__ __forceinline__ i32x4 mma16(bf16x8 a, bf16x8 b, i32x4 c) { return __builtin_amdgcn_mfma_i32_16x16x64_i8(__builtin_bit_cast(i32x4, a), __builtin_bit_cast(i32x4, b), c, 0, 0, 0); }
template <bool I8> struct AccT { typedef f32x4 type; };
template <> struct AccT<true> { typedef i32x4 type; };
template <class Epi, class Sched, bool ALIGN_EPI = false, bool SP2 = false>
__device__ __forceinline__ void gemm_phase(PG8_LAS unsigned char* lds, const Gemm g, const Sched& S, const Epi& E) {
    const int tid = threadIdx.x, wid = __builtin_amdgcn_readfirstlane(tid >> 6), lane = tid & 63, wr = wid >> 2, wc = wid & 3, fr = lane & 15, fq = lane >> 4;
    const int K = g.K, nt = K / BK;
    unsigned voffA[2], voffB[2];
#pragma unroll
    for (int i = 0; i < 2; ++i) { int R, C; stage_rc(tid * 16 + i * 8192, R, C); const int Rb = Epi::PERM ? ((R & ~31) + perm32(R & 31)) : R;
        voffA[i] = (unsigned)(R * K + C) * 2u; voffB[i] = (unsigned)(Rb * K + C) * 2u; }
    const size_t kstep = (size_t)(BK * 2);
    const size_t hstep = (size_t)HALF * K * 2;
    const size_t tstep = 2 * hstep;
    const unsigned ldsw = (unsigned)wid * 1024u;
    const int aoff = lds_byte(wr * 64 + fr, fq * 8), boff = lds_byte(wc * 32 + fr, fq * 8);
#define PG8_SA(b, h) (((b) * 2 + (h)) * HTB)
#define PG8_SB(b, h) ((4 + (b) * 2 + (h)) * HTB)
#define PG8_STAGE(bufoff, gbase, voff) do { _Pragma("unroll") for (int _i = 0; _i < 2; ++_i) \
        __builtin_amdgcn_global_load_lds((const unsigned*)((const char*)(gbase) + (voff)[_i]), (PG8_LAS unsigned*)(lds + (bufoff) + ldsw + _i * 8192), 16, 0, 0); } while (0)
#define PG8_LDA(dst, b, h) do { _Pragma("unroll") for (int m = 0; m < 4; ++m) _Pragma("unroll") for (int k = 0; k < 2; ++k) dst[m][k] = *(const PG8_LAS bf16x8*)(lds + PG8_SA(b, h) + aoff + m * 2048 + k * 1024); } while (0)
#define PG8_LDB(dst, b, h) do { _Pragma("unroll") for (int n = 0; n < 2; ++n) _Pragma("unroll") for (int k = 0; k < 2; ++k) dst[n][k] = *(const PG8_LAS bf16x8*)(lds + PG8_SB(b, h) + boff + n * 2048 + k * 1024); } while (0)
#define PG8_MMA(ai, bj, At, Bt) do { __builtin_amdgcn_s_setprio(1); _Pragma("unroll") for (int m = 0; m < 4; ++m) _Pragma("unroll") for (int n = 0; n < 2; ++n) _Pragma("unroll") for (int k = 0; k < 2; ++k) \
        acc[ai][bj][m][n] = mma16(Bt[n][k], At[m][k], acc[ai][bj][m][n]); __builtin_amdgcn_s_setprio(0); } while (0)
#define PG8_WAIT_V(n) asm volatile("s_waitcnt vmcnt(" #n ")" ::: "memory")
#define PG8_WAIT_L(n) asm volatile("s_waitcnt lgkmcnt(" #n ")" ::: "memory")
#define PG8_BAR __builtin_amdgcn_s_barrier()
#define PG8_SCHED __builtin_amdgcn_sched_barrier(0)
    Unit cur, nxt; int ui = 0;
    if (!S.next(0, cur)) return;
    typedef typename AccT<Epi::I8>::type acc_t; const acc_t acc_zero = {0, 0, 0, 0};
    acc_t acc[2][2][4][2];
#pragma unroll
    for (int a = 0; a < 2; ++a)
#pragma unroll
        for (int b = 0; b < 2; ++b)
#pragma unroll
            for (int m = 0; m < 4; ++m)
#pragma unroll
                for (int n = 0; n < 2; ++n) acc[a][b][m][n] = acc_zero;
    bf16x8 At[4][2], B0[2][2], B1[2][2];
    const char* cA = (const char*)g.A + (size_t)cur.pm * tstep; const char* cB = (const char*)g.Bt + (size_t)cur.pn * tstep;
    S.a_ready(cur);
    if constexpr (SP2) {
        PG8_STAGE(PG8_SB(0, 0), cB, voffB); PG8_STAGE(PG8_SB(0, 1), cB + hstep, voffB); PG8_STAGE(PG8_SA(0, 0), cA, voffA); PG8_STAGE(PG8_SA(0, 1), cA + hstep, voffA);
        if (wr == 1) PG8_BAR;
        PG8_WAIT_V(2); PG8_BAR;
        PG8_STAGE(PG8_SB(1, 0), cB + kstep, voffB); PG8_STAGE(PG8_SA(1, 0), cA + kstep, voffA); PG8_STAGE(PG8_SB(1, 1), cB + hstep + kstep, voffB);
        PG8_WAIT_V(6); PG8_BAR;
    } else {
        PG8_STAGE(PG8_SB(0, 0), cB, voffB); PG8_STAGE(PG8_SA(0, 0), cA, voffA); PG8_STAGE(PG8_SB(0, 1), cB + hstep, voffB); PG8_STAGE(PG8_SA(0, 1), cA + hstep, voffA);
        if (wr == 1) PG8_BAR;
        PG8_WAIT_V(4); PG8_BAR;
        PG8_STAGE(PG8_SB(1, 0), cB + kstep, voffB); PG8_STAGE(PG8_SA(1, 0), cA + kstep, voffA); PG8_STAGE(PG8_SB(1, 1), cB + hstep + kstep, voffB);
        PG8_WAIT_V(6); PG8_BAR;
    }
    for (;;) {
        const bool has_next = S.next(ui + 1, nxt);
        const char* nA = has_next ? (const char*)g.A + (size_t)nxt.pm * tstep : cA; const char* nB = has_next ? (const char*)g.Bt + (size_t)nxt.pn * tstep : cB;
        for (int t = 0; t < nt; t += 2) {
            const bool last = (t == nt - 2);
            const char* a1 = cA + (size_t)(t + 1) * kstep;
            const char* a2 = last ? nA : cA + (size_t)(t + 2) * kstep; const char* b2 = last ? nB : cB + (size_t)(t + 2) * kstep;
            const char* a3 = a2 + kstep; const char* b3 = b2 + kstep;
            if (last && has_next) S.a_ready(nxt);
            if constexpr (SP2) {
            PG8_LDB(B0, 0, 0); PG8_LDB(B1, 0, 1); PG8_SCHED; PG8_LDA(At, 0, 0); PG8_STAGE(PG8_SA(1, 1), a1 + hstep, voffA);
            PG8_WAIT_V(8); PG8_WAIT_L(0); PG8_BAR; PG8_MMA(0, 0, At, B0); PG8_MMA(0, 1, At, B1); PG8_BAR; PG8_SCHED;
            PG8_LDA(At, 0, 1); PG8_STAGE(PG8_SB(0, 0), b2, voffB); PG8_STAGE(PG8_SB(0, 1), b2 + hstep, voffB); PG8_STAGE(PG8_SA(0, 0), a2, voffA);
            PG8_WAIT_V(8); PG8_WAIT_L(0); PG8_BAR; PG8_MMA(1, 0, At, B0); PG8_MMA(1, 1, At, B1); PG8_BAR; PG8_SCHED;
            PG8_LDB(B0, 1, 0); PG8_LDB(B1, 1, 1); PG8_SCHED; PG8_LDA(At, 1, 0); PG8_STAGE(PG8_SA(0, 1), a2 + hstep, voffA);
            PG8_WAIT_V(8); PG8_WAIT_L(0); PG8_BAR; PG8_MMA(0, 0, At, B0); PG8_MMA(0, 1, At, B1); PG8_BAR; PG8_SCHED;
            PG8_LDA(At, 1, 1); PG8_STAGE(PG8_SB(1, 0), b3, voffB); PG8_STAGE(PG8_SB(1, 1), b3 + hstep, voffB); PG8_STAGE(PG8_SA(1, 0), a3, voffA);
            PG8_WAIT_V(8); PG8_WAIT_L(0); PG8_BAR; PG8_MMA(1, 0, At, B0); PG8_MMA(1, 1, At, B1); PG8_BAR; PG8_SCHED;
            } else {
            PG8_LDB(B0, 0, 0); PG8_SCHED; PG8_LDA(At, 0, 0); PG8_STAGE(PG8_SA(1, 1), a1 + hstep, voffA);
            PG8_WAIT_L(8); PG8_BAR; PG8_WAIT_L(0); PG8_MMA(0, 0, At, B0); PG8_BAR; PG8_SCHED;
            PG8_LDB(B1, 0, 1); PG8_STAGE(PG8_SB(0, 0), b2, voffB);
            PG8_BAR; PG8_WAIT_L(0); PG8_MMA(0, 1, At, B1); PG8_BAR;
            PG8_LDA(At, 0, 1); PG8_STAGE(PG8_SA(0, 0), a2, voffA);
            PG8_BAR; PG8_WAIT_L(0); PG8_MMA(1, 0, At, B0); PG8_BAR; PG8_SCHED;
            PG8_STAGE(PG8_SB(0, 1), b2 + hstep, voffB);
            PG8_WAIT_V(6); PG8_BAR; PG8_MMA(1, 1, At, B1); PG8_BAR;
            PG8_LDB(B0, 1, 0); PG8_SCHED; PG8_LDA(At, 1, 0); PG8_STAGE(PG8_SA(0, 1), a2 + hstep, voffA);
            PG8_WAIT_L(8); PG8_BAR; PG8_WAIT_L(0); PG8_MMA(0, 0, At, B0); PG8_BAR; PG8_SCHED;
            PG8_LDB(B1, 1, 1); PG8_STAGE(PG8_SB(1, 0), b3, voffB);
            PG8_BAR; PG8_WAIT_L(0); PG8_MMA(0, 1, At, B1); PG8_BAR;
            PG8_LDA(At, 1, 1); PG8_STAGE(PG8_SA(1, 0), a3, voffA);
            PG8_BAR; PG8_WAIT_L(0); PG8_MMA(1, 0, At, B0); PG8_BAR; PG8_SCHED;
            PG8_STAGE(PG8_SB(1, 1), b3 + hstep, voffB);
            PG8_WAIT_V(6); PG8_BAR; PG8_MMA(1, 1, At, B1); PG8_BAR;
            }
        }
        if constexpr (ALIGN_EPI) { if (wr == 0) PG8_BAR; }
        if constexpr (!Epi::AFTER_DRAIN) { E(acc, cur, wr, wc, fr, fq); S.done(cur); }
        if (!has_next) break;
#pragma unroll
        for (int a = 0; a < 2; ++a)
#pragma unroll
            for (int b = 0; b < 2; ++b)
#pragma unroll
                for (int m = 0; m < 4; ++m)
#pragma unroll
                    for (int n = 0; n < 2; ++n) acc[a][b][m][n] = acc_zero;
        cur = nxt; cA = nA; cB = nB; ++ui;
        if constexpr (ALIGN_EPI) { if (wr == 1) PG8_BAR; }
    }
    PG8_WAIT_V(0);
    if constexpr (!ALIGN_EPI) { if (wr == 0) PG8_BAR; }
    PG8_BAR;
    if constexpr (Epi::AFTER_DRAIN) { E.fused(acc, cur, wr, wc, fr, fq, lds, wid, lane); S.done(cur); }
#undef PG8_SA
#undef PG8_SB
#undef PG8_STAGE
#undef PG8_LDA
#undef PG8_LDB
#undef PG8_MMA
#undef PG8_WAIT_V
#undef PG8_WAIT_L
#undef PG8_BAR
#undef PG8_SCHED
}
}
typedef unsigned short bf16;
#define LAS __attribute__((address_space(3)))
constexpr int B_ = 16, S_ = 2048, D_ = 1024, T_ = B_ * S_;
constexpr int INC = 3080, NPROJ = 3072;
constexpr int C_QA = 0, C_KA = 512, C_VA = 1024, C_XM = 1536, C_VM = 2048, C_OM = 2560;
constexpr float ALPHA = 1.189207115002721f;
constexpr float LN_EPS = 1e-5f;
constexpr size_t MiB = 1u << 20;
constexpr int NWAVES = 8, NTHREADS = 512;
constexpr int LDS_BYTES = 147456;

constexpr size_t WS_WIN = 1 * MiB;
constexpr size_t WS_SWN = 768 * 1024, WS_SXA = 800 * 1024;
constexpr size_t WS_WOUT = 7 * MiB;
constexpr size_t WS_WQ = 9 * MiB;
constexpr size_t WS_SWQ = 780 * 1024;
constexpr size_t WS_GATE = 13 * MiB;
constexpr size_t WS_PROJ = 16 * MiB;
constexpr size_t WS_QRY = 16 * MiB;
constexpr size_t WS_Y1 = 336 * MiB;
constexpr size_t WS_ST1 = 305 * MiB;
constexpr size_t WS_MQ = 208 * MiB, WS_MK = 240 * MiB;
constexpr size_t WS_CONCAT = 272 * MiB;
constexpr size_t WS_XB = 336 * MiB;
constexpr size_t WS_SK = 15 * MiB + 512 * 1024;
constexpr size_t WS_EIDX = 144 * MiB, WS_GATEV = 160 * MiB;
constexpr size_t WS_AFIN = 176 * MiB;
constexpr size_t WS_SA = 192 * MiB;
constexpr size_t WS_FFN = 208 * MiB;
constexpr size_t WS_APART = 208 * MiB;
constexpr size_t WS_XQ = 272 * MiB, WS_SX = 304 * MiB;
constexpr size_t WS_WD = 400 * MiB, WS_WU = 432 * MiB;
constexpr size_t WS_SCD = 640 * 1024, WS_SCU = 704 * 1024;
constexpr size_t WS_PO01 = 336 * MiB;
constexpr size_t OUT_DBUF = 40 * MiB, OUT_NLOC = 72 * MiB, OUT_CSC = 73 * MiB;
constexpr size_t WS_WMT = 0;
constexpr size_t OUT_PO2 = 0, OUT_PML = 32 * MiB;
constexpr size_t WS_END = 464 * MiB;
typedef short bf16x8 __attribute__((ext_vector_type(8)));
typedef float f32x16 __attribute__((ext_vector_type(16)));

__device__ __forceinline__ float bf2f(bf16 v) { return __uint_as_float((unsigned)v << 16); }
__device__ __forceinline__ unsigned f2bf(float f) { unsigned u = __float_as_uint(f); return (u + 0x7fffu + ((u >> 16) & 1u)) >> 16; }
__device__ __forceinline__ unsigned pk2(float lo, float hi) { return f2bf(lo) | (f2bf(hi) << 16); }
#define WAVE_FENCE() asm volatile("s_waitcnt lgkmcnt(0)" ::: "memory")
template <int CTRL> __device__ __forceinline__ float dppf_(float v) { return __int_as_float(__builtin_amdgcn_mov_dpp(__float_as_int(v), CTRL, 0xF, 0xF, true)); }
__device__ __forceinline__ float wave_sum(float v) {
    v += dppf_<0xB1>(v); v += dppf_<0x4E>(v); v += dppf_<0x141>(v); v += dppf_<0x140>(v);
    { const auto r = __builtin_amdgcn_permlane16_swap(__float_as_uint(v), __float_as_uint(v), false, false); v = __uint_as_float(r[0]) + __uint_as_float(r[1]); }
    { const auto r = __builtin_amdgcn_permlane32_swap(__float_as_uint(v), __float_as_uint(v), false, false); v = __uint_as_float(r[0]) + __uint_as_float(r[1]); }
    return v;
}
__device__ __forceinline__ float wave_max(float v) {
    v = fmaxf(v, dppf_<0xB1>(v)); v = fmaxf(v, dppf_<0x4E>(v)); v = fmaxf(v, dppf_<0x141>(v)); v = fmaxf(v, dppf_<0x140>(v));
    { const auto r = __builtin_amdgcn_permlane16_swap(__float_as_uint(v), __float_as_uint(v), false, false); v = fmaxf(__uint_as_float(r[0]), __uint_as_float(r[1])); }
    { const auto r = __builtin_amdgcn_permlane32_swap(__float_as_uint(v), __float_as_uint(v), false, false); v = fmaxf(__uint_as_float(r[0]), __uint_as_float(r[1])); }
    return v;
}
#define RLX_AGENT __ATOMIC_RELAXED, __HIP_MEMORY_SCOPE_AGENT
#define XB_TMO      128
#define XB_XCNT(j)  (256  + 64 * (j))
#define XB_XSUB(j)  (1280 + 64 * (j))
#define XB_XGEN(j)  (2304 + 64 * (j))
#define XB_TOP      3328
#define XB_TOPGEN   3392
#define XCD_BAR_WORDS 3456
#define XB_SPIN_CAP (1u << 18)

__device__ __forceinline__ unsigned xb_ld(unsigned* p)              { return __hip_atomic_load(p, __ATOMIC_RELAXED, __HIP_MEMORY_SCOPE_AGENT); }
__device__ __forceinline__ unsigned xb_add(unsigned* p, unsigned v) { return __hip_atomic_fetch_add(p, v, __ATOMIC_RELAXED, __HIP_MEMORY_SCOPE_AGENT); }
__device__ __forceinline__ unsigned xb_xcc_id() { return (unsigned)__builtin_amdgcn_s_getreg((3 << 11) | 20) & 0xFu; }
#define XB_SPIN(cond, bar) do { unsigned _sp = 0; while (cond) { __builtin_amdgcn_s_sleep(1); \
    if ((++_sp & 255u) == 0u) { if (xb_ld(&(bar)[XB_TMO])) break; if (_sp > XB_SPIN_CAP) { atomicAdd(&(bar)[XB_TMO], 1u); break; } } } } while (0)

struct XcdBarrier {
    unsigned* bar; unsigned x;
    volatile LAS unsigned* st;
};

__device__ __forceinline__ XcdBarrier xcd_barrier_post(unsigned* bar, volatile LAS unsigned* st) {
    XcdBarrier b; b.bar = bar; b.x = xb_xcc_id(); b.st = st;
    if (threadIdx.x == 0) (void)xb_add(&bar[XB_XCNT(b.x)], 1u);
    return b;
}
__device__ __forceinline__ void xcd_barrier_complete(unsigned* bar, unsigned x, unsigned& nloc, unsigned& nx) {
    const unsigned G = gridDim.x * gridDim.y * gridDim.z;
    unsigned sum, cnt, mine, sp = 0u;
    for (;;) {
        sum = 0u; cnt = 0u; mine = 0u;
#pragma unroll
        for (unsigned j = 0; j < 16; ++j) { const unsigned c = xb_ld(&bar[XB_XCNT(j)]); sum += c; cnt += (c > 0u) ? 1u : 0u; mine = (j == x) ? c : mine; }
        if (sum == G) break;
        __builtin_amdgcn_s_sleep(1);
        if ((++sp & 255u) == 0u) { if (xb_ld(&bar[XB_TMO])) break; if (sp > XB_SPIN_CAP) { atomicAdd(&bar[XB_TMO], 1u); break; } }
    }
    nloc = mine > 0u ? mine : 1u; nx = cnt > 0u ? cnt : 1u;
}

__device__ __forceinline__ void xcd_barrier(const XcdBarrier& b) {
    asm volatile("s_waitcnt vmcnt(0)" ::: "memory");
    __syncthreads();
    if (threadIdx.x == 0) {
        unsigned* bar = b.bar;
        __builtin_amdgcn_s_waitcnt(0);
        unsigned nloc = b.st[0], nx = b.st[1];
        if (nloc == 0u) { xcd_barrier_complete(bar, b.x, nloc, nx); b.st[0] = nloc; b.st[1] = nx; }
        const unsigned old = xb_add(&bar[XB_XSUB(b.x)], 1u);
        const unsigned gen = old / nloc;
        if (old + 1u == (gen + 1u) * nloc) {
            __builtin_amdgcn_fence(__ATOMIC_RELEASE, "agent");
            asm volatile("s_waitcnt vmcnt(0)" ::: "memory");
            const unsigned og = xb_add(&bar[XB_TOP], 1u);
            const unsigned tg = og / nx;
            if (og + 1u == (tg + 1u) * nx) xb_add(&bar[XB_TOPGEN], 1u);
            else XB_SPIN(xb_ld(&bar[XB_TOPGEN]) == tg, bar);
            __builtin_amdgcn_fence(__ATOMIC_ACQUIRE, "agent");
            xb_add(&bar[XB_XGEN(b.x)], 1u);
            asm volatile("s_waitcnt vmcnt(0)" ::: "memory");
        } else {
            XB_SPIN(xb_ld(&bar[XB_XGEN(b.x)]) == gen, bar);
            __builtin_amdgcn_fence(__ATOMIC_ACQUIRE, "agent");
            asm volatile("s_waitcnt vmcnt(0)" ::: "memory");
        }
    }
    __syncthreads();
}

constexpr size_t WS_BAR = 512 * 1024;
constexpr size_t WS_CMX = 512 * 1024 + 16384;
constexpr int MISC_OFF = 131072 + 512;
struct Args { const float* in[18]; float* out; unsigned char* ws; int ph_lo, ph_hi; };
struct Ctx { int tid, lane, wave, G, gw, NGW, gwx; unsigned char* lds; LAS unsigned char* ldsl; };

__device__ __forceinline__ void transpose_item(const float* W, int ldw, int K, int nblk, bf16* WT, float* scr, int item, int lane) {
    const int kb = item / nblk, nb = item % nblk, k0 = 64 * kb, n0 = 32 * nb;
#pragma unroll 8
    for (int i = 0; i < 32; ++i) { const int kk = 2 * i + (lane >> 5); scr[kk * 33 + (lane & 31)] = W[(size_t)(k0 + kk) * ldw + n0 + (lane & 31)]; }
    WAVE_FENCE();
    const int c = lane & 7;
#pragma unroll
    for (int j = 0; j < 4; ++j) { const int n = (lane >> 3) + 8 * j; const float* s = scr + (8 * c) * 33 + n;
        uint4 o; o.x = pk2(s[0 * 33], s[1 * 33]); o.y = pk2(s[2 * 33], s[3 * 33]); o.z = pk2(s[4 * 33], s[5 * 33]); o.w = pk2(s[6 * 33], s[7 * 33]);
        *(uint4*)(WT + (size_t)(n0 + n) * K + k0 + 8 * c) = o; }
    WAVE_FENCE();
}
__device__ __forceinline__ void ph_prologue(const Ctx& c, const Args& a) {
    const float* x = a.in[0]; const float* w_in = a.in[1]; const float* b_ig = a.in[6]; const float* b_fg = a.in[7];
    bf16* WoutT = (bf16*)(a.ws + WS_WOUT); unsigned* xq8 = (unsigned*)(a.ws + WS_XB); float* sxa = (float*)(a.ws + WS_SXA);
    float* ipre = (float*)(a.ws + WS_GATE); float* logf = ipre + (size_t)T_ * 4;
    float* scr = (float*)(c.lds + c.wave * 8448); float* wgs = (float*)(c.lds + 69632);
    for (int i = c.tid; i < 8192; i += NTHREADS) wgs[i] = w_in[(size_t)(i >> 3) * INC + NPROJ + (i & 7)];
    constexpr int I_IN = 16 * 96, I_OUT = 16 * 32, I_Q = 16 * 64;
    unsigned* cmx = (unsigned*)(a.ws + WS_CMX); unsigned* ccnt = cmx + NPROJ + 2048;
    for (int it = c.gw; it < I_IN + I_Q; it += c.NGW) {
        const bool isq = it >= I_IN; const int r = isq ? it - I_IN : it, nblk = isq ? 64 : 96, ldw = isq ? 2048 : INC; const float* W = isq ? a.in[12] : w_in;
        const int kb = r / nblk, nb = r % nblk, k0 = 64 * kb, n0 = 32 * nb, cl = c.lane & 31, kh = c.lane >> 5; float am = 0.f;
#pragma unroll 8
        for (int i = 0; i < 32; ++i) am = fmaxf(am, fabsf(W[(size_t)(k0 + 2 * i + kh) * ldw + n0 + cl]));
        am = fmaxf(am, __shfl_xor(am, 32));
        unsigned prev = 0u;
        if (c.lane < 32) prev = atomicMax(cmx + (isq ? NPROJ : 0) + n0 + cl, __float_as_uint(am));
        asm volatile("s_waitcnt vmcnt(0)" : "+v"(prev) :: "memory");
        if (c.lane == 0) __hip_atomic_fetch_add(ccnt + (isq ? 96 : 0) + nb, 1u, __ATOMIC_RELAXED, __HIP_MEMORY_SCOPE_AGENT);
    }
    for (int it = c.gw; it < I_OUT; it += c.NGW) transpose_item(a.in[9], D_, D_, 32, WoutT, scr, it, c.lane);
    for (int it = c.gw; it < 64; it += c.NGW) {
        const int mat = it >> 5, h = (it >> 3) & 3, r = it & 7;
        transpose_item(a.in[4 + mat] + (size_t)h * 128 * 128, 128, 128, 4, (bf16*)(a.ws + WS_WMT) + (size_t)(mat * 4 + h) * 128 * 128, scr, r, c.lane);
    }
    { const float4* sk = (const float4*)a.in[13]; uint2* skb = (uint2*)(a.ws + WS_SK);
      for (int i = blockIdx.x * NTHREADS + c.tid; i < 8 * 2 * 128 * 128 / 4; i += c.G * NTHREADS) { const float4 v = sk[i]; uint2 o; o.x = pk2(v.x, v.y); o.y = pk2(v.z, v.w); skb[i] = o; } }
    for (int r0 = c.gw * 4; r0 < 2 * 16384; r0 += c.NGW * 4) {
      float4 vv[4][4];
#pragma unroll
      for (int rr = 0; rr < 4; ++rr) { const int r = r0 + rr; const float4* src = (const float4*)(a.in[14 + (r >> 14)] + (size_t)(r & 16383) * D_) + c.lane;
#pragma unroll
          for (int j = 0; j < 4; ++j) vv[rr][j] = src[64 * j]; }
#pragma unroll
      for (int rr = 0; rr < 4; ++rr) {
        const int r = r0 + rr, tb = r >> 14, e = r & 16383;
        float4 v[4]; float mx = 0.f;
#pragma unroll
        for (int j = 0; j < 4; ++j) { v[j] = vv[rr][j]; mx = fmaxf(mx, fmaxf(fmaxf(fabsf(v[j].x), fabsf(v[j].y)), fmaxf(fabsf(v[j].z), fabsf(v[j].w)))); }
        mx = fmaxf(wave_max(mx), 1e-30f);
        const float inv = 127.f / mx;
        if (c.lane == 0) ((float*)(a.ws + (tb ? WS_SCU : WS_SCD)))[e] = mx * (1.f / 127.f);
        unsigned* dst = (unsigned*)(a.ws + (tb ? WS_WU : WS_WD));
#pragma unroll
        for (int j = 0; j < 4; ++j) { const int p = (__float2int_rn(v[j].x * inv) & 0xff) | ((__float2int_rn(v[j].y * inv) & 0xff) << 8) | ((__float2int_rn(v[j].z * inv) & 0xff) << 16) | (__float2int_rn(v[j].w * inv) << 24);
            dst[(size_t)(2 * j + (c.lane >> 5)) * (16384 * 32) + (size_t)e * 32 + (c.lane & 31)] = (unsigned)p; }
      }
    }
    __syncthreads();
    for (int rowb = c.gw * 4; rowb < T_; rowb += c.NGW * 4) {
      float4 xx[4][4];
#pragma unroll
      for (int rr = 0; rr < 4; ++rr) { const float4* xr = (const float4*)(x + (size_t)(rowb + rr) * D_) + c.lane;
#pragma unroll
          for (int j = 0; j < 4; ++j) xx[rr][j] = xr[64 * j]; }
      float g[4][8];
#pragma unroll
      for (int rr = 0; rr < 4; ++rr)
#pragma unroll
          for (int i = 0; i < 8; ++i) g[rr][i] = 0.f;
#pragma unroll
      for (int j = 0; j < 4; ++j) {
          const int k = (64 * j + c.lane) * 4;
#pragma unroll
          for (int i = 0; i < 4; ++i) { const float4 w0 = *(const float4*)(wgs + (k + i) * 8), w1 = *(const float4*)(wgs + (k + i) * 8 + 4);
#pragma unroll
              for (int rr = 0; rr < 4; ++rr) { const float4 v = xx[rr][j]; const float xv = (i == 0) ? v.x : (i == 1) ? v.y : (i == 2) ? v.z : v.w;
                  g[rr][0] += xv * w0.x; g[rr][1] += xv * w0.y; g[rr][2] += xv * w0.z; g[rr][3] += xv * w0.w; g[rr][4] += xv * w1.x; g[rr][5] += xv * w1.y; g[rr][6] += xv * w1.z; g[rr][7] += xv * w1.w; } }
      }
#pragma unroll
      for (int rr = 0; rr < 4; ++rr) {
          float am = 0.f;
#pragma unroll
          for (int j = 0; j < 4; ++j) { const float4 v = xx[rr][j]; am = fmaxf(am, fmaxf(fmaxf(fabsf(v.x), fabsf(v.y)), fmaxf(fabsf(v.z), fabsf(v.w)))); }
          am = fmaxf(wave_max(am), 1e-30f); const float inv = 127.f / am;
          if (c.lane == 0) sxa[rowb + rr] = am * (1.f / 127.f);
#pragma unroll
          for (int j = 0; j < 4; ++j) { const float4 v = xx[rr][j];
              xq8[(size_t)(rowb + rr) * 256 + 64 * j + c.lane] = (unsigned)((__float2int_rn(v.x * inv) & 0xff) | ((__float2int_rn(v.y * inv) & 0xff) << 8) | ((__float2int_rn(v.z * inv) & 0xff) << 16) | (__float2int_rn(v.w * inv) << 24)); }
      }
#pragma unroll
      for (int rr = 0; rr < 4; ++rr) {
        const int row = rowb + rr;
#pragma unroll
        for (int i = 0; i < 8; ++i) g[rr][i] = wave_sum(g[rr][i]);
        if (c.lane < 8) {
            float gv = g[rr][0];
#pragma unroll
            for (int i = 1; i < 8; ++i) gv = (c.lane == i) ? g[rr][i] : gv;
            if (c.lane < 4) ipre[(size_t)row * 4 + c.lane] = gv + b_ig[c.lane];
            else { const float z = gv + b_fg[c.lane - 4]; logf[(size_t)row * 4 + c.lane - 4] = fminf(z, 0.f) - log1pf(expf(-fabsf(z))); }
        }
      }
    }
    for (int it = c.gw; it < I_IN + I_Q; it += c.NGW) {
        const bool isq = it >= I_IN; const int r = isq ? it - I_IN : it, nblk = isq ? 64 : 96, ldw = isq ? 2048 : INC; const float* W = isq ? a.in[12] : w_in;
        const int kb = r / nblk, nb = r % nblk, k0 = 64 * kb, n0 = 32 * nb, cl = c.lane & 31, kh = c.lane >> 5;
        { unsigned spins = 0; while (__hip_atomic_load(ccnt + (isq ? 96 : 0) + nb, __ATOMIC_RELAXED, __HIP_MEMORY_SCOPE_AGENT) < 16u && ++spins < (1u << 22)) __builtin_amdgcn_s_sleep(2); }
        const float am = fmaxf(__uint_as_float(__hip_atomic_load(cmx + (isq ? NPROJ : 0) + n0 + cl, __ATOMIC_RELAXED, __HIP_MEMORY_SCOPE_AGENT)), 1e-30f), inv = 127.f / am;
        if (kb == 0 && c.lane < 32) ((float*)(a.ws + (isq ? WS_SWQ : WS_SWN)))[n0 + cl] = am * (1.f / 127.f);
        unsigned char* W8 = a.ws + (isq ? WS_WQ : WS_WIN);
#pragma unroll 8
        for (int i = 0; i < 32; ++i) { const int kk = 2 * i + kh; scr[kk * 33 + cl] = W[(size_t)(k0 + kk) * ldw + n0 + cl] * inv; }
        WAVE_FENCE();
        const int c8 = c.lane & 7;
#pragma unroll
        for (int j = 0; j < 4; ++j) { const int n = (c.lane >> 3) + 8 * j; const float* sp = scr + (8 * c8) * 33 + n;
            uint2 o; o.x = (unsigned)((__float2int_rn(sp[0]) & 0xff) | ((__float2int_rn(sp[33]) & 0xff) << 8) | ((__float2int_rn(sp[66]) & 0xff) << 16) | (__float2int_rn(sp[99]) << 24));
            o.y = (unsigned)((__float2int_rn(sp[132]) & 0xff) | ((__float2int_rn(sp[165]) & 0xff) << 8) | ((__float2int_rn(sp[198]) & 0xff) << 16) | (__float2int_rn(sp[231]) << 24));
            *(uint2*)(W8 + (size_t)(n0 + n) * D_ + k0 + 8 * c8) = o; }
        WAVE_FENCE();
    }
}

typedef short s16x4 __attribute__((ext_vector_type(4)));
typedef unsigned u32x4 __attribute__((ext_vector_type(4)));
typedef unsigned u32x2 __attribute__((ext_vector_type(2)));
typedef float f32x4 __attribute__((ext_vector_type(4)));
typedef float f32x2_t __attribute__((ext_vector_type(2))); typedef __bf16 bf16x2_t __attribute__((ext_vector_type(2)));
__device__ __forceinline__ unsigned cvtpk(float lo, float hi) { const f32x2_t v = {lo, hi}; const bf16x2_t b = __builtin_convertvector(v, bf16x2_t); return __builtin_bit_cast(unsigned, b); }
__device__ __forceinline__ bf16x8 pack8(const f32x16& p, int b0) {
    union { unsigned u[4]; bf16x8 v; } x;
    x.u[0] = cvtpk(p[b0 + 0], p[b0 + 1]); x.u[1] = cvtpk(p[b0 + 2], p[b0 + 3]); x.u[2] = cvtpk(p[b0 + 4], p[b0 + 5]); x.u[3] = cvtpk(p[b0 + 6], p[b0 + 7]); return x.v;
}
__device__ __forceinline__ s16x4 tr_read(LAS unsigned char* p) { return __builtin_amdgcn_ds_read_tr16_b64_v4i16((LAS s16x4*)p); }
constexpr int AT_VP = 192, AT_OP = 144;
template <int T0> __device__ __forceinline__ void attn_task(LAS unsigned char* vl, const bf16* proj, unsigned char* ws, unsigned char* ob, int lane, int br, int b, int h, int d, int r, int m0) {
    const int col = lane & 31, hh = lane >> 5, i16 = lane & 15, grp = lane >> 4;
    const float CS = 0.125f * 1.4426950408889634f;
    const bf16* base = proj + (size_t)b * S_ * NPROJ + h * 64 + 8 * hh;
    const int tq = (m0 + col) * d + r;
    bf16x8 bq[4];
#pragma unroll
    for (int s = 0; s < 4; ++s) bq[s] = *(const bf16x8*)(base + (size_t)tq * NPROJ + C_QA + 16 * s);
    bf16x8 ka[5][4];
#pragma unroll
    for (int tau = T0; tau < 5; ++tau) { const bf16* kp = base + (size_t)((m0 - 128 + 32 * tau + col) * d + r) * NPROJ + C_KA;
#pragma unroll
        for (int s = 0; s < 4; ++s) ka[tau][s] = *(const bf16x8*)(kp + 16 * s); }
    f32x16 sc[5];
#pragma unroll
    for (int tau = T0; tau < 5; ++tau) {
        f32x16 acc;
#pragma unroll
        for (int i = 0; i < 16; ++i) acc[i] = 0.f;
#pragma unroll
        for (int s = 0; s < 4; ++s) acc = __builtin_amdgcn_mfma_f32_32x32x16_bf16(ka[tau][s], bq[s], acc, 0, 0, 0);
#pragma unroll
        for (int i = 0; i < 16; ++i) { const int cr = (i & 3) + 8 * (i >> 2) + 4 * hh;
            const bool ok = (tau == 0) ? (cr >= col) : ((tau == 4) ? (cr <= col) : true);
            sc[tau][i] = ok ? acc[i] * CS : -INFINITY; }
    }
    u32x4 vv[5][4];
#pragma unroll
    for (int tau = T0; tau < 5; ++tau)
#pragma unroll
        for (int q = 0; q < 4; ++q) { const int id = lane + 64 * q, row = id >> 3, ch = id & 7;
            vv[tau][q] = *(const u32x4*)(proj + (size_t)(b * S_ + (m0 - 128 + 32 * tau + row) * d + r) * NPROJ + C_VA + h * 64 + 8 * ch); }
    float mx = -INFINITY;
#pragma unroll
    for (int tau = T0; tau < 5; ++tau)
#pragma unroll
        for (int i = 0; i < 16; ++i) mx = fmaxf(mx, sc[tau][i]);
    mx = fmaxf(mx, __shfl_xor(mx, 32));
    float l = 0.f;
#pragma unroll
    for (int tau = T0; tau < 5; ++tau)
#pragma unroll
        for (int i = 0; i < 16; ++i) { const float p = __builtin_amdgcn_exp2f(sc[tau][i] - mx); sc[tau][i] = p; l += p; }
    l += __shfl_xor(l, 32);
    f32x16 o[2];
#pragma unroll
    for (int i = 0; i < 16; ++i) { o[0][i] = 0.f; o[1][i] = 0.f; }
#pragma unroll
    for (int tau = T0; tau < 5; ++tau) {
#pragma unroll
        for (int q = 0; q < 4; ++q) { const int id = lane + 64 * q, row = id >> 3, ch = id & 7; *(LAS u32x4*)(vl + row * AT_VP + ch * 16) = vv[tau][q]; }
        WAVE_FENCE();
        const bf16x8 pb0 = pack8(sc[tau], 0), pb1 = pack8(sc[tau], 8);
#pragma unroll
        for (int dt = 0; dt < 2; ++dt)
#pragma unroll
            for (int ks = 0; ks < 2; ++ks) {
                LAS unsigned char* ap = vl + (16 * ks + 4 * hh + (i16 >> 2)) * AT_VP + (32 * dt + 16 * (grp & 1) + 4 * (i16 & 3)) * 2;
                const s16x4 lo = tr_read(ap), hi = tr_read(ap + 8 * AT_VP);
                const bf16x8 av = {lo[0], lo[1], lo[2], lo[3], hi[0], hi[1], hi[2], hi[3]};
                o[dt] = __builtin_amdgcn_mfma_f32_32x32x16_bf16(av, ks ? pb1 : pb0, o[dt], 0, 0, 0);
            }
        WAVE_FENCE();
    }
#pragma unroll
    for (int dt = 0; dt < 2; ++dt)
#pragma unroll
        for (int q4 = 0; q4 < 4; ++q4) { u32x2 w; w.x = cvtpk(o[dt][4 * q4], o[dt][4 * q4 + 1]); w.y = cvtpk(o[dt][4 * q4 + 2], o[dt][4 * q4 + 3]);
            *(LAS u32x2*)(vl + col * AT_OP + (32 * dt + 8 * q4 + 4 * hh) * 2) = w; }
    WAVE_FENCE();
    bf16* pO = (br < 2) ? (bf16*)(ws + WS_PO01 + (size_t)br * 32 * MiB) : (bf16*)(ob + OUT_PO2);
#pragma unroll
    for (int q = 0; q < 4; ++q) { const int id = lane + 64 * q, row = id >> 3, ch = id & 7;
        const u32x4 v = *(LAS u32x4*)(vl + row * AT_OP + ch * 16);
        *(u32x4*)(pO + ((size_t)(b * S_ + (m0 + row) * d + r) * 8 + h) * 64 + 8 * ch) = v; }
    if (hh == 0) ((float2*)(ob + OUT_PML))[((size_t)br * T_ + b * S_ + tq) * 8 + h] = make_float2(mx, l);
    WAVE_FENCE();
}
__device__ __forceinline__ void ph_attn(const Ctx& c, const bf16* proj, unsigned char* ws, unsigned char* ob) {
    LAS unsigned char* vl = c.ldsl + c.wave * 6144;
    for (int task = c.gwx; task < 3 * B_ * 8 * 64; task += c.NGW) {
        const int bh = task / 192, rem = task % 192, br = rem >> 6, rq = rem & 63;
        const int dsh = 2 * br, d = 1 << dsh, nqsh = 6 - dsh;
        const int r = rq >> nqsh, m0 = (rq & ((1 << nqsh) - 1)) * 32, b = bh >> 3, h = bh & 7;
        switch (m0 >= 128 ? 0 : (128 - m0) >> 5) {
            case 0: attn_task<0>(vl, proj, ws, ob, c.lane, br, b, h, d, r, m0); break;
            case 1: attn_task<1>(vl, proj, ws, ob, c.lane, br, b, h, d, r, m0); break;
            case 2: attn_task<2>(vl, proj, ws, ob, c.lane, br, b, h, d, r, m0); break;
            case 3: attn_task<3>(vl, proj, ws, ob, c.lane, br, b, h, d, r, m0); break;
            default: attn_task<4>(vl, proj, ws, ob, c.lane, br, b, h, d, r, m0); break;
        }
    }
}
__device__ __forceinline__ void ph_attn_merge(const Ctx& c, const unsigned char* ws, const unsigned char* ob, bf16* concat) {
    const int lane = c.lane, h = lane >> 3, c8 = lane & 7;
    const float2* pML = (const float2*)(ob + OUT_PML);
    for (int t = c.gw; t < T_; t += c.NGW) {
        uint4 v[3]; float2 ml[3];
#pragma unroll
        for (int br = 0; br < 3; ++br) { const bf16* pO = (br < 2) ? (const bf16*)(ws + WS_PO01 + (size_t)br * 32 * MiB) : (const bf16*)(ob + OUT_PO2);
            v[br] = *(const uint4*)(pO + ((size_t)t * 8 + h) * 64 + 8 * c8); ml[br] = pML[((size_t)br * T_ + t) * 8 + h]; }
        const float M = fmaxf(ml[0].x, fmaxf(ml[1].x, ml[2].x));
        const float w0 = __builtin_amdgcn_exp2f(ml[0].x - M), w1 = __builtin_amdgcn_exp2f(ml[1].x - M), w2 = __builtin_amdgcn_exp2f(ml[2].x - M);
        const float inv = 1.f / (ml[0].y * w0 + ml[1].y * w1 + ml[2].y * w2);
        const unsigned* a0 = (const unsigned*)&v[0]; const unsigned* a1 = (const unsigned*)&v[1]; const unsigned* a2 = (const unsigned*)&v[2];
        uint4 o; unsigned* op = (unsigned*)&o;
#pragma unroll
        for (int e = 0; e < 4; ++e) {
            const float lo = (w0 * __uint_as_float(a0[e] << 16) + w1 * __uint_as_float(a1[e] << 16) + w2 * __uint_as_float(a2[e] << 16)) * inv;
            const float hi = (w0 * __uint_as_float(a0[e] & 0xffff0000u) + w1 * __uint_as_float(a1[e] & 0xffff0000u) + w2 * __uint_as_float(a2[e] & 0xffff0000u)) * inv;
            op[e] = pk2(lo, hi);
        }
        *(uint4*)(concat + (size_t)t * D_ + h * 64 + 8 * c8) = o;
    }
}
constexpr int ML_XP = 272, ML_VP = 320;
struct ChunkGates { float bc0, bc1, u0, u1, incl; };
__device__ __forceinline__ ChunkGates chunk_gates(const float* ipre, const float* logf, int bt0, int h, int lane) {
    const float lf0 = logf[(size_t)(bt0 + 2 * lane) * 4 + h], lf1 = logf[(size_t)(bt0 + 2 * lane + 1) * 4 + h];
    const float ip0 = ipre[(size_t)(bt0 + 2 * lane) * 4 + h], ip1 = ipre[(size_t)(bt0 + 2 * lane + 1) * 4 + h];
    float incl = lf0 + lf1;
#pragma unroll
    for (int o = 1; o < 64; o <<= 1) { const float n = __shfl_up(incl, o); if (lane >= o) incl += n; }
    ChunkGates g; g.incl = incl; g.bc1 = incl; g.bc0 = incl - lf1; g.u0 = ip0 - g.bc0; g.u1 = ip1 - g.bc1; return g;
}
__device__ __forceinline__ bf16x8 tr_pair(LAS unsigned char* p, int hi_off) { const s16x4 lo = tr_read(p), hi = tr_read(p + hi_off); return (bf16x8){lo[0], lo[1], lo[2], lo[3], hi[0], hi[1], hi[2], hi[3]}; }

__device__ __forceinline__ void ph_m1(const Ctx& c, const Args& a, const bf16* proj, const float* ipre, const float* logf, bf16* mq, bf16* mk, unsigned char* ob) {
    const float* conv_w = a.in[2]; const float* conv_b = a.in[3];
    const bf16* WmT = (const bf16*)(a.ws + WS_WMT);
    bf16* Dbuf = (bf16*)(ob + OUT_DBUF); float* nloc = (float*)(ob + OUT_NLOC); float* csc = (float*)(ob + OUT_CSC);
    LAS unsigned char* XC = c.ldsl; LAS unsigned char* KS = c.ldsl + 34816; LAS unsigned char* VS = c.ldsl + 75776;
    LAS float* wkt = (LAS float*)(c.ldsl + 116736); LAS float* nred = (LAS float*)(c.ldsl + 117760);
    const int tid = c.tid, lane = c.lane, wave = c.wave, col = lane & 31, hh = lane >> 5, i16 = lane & 15, grp = lane >> 4;
    for (int u = blockIdx.x; u < 1024; u += c.G) {
        const int bh = u >> 4, cc = u & 15, b = bh >> 2, h = bh & 3, bt0 = b * S_ + cc * 128;
        if (wave == 0) {
            const ChunkGates g = chunk_gates(ipre, logf, bt0, h, lane);
            const float umax = wave_max(fmaxf(g.u0, g.u1)), bL = __shfl(g.incl, 63);
            wkt[2 * lane] = expf(g.u0 - umax); wkt[2 * lane + 1] = expf(g.u1 - umax);
            if (lane == 0) { csc[2 * u] = bL; csc[2 * u + 1] = bL + umax; }
        }
        {
            const int ch = tid & 127, ts = (tid >> 7) * 32, cidx = h * 128 + ch;
            const float w0 = conv_w[cidx], w1 = conv_w[512 + cidx], w2 = conv_w[1024 + cidx], w3 = conv_w[1536 + cidx], cb = conv_b[cidx];
            const bf16* xp = proj + (size_t)bt0 * NPROJ + C_XM + cidx;
            const int tseq = cc * 128 + ts;
            float p3 = (tseq - 3 >= 0) ? bf2f(xp[(ptrdiff_t)(ts - 3) * NPROJ]) : 0.f, p2 = (tseq - 2 >= 0) ? bf2f(xp[(ptrdiff_t)(ts - 2) * NPROJ]) : 0.f, p1 = (tseq - 1 >= 0) ? bf2f(xp[(ptrdiff_t)(ts - 1) * NPROJ]) : 0.f;
            for (int i = 0; i < 32; ++i) {
                const float cur = bf2f(xp[(size_t)(ts + i) * NPROJ]);
                const float acc = cb + w0 * p3 + w1 * p2 + w2 * p1 + w3 * cur;
                *(LAS bf16*)(XC + (ts + i) * ML_XP + ch * 2) = (bf16)f2bf(acc / (1.f + expf(-acc)));
                p3 = p2; p2 = p1; p1 = cur;
            }
        }
#pragma unroll
        for (int q = 0; q < 4; ++q) { const int id = tid + 512 * q, row = id >> 4, ch = id & 15;
            *(LAS u32x4*)(VS + row * ML_VP + ch * 16) = *(const u32x4*)(proj + (size_t)(bt0 + row) * NPROJ + C_VM + h * 128 + 8 * ch); }
        __syncthreads();
        {
            const int tokt = wave & 3, mat = wave >> 2, tok = 32 * tokt + col;
            bf16x8 xf[8];
#pragma unroll
            for (int s2 = 0; s2 < 8; ++s2) xf[s2] = *(LAS bf16x8*)(XC + tok * ML_XP + (16 * s2 + 8 * hh) * 2);
            const float wkl = wkt[tok];
            const bf16* WT = WmT + (size_t)(mat * 4 + h) * 128 * 128 + (size_t)col * 128 + 8 * hh;
            bf16* og = (mat ? mk : mq) + (size_t)(bt0 + tok) * 512 + h * 128;
#pragma unroll
            for (int ft = 0; ft < 4; ++ft) {
                const bf16* wp = WT + (size_t)ft * 32 * 128; asm volatile("" : "+v"(wp));
                f32x16 acc;
#pragma unroll
                for (int i = 0; i < 16; ++i) acc[i] = 0.f;
#pragma unroll
                for (int s2 = 0; s2 < 8; ++s2) { const bf16x8 af = *(const bf16x8*)(wp + 16 * s2); acc = __builtin_amdgcn_mfma_f32_32x32x16_bf16(af, xf[s2], acc, 0, 0, 0); }
#pragma unroll
                for (int q4 = 0; q4 < 4; ++q4) {
                    const int f0 = 32 * ft + 8 * q4 + 4 * hh;
                    const float sc = mat ? 1.f : 0.08838834764831845f;
                    const float v0 = acc[4 * q4] * sc, v1 = acc[4 * q4 + 1] * sc, v2 = acc[4 * q4 + 2] * sc, v3 = acc[4 * q4 + 3] * sc;
                    u32x2 w; w.x = cvtpk(v0, v1); w.y = cvtpk(v2, v3);
                    *(u32x2*)(og + f0) = w;
                    if (mat) { u32x2 ws2; ws2.x = cvtpk(v0 * wkl, v1 * wkl); ws2.y = cvtpk(v2 * wkl, v3 * wkl); *(LAS u32x2*)(KS + tok * ML_VP + f0 * 2) = ws2; }
                }
            }
        }
        __syncthreads();
        {
            const int vt = wave >> 1, kt0 = 2 * (wave & 1);
            f32x16 d0, d1;
#pragma unroll
            for (int i = 0; i < 16; ++i) { d0[i] = 0.f; d1[i] = 0.f; }
            const int roff = (8 * hh + (i16 >> 2)) * ML_VP + (16 * (grp & 1) + 4 * (i16 & 3)) * 2;
#pragma unroll
            for (int st = 0; st < 8; ++st) {
                const bf16x8 av = tr_pair(VS + st * 16 * ML_VP + roff + vt * 64, 4 * ML_VP);
                const bf16x8 b0 = tr_pair(KS + st * 16 * ML_VP + roff + kt0 * 64, 4 * ML_VP), b1 = tr_pair(KS + st * 16 * ML_VP + roff + (kt0 + 1) * 64, 4 * ML_VP);
                d0 = __builtin_amdgcn_mfma_f32_32x32x16_bf16(av, b0, d0, 0, 0, 0); d1 = __builtin_amdgcn_mfma_f32_32x32x16_bf16(av, b1, d1, 0, 0, 0);
            }
            bf16* dp = Dbuf + (size_t)u * 16384 + (size_t)(32 * vt + 4 * hh) * 128 + 32 * kt0 + col;
#pragma unroll
            for (int i = 0; i < 16; ++i) { const int vr = (i & 3) + 8 * (i >> 2); dp[vr * 128] = (bf16)f2bf(d0[i]); dp[vr * 128 + 32] = (bf16)f2bf(d1[i]); }
            const int k = tid & 127, part = tid >> 7; float sacc = 0.f;
            for (int s2 = 0; s2 < 32; ++s2) sacc += bf2f(*(LAS bf16*)(KS + (32 * part + s2) * ML_VP + k * 2));
            nred[part * 128 + k] = sacc;
        }
        __syncthreads();
        if (tid < 128) nloc[(size_t)u * 128 + tid] = nred[tid] + nred[128 + tid] + nred[256 + tid] + nred[384 + tid];
        __syncthreads();
    }
}

__device__ __forceinline__ void ph_m3(const Ctx& c, const Args& a, const bf16* proj, const float* ipre, const float* logf, const bf16* mq, const bf16* mk, const unsigned char* ob, bf16* concat) {
    const float* mh_g = a.in[8];
    const bf16* Dbuf = (const bf16*)(ob + OUT_DBUF); const float* nloc = (const float*)(ob + OUT_NLOC); const float* csc = (const float*)(ob + OUT_CSC);
    LAS unsigned char* VS = c.ldsl; LAS unsigned char* CS = c.ldsl + 40960; LAS unsigned char* OST = CS; LAS unsigned char* KS = c.ldsl + 81920;
    LAS float* utab = (LAS float*)(c.ldsl + 75776); LAS float* mxt = utab + 128; LAS float* wit = utab + 256; LAS float* ednt = utab + 384; LAS float* nvec = utab + 512;
    LAS float* nrm = (LAS float*)(c.ldsl + 78848);
    LAS float* coef = (LAS float*)(c.ldsl + 116736);
    const int tid = c.tid, lane = c.lane, wave = c.wave, col = lane & 31, hh = lane >> 5, i16 = lane & 15, grp = lane >> 4;
    for (int ui = blockIdx.x; ui < 1024; ui += c.G) {
        const int bh = ui >> 4, cc = ((ui & 15) + 5 * (bh >> 4) + bh) & 15, b = bh >> 2, h = bh & 3, bt0 = b * S_ + cc * 128;
        float mc = 0.f;
        for (int c2 = 0; c2 < cc; ++c2) mc = fmaxf(csc[2 * (bh * 16 + c2)] + mc, csc[2 * (bh * 16 + c2) + 1]);
        const int tt = wave & 3, vh = wave >> 2, t = 32 * tt + col;
        bf16x8 bq[8];
        { const bf16* qp = mq + (size_t)(bt0 + t) * 512 + h * 128 + 8 * hh;
#pragma unroll
          for (int s2 = 0; s2 < 8; ++s2) bq[s2] = *(const bf16x8*)(qp + 16 * s2); }
        if (tid < 16) { float suf = 0.f; for (int c2 = cc - 1; c2 > tid; --c2) suf += csc[2 * (bh * 16 + c2)];
            coef[tid] = (tid < cc) ? expf(csc[2 * (bh * 16 + tid) + 1] + suf - mc) : 0.f; }
        if (wave == 1) {
            const ChunkGates g = chunk_gates(ipre, logf, bt0, h, lane);
            float incm = fmaxf(g.u0, g.u1);
#pragma unroll
            for (int o = 1; o < 64; o <<= 1) { const float n = __shfl_up(incm, o); if (lane >= o) incm = fmaxf(incm, n); }
            float exm = __shfl_up(incm, 1); if (lane == 0) exm = -INFINITY;
            const float M0 = fmaxf(mc, fmaxf(exm, g.u0)), M1 = fmaxf(mc, incm);
            utab[2 * lane] = g.u0; utab[2 * lane + 1] = g.u1; mxt[2 * lane] = M0; mxt[2 * lane + 1] = M1;
            wit[2 * lane] = expf(mc - M0); wit[2 * lane + 1] = expf(mc - M1); ednt[2 * lane] = expf(-(g.bc0 + M0)); ednt[2 * lane + 1] = expf(-(g.bc1 + M1));
        }
#pragma unroll
        for (int q = 0; q < 4; ++q) { const int id = tid + 512 * q, row = id >> 4, ch = id & 15;
            *(LAS u32x4*)(VS + row * ML_VP + ch * 16) = *(const u32x4*)(proj + (size_t)(bt0 + row) * NPROJ + C_VM + h * 128 + 8 * ch);
            *(LAS u32x4*)(KS + row * ML_XP + ch * 16) = *(const u32x4*)(mk + (size_t)(bt0 + row) * 512 + h * 128 + 8 * ch); }
        __syncthreads();
#pragma unroll
        for (int q = 0; q < 4; ++q) {
            const int id = tid + 512 * q, row = id >> 4, ch = id & 15;
            float acc[8] = {0.f, 0.f, 0.f, 0.f, 0.f, 0.f, 0.f, 0.f};
            for (int c2 = 0; c2 < cc; ++c2) {
                const float cf = coef[c2]; const u32x4 dv = *(const u32x4*)(Dbuf + (size_t)(bh * 16 + c2) * 16384 + row * 128 + 8 * ch);
                acc[0] += cf * __uint_as_float(dv.x << 16); acc[1] += cf * __uint_as_float(dv.x & 0xffff0000u); acc[2] += cf * __uint_as_float(dv.y << 16); acc[3] += cf * __uint_as_float(dv.y & 0xffff0000u);
                acc[4] += cf * __uint_as_float(dv.z << 16); acc[5] += cf * __uint_as_float(dv.z & 0xffff0000u); acc[6] += cf * __uint_as_float(dv.w << 16); acc[7] += cf * __uint_as_float(dv.w & 0xffff0000u);
            }
            u32x4 o; o.x = cvtpk(acc[0], acc[1]); o.y = cvtpk(acc[2], acc[3]); o.z = cvtpk(acc[4], acc[5]); o.w = cvtpk(acc[6], acc[7]);
            *(LAS u32x4*)(CS + row * ML_XP + ch * 16) = o;
        }
        if (tid < 128) { float nv = 0.f; for (int c2 = 0; c2 < cc; ++c2) nv += coef[c2] * nloc[(size_t)(bh * 16 + c2) * 128 + tid]; nvec[tid] = nv; }
        __syncthreads();
        const float Mt = mxt[t], wint = wit[t], edn = ednt[t];
        f32x16 acc[2];
#pragma unroll
        for (int vtl = 0; vtl < 2; ++vtl) {
#pragma unroll
            for (int i = 0; i < 16; ++i) acc[vtl][i] = 0.f;
#pragma unroll
            for (int s2 = 0; s2 < 8; ++s2) { const bf16x8 af = *(LAS bf16x8*)(CS + (64 * vh + 32 * vtl + col) * ML_XP + (16 * s2 + 8 * hh) * 2); acc[vtl] = __builtin_amdgcn_mfma_f32_32x32x16_bf16(af, bq[s2], acc[vtl], 0, 0, 0); }
#pragma unroll
            for (int i = 0; i < 16; ++i) acc[vtl][i] *= wint;
        }
        float qn = 0.f;
#pragma unroll
        for (int s2 = 0; s2 < 8; ++s2) {
            const f32x4 n0 = *(LAS f32x4*)(nvec + 16 * s2 + 8 * hh), n1 = *(LAS f32x4*)(nvec + 16 * s2 + 8 * hh + 4);
            const unsigned* qw = (const unsigned*)&bq[s2];
            qn += __uint_as_float(qw[0] << 16) * n0[0] + __uint_as_float(qw[0] & 0xffff0000u) * n0[1] + __uint_as_float(qw[1] << 16) * n0[2] + __uint_as_float(qw[1] & 0xffff0000u) * n0[3];
            qn += __uint_as_float(qw[2] << 16) * n1[0] + __uint_as_float(qw[2] & 0xffff0000u) * n1[1] + __uint_as_float(qw[3] << 16) * n1[2] + __uint_as_float(qw[3] & 0xffff0000u) * n1[3];
        }
        qn += __shfl_xor(qn, 32);
        float dsum = 0.f;
        for (int st = 0; st <= tt; ++st) {
            f32x16 sT;
#pragma unroll
            for (int i = 0; i < 16; ++i) sT[i] = 0.f;
#pragma unroll
            for (int s2 = 0; s2 < 8; ++s2) { const bf16x8 kf = *(LAS bf16x8*)(KS + (32 * st + col) * ML_XP + (16 * s2 + 8 * hh) * 2); sT = __builtin_amdgcn_mfma_f32_32x32x16_bf16(kf, bq[s2], sT, 0, 0, 0); }
            f32x16 p;
#pragma unroll
            for (int q4 = 0; q4 < 4; ++q4) {
                const f32x4 uu = *(LAS f32x4*)(utab + 32 * st + 8 * q4 + 4 * hh);
#pragma unroll
                for (int e = 0; e < 4; ++e) { const int cr = 8 * q4 + 4 * hh + e; const bool ok = (st < tt) || (cr <= col);
                    const float pv = ok ? expf(uu[e] - Mt) * sT[4 * q4 + e] : 0.f; p[4 * q4 + e] = pv; dsum += pv; }
            }
            const bf16x8 pb0 = pack8(p, 0), pb1 = pack8(p, 8);
#pragma unroll
            for (int vtl = 0; vtl < 2; ++vtl)
#pragma unroll
                for (int ks = 0; ks < 2; ++ks) {
                    const bf16x8 av = tr_pair(VS + (32 * st + 16 * ks + 4 * hh + (i16 >> 2)) * ML_VP + (64 * vh + 32 * vtl + 16 * (grp & 1) + 4 * (i16 & 3)) * 2, 8 * ML_VP);
                    acc[vtl] = __builtin_amdgcn_mfma_f32_32x32x16_bf16(av, ks ? pb1 : pb0, acc[vtl], 0, 0, 0);
                }
        }
        dsum += __shfl_xor(dsum, 32);
        const float den = wint * qn + dsum, inv = 1.f / fmaxf(fabsf(den), edn);
        float s1 = 0.f, s2q = 0.f;
#pragma unroll
        for (int vtl = 0; vtl < 2; ++vtl)
#pragma unroll
            for (int i = 0; i < 16; ++i) { const float hv = acc[vtl][i] * inv; acc[vtl][i] = hv; s1 += hv; s2q += hv * hv; }
        s1 += __shfl_xor(s1, 32); s2q += __shfl_xor(s2q, 32);
        if (hh == 0) { nrm[(vh * 128 + t) * 2] = s1; nrm[(vh * 128 + t) * 2 + 1] = s2q; }
        __syncthreads();
        s1 += nrm[((vh ^ 1) * 128 + t) * 2]; s2q += nrm[((vh ^ 1) * 128 + t) * 2 + 1];
        const float mu = s1 * (1.f / 128.f), var = fmaxf(s2q * (1.f / 128.f) - mu * mu, 0.f), rstd = 1.f / sqrtf(var + LN_EPS);
        const bf16* omp = proj + (size_t)(bt0 + t) * NPROJ + C_OM + h * 128;
#pragma unroll
        for (int vtl = 0; vtl < 2; ++vtl)
#pragma unroll
            for (int q4 = 0; q4 < 4; ++q4) {
                const int v0 = 64 * vh + 32 * vtl + 8 * q4 + 4 * hh;
                const u32x2 ow = *(const u32x2*)(omp + v0); const f32x4 gg = *(const f32x4*)(mh_g + h * 128 + v0);
                const float o0 = __uint_as_float(ow.x << 16), o1 = __uint_as_float(ow.x & 0xffff0000u), o2 = __uint_as_float(ow.y << 16), o3 = __uint_as_float(ow.y & 0xffff0000u);
                const float r0 = (acc[vtl][4 * q4] - mu) * rstd * gg[0] / (1.f + expf(-o0)), r1 = (acc[vtl][4 * q4 + 1] - mu) * rstd * gg[1] / (1.f + expf(-o1));
                const float r2 = (acc[vtl][4 * q4 + 2] - mu) * rstd * gg[2] / (1.f + expf(-o2)), r3 = (acc[vtl][4 * q4 + 3] - mu) * rstd * gg[3] / (1.f + expf(-o3));
                u32x2 w; w.x = cvtpk(r0, r1); w.y = cvtpk(r2, r3);
                *(LAS u32x2*)(OST + t * ML_XP + v0 * 2) = w;
            }
        __syncthreads();
#pragma unroll
        for (int q = 0; q < 4; ++q) { const int id = tid + 512 * q, row = id >> 4, ch = id & 15;
            *(u32x4*)(concat + (size_t)(bt0 + row) * D_ + 512 + h * 128 + 8 * ch) = *(LAS u32x4*)(OST + row * ML_XP + ch * 16); }
        __syncthreads();
    }
}
__device__ __forceinline__ void ph_ln1(const Ctx& c, const bf16* y1, const float* g, const float* bb, float2* st1, unsigned* xq, float* sx) {
    constexpr int RB = 4;
    for (int row0 = c.gw * RB; row0 < T_; row0 += c.NGW * RB) {
      uint2 yv[RB][4];
#pragma unroll
      for (int r = 0; r < RB; ++r) { const uint2* p = (const uint2*)(y1 + (size_t)(row0 + r) * D_) + c.lane;
#pragma unroll
          for (int j = 0; j < 4; ++j) yv[r][j] = p[64 * j]; }
#pragma unroll
      for (int r = 0; r < RB; ++r) {
        const int row = row0 + r; float4 v[4]; float s = 0.f;
#pragma unroll
        for (int j = 0; j < 4; ++j) { const uint2 w = yv[r][j]; v[j].x = __uint_as_float(w.x << 16); v[j].y = __uint_as_float(w.x & 0xffff0000u); v[j].z = __uint_as_float(w.y << 16); v[j].w = __uint_as_float(w.y & 0xffff0000u);
            s += v[j].x + v[j].y + v[j].z + v[j].w; }
        const float mu = wave_sum(s) * (1.f / D_); float q = 0.f;
#pragma unroll
        for (int j = 0; j < 4; ++j) { v[j].x -= mu; v[j].y -= mu; v[j].z -= mu; v[j].w -= mu; q += v[j].x * v[j].x + v[j].y * v[j].y + v[j].z * v[j].z + v[j].w * v[j].w; }
        const float rstd = 1.f / sqrtf(wave_sum(q) * (1.f / D_) + LN_EPS);
        float4 ov[4]; float am = 0.f;
#pragma unroll
        for (int j = 0; j < 4; ++j) { const int cc = (64 * j + c.lane) * 4; const float4 gg = *(const float4*)(g + cc), b4 = *(const float4*)(bb + cc);
            float4 o; o.x = v[j].x * rstd * gg.x + b4.x; o.y = v[j].y * rstd * gg.y + b4.y; o.z = v[j].z * rstd * gg.z + b4.z; o.w = v[j].w * rstd * gg.w + b4.w;
            ov[j] = o; am = fmaxf(am, fmaxf(fmaxf(fabsf(o.x), fabsf(o.y)), fmaxf(fabsf(o.z), fabsf(o.w)))); }
        am = fmaxf(wave_max(am), 1e-30f); const float inv = 127.f / am;
        if (c.lane == 0) { sx[row] = am * (1.f / 127.f); st1[row] = make_float2(mu, rstd); }
#pragma unroll
        for (int j = 0; j < 4; ++j) xq[(size_t)row * 256 + 64 * j + c.lane] = (unsigned)((__float2int_rn(ov[j].x * inv) & 0xff) | ((__float2int_rn(ov[j].y * inv) & 0xff) << 8) | ((__float2int_rn(ov[j].z * inv) & 0xff) << 16) | (__float2int_rn(ov[j].w * inv) << 24));
      }
    }
}
__device__ __forceinline__ int kmax(int a, int b) { int r; asm("v_max_f32 %0, %1, %2" : "=v"(r) : "v"(a), "v"(b)); return r; }
__device__ __forceinline__ int kmin(int a, int b) { int r; asm("v_min_f32 %0, %1, %2" : "=v"(r) : "v"(a), "v"(b)); return r; }
__device__ __forceinline__ void ced(int& a, int& b) { const int hi = kmax(a, b), lo = kmin(a, b); a = hi; b = lo; }
__device__ __forceinline__ void sort16_desc(int (&k)[16]) {
    ced(k[0], k[1]); ced(k[2], k[3]); ced(k[4], k[5]); ced(k[6], k[7]); ced(k[8], k[9]); ced(k[10], k[11]); ced(k[12], k[13]); ced(k[14], k[15]);
    ced(k[0], k[2]); ced(k[1], k[3]); ced(k[4], k[6]); ced(k[5], k[7]); ced(k[8], k[10]); ced(k[9], k[11]); ced(k[12], k[14]); ced(k[13], k[15]);
    ced(k[1], k[2]); ced(k[5], k[6]); ced(k[0], k[4]); ced(k[3], k[7]); ced(k[9], k[10]); ced(k[13], k[14]); ced(k[8], k[12]); ced(k[11], k[15]);
    ced(k[2], k[6]); ced(k[1], k[5]); ced(k[10], k[14]); ced(k[9], k[13]); ced(k[0], k[8]); ced(k[7], k[15]);
    ced(k[2], k[4]); ced(k[3], k[5]); ced(k[10], k[12]); ced(k[11], k[13]);
    ced(k[1], k[2]); ced(k[3], k[4]); ced(k[5], k[6]); ced(k[9], k[10]); ced(k[11], k[12]); ced(k[13], k[14]);
    ced(k[4], k[12]); ced(k[2], k[10]); ced(k[6], k[14]); ced(k[1], k[9]); ced(k[5], k[13]); ced(k[3], k[11]);
    ced(k[4], k[8]); ced(k[6], k[10]); ced(k[5], k[9]); ced(k[7], k[11]);
    ced(k[2], k[4]); ced(k[6], k[8]); ced(k[10], k[12]); ced(k[3], k[5]); ced(k[7], k[9]); ced(k[11], k[13]);
    ced(k[1], k[2]); ced(k[3], k[4]); ced(k[5], k[6]); ced(k[7], k[8]); ced(k[9], k[10]); ced(k[11], k[12]); ced(k[13], k[14]);
}
__device__ __forceinline__ void merge16_desc(int (&k)[16]) {
#pragma unroll
    for (int stride = 8; stride > 0; stride >>= 1)
#pragma unroll
        for (int i = 0; i < 16; ++i) { const int j = i ^ stride; if (j > i) ced(k[i], k[j]); }
}
__device__ __forceinline__ void top16_of(int (&a)[16], const int (&b)[16]) {
#pragma unroll
    for (int i = 0; i < 16; ++i) a[i] = kmax(a[i], b[15 - i]);
    merge16_desc(a);
}
__device__ __forceinline__ void top16_tile(const f32x16& acc, int kt, int hh, int (&top)[16]) {
    int g[16];
#pragma unroll
    for (int i = 0; i < 16; ++i) { const int idx = 32 * kt + (i & 3) + 8 * (i >> 2) + 4 * hh; g[i] = (__float_as_int(acc[i]) & ~127) | idx; }
    sort16_desc(g);
    if (kt == 0) {
#pragma unroll
        for (int i = 0; i < 16; ++i) top[i] = g[i];
    } else top16_of(top, g);
}
__device__ __forceinline__ void ph_route(const Ctx& c, const bf16* qry, const bf16* SK, unsigned* eidx, float* gate) {
    const int lane = c.lane, col = lane & 31, hh = lane >> 5;
    pg8::StaticOrder S; S.init(T_, 2048, c.G, (int)blockIdx.x); pg8::Unit u;
    for (int ui = 0; S.next(ui, u); ++ui) {
        const int h = u.pn, t0 = u.pm * 256 + 32 * c.wave;
        int top[2][16];
#pragma unroll
        for (int p = 0; p < 2; ++p) {
            bf16x8 bq[8];
            const bf16* qrow = qry + (size_t)(t0 + col) * 2048 + h * 256 + p * 128 + 8 * hh;
#pragma unroll
            for (int s = 0; s < 8; ++s) bq[s] = *(const bf16x8*)(qrow + 16 * s);
            const bf16* krow = SK + ((size_t)(h * 2 + p) * 128 + col) * 128 + 8 * hh;
#pragma unroll
            for (int kt = 0; kt < 4; ++kt) {
                f32x16 acc;
                const bf16* kr = krow + (size_t)kt * 32 * 128; asm volatile("" : "+v"(kr));
#pragma unroll
                for (int i = 0; i < 16; ++i) acc[i] = 0.f;
#pragma unroll
                for (int s = 0; s < 8; ++s) { const bf16x8 ka = *(const bf16x8*)(kr + 16 * s); acc = __builtin_amdgcn_mfma_f32_32x32x16_bf16(ka, bq[s], acc, 0, 0, 0); }
                top16_tile(acc, kt, hh, top[p]);
            }
            { int g[16];
#pragma unroll
              for (int i = 0; i < 16; ++i) g[i] = __shfl_xor(top[p][i], 32);
              top16_of(top[p], g); }
        }
        float f1[16], f2[16]; int i1[16], i2[16];
#pragma unroll
        for (int i = 0; i < 16; ++i) { f1[i] = __int_as_float(top[0][i]); i1[i] = (top[0][i] & 127) << 7; f2[i] = __int_as_float(top[1][i]); i2[i] = top[1][i] & 127; }
#define CK(a, b) ((__float_as_int(f1[a] + f2[b]) & ~0x3fff) | i1[a] | i2[b])
        int k0[16], k1[16], k2[16];
#pragma unroll
        for (int b = 0; b < 16; ++b) k0[b] = CK(0, b);
#pragma unroll
        for (int b = 0; b < 8; ++b) { k1[b] = CK(1, b); k1[8 + b] = CK(15 - b, 0); }
        merge16_desc(k1);
        k2[0] = CK(2, 0); k2[1] = CK(2, 1); k2[2] = CK(2, 2); k2[3] = CK(2, 3); k2[4] = CK(2, 4); k2[5] = CK(3, 0); k2[6] = CK(3, 1); k2[7] = CK(3, 2); k2[8] = CK(3, 3);
        k2[9] = CK(4, 0); k2[10] = CK(4, 1); k2[11] = CK(4, 2); k2[12] = CK(5, 0); k2[13] = CK(5, 1); k2[14] = CK(6, 0); k2[15] = CK(6, 1);
        sort16_desc(k2);
        k2[15] = kmax(k2[15], CK(7, 0)); k2[14] = kmax(k2[14], CK(7, 1));
        merge16_desc(k2);
        top16_of(k0, k1);
        top16_of(k0, k2);
#undef CK
        int p0[16];
#pragma unroll
        for (int i = 0; i < 16; ++i) { p0[i] = k0[i] & 0x3fff; k0[i] &= ~0x3fff; }
        float e[16]; float den = 0.f; const float m = __int_as_float(k0[0]);
#pragma unroll
        for (int i = 0; i < 16; ++i) { e[i] = __builtin_amdgcn_exp2f((__int_as_float(k0[i]) - m) * 1.4426950408889634f); den += e[i]; }
        const float inv = 1.f / den;
        float4 og[2];
        og[0].x = (hh ? e[8] : e[0]) * inv; og[0].y = (hh ? e[9] : e[1]) * inv; og[0].z = (hh ? e[10] : e[2]) * inv; og[0].w = (hh ? e[11] : e[3]) * inv;
        og[1].x = (hh ? e[12] : e[4]) * inv; og[1].y = (hh ? e[13] : e[5]) * inv; og[1].z = (hh ? e[14] : e[6]) * inv; og[1].w = (hh ? e[15] : e[7]) * inv;
        const size_t ob = (size_t)(t0 + col) * 128 + h * 16 + hh * 8;
        *(float4*)(gate + ob) = og[0]; *(float4*)(gate + ob + 4) = og[1];
        { uint4 o;
            o.x = (unsigned)(hh ? p0[4] : p0[0]) | ((unsigned)(hh ? p0[12] : p0[8]) << 16); o.y = (unsigned)(hh ? p0[5] : p0[1]) | ((unsigned)(hh ? p0[13] : p0[9]) << 16);
            o.z = (unsigned)(hh ? p0[6] : p0[2]) | ((unsigned)(hh ? p0[14] : p0[10]) << 16); o.w = (unsigned)(hh ? p0[7] : p0[3]) | ((unsigned)(hh ? p0[15] : p0[11]) << 16);
            *(uint4*)(eidx + ((size_t)(t0 + col) * 8 + h) * 8 + 4 * hh) = o; }
    }
}
typedef __bf16 v2bf __attribute__((ext_vector_type(2)));
__device__ __forceinline__ float dot2bf(unsigned a, unsigned b, float c) { return __builtin_amdgcn_fdot2_f32_bf16(__builtin_bit_cast(v2bf, a), __builtin_bit_cast(v2bf, b), c, false); }
template <int CTRL> __device__ __forceinline__ float dppf(float v) { return __int_as_float(__builtin_amdgcn_mov_dpp(__float_as_int(v), CTRL, 0xF, 0xF, true)); }
__device__ __forceinline__ float sum8(float v) { v += dppf<0xB1>(v); v += dppf<0x4E>(v); v += dppf<0x141>(v); return v; }
struct SliceMap { int j, sw, nsw; };
__device__ __forceinline__ SliceMap slice_map(const Ctx& c, unsigned* bar) {
    volatile LAS unsigned* st = (volatile LAS unsigned*)(c.ldsl + MISC_OFF);
    if (c.tid == 0) { unsigned even = (c.G % 8 == 0) ? 1u : 0u;
        for (unsigned j = 0; j < 16; ++j) { const unsigned cnt = xb_ld(&bar[XB_XCNT(j)]); if (cnt != (j < 8 ? (unsigned)c.G / 8u : 0u)) even = 0u; }
        st[4] = even; }
    __syncthreads();
    SliceMap m; m.nsw = c.G;
    if (st[4]) { m.j = (int)st[2]; m.sw = (int)st[3] * NWAVES + c.wave; }
    else { const bool sl = (c.G % 8) == 0; m.j = sl ? (int)(blockIdx.x & 7) : (c.gw & 7); m.sw = sl ? (int)(blockIdx.x >> 3) * NWAVES + c.wave : (c.gw >> 3); }
    m.j = __builtin_amdgcn_readfirstlane(m.j); m.sw = __builtin_amdgcn_readfirstlane(m.sw);
    __syncthreads();
    return m;
}
typedef float f32x2 __attribute__((ext_vector_type(2)));
template <int S> __device__ __forceinline__ unsigned bcast8(unsigned v, bool inq0) {
    const unsigned q = (unsigned)__builtin_amdgcn_mov_dpp((int)v, (S & 3) * 0x55, 0xF, 0xF, true);
    const unsigned r = (unsigned)__builtin_amdgcn_mov_dpp((int)q, 0x141, 0xF, 0xF, true);
    return ((S < 4) == inq0) ? q : r;
}
template <int HF> __device__ __forceinline__ void gather8(u32x4 (&w)[8], const unsigned char* wslice, unsigned moff, unsigned idw, bool inq0) {
#define G8ROW(R) { const unsigned b = bcast8<R>(idw, inq0); const unsigned id = HF ? (b >> 16) : (b & 0xffffu); w[R] = *(const u32x4*)(wslice + ((id << 7) + moff)); }
    G8ROW(0) G8ROW(1) G8ROW(2) G8ROW(3) G8ROW(4) G8ROW(5) G8ROW(6) G8ROW(7)
#undef G8ROW
}
template <int CTRL> __device__ __forceinline__ int dppi(int v) { return __builtin_amdgcn_mov_dpp(v, CTRL, 0xF, 0xF, true); }
__device__ __forceinline__ int g1_half(const u32x4 (&w)[8], const u32x4 xq, int m) {
    int d[8];
#pragma unroll
    for (int i = 0; i < 8; ++i) {
        int v = __builtin_amdgcn_sdot4((int)w[i].x, (int)xq.x, 0, false); v = __builtin_amdgcn_sdot4((int)w[i].y, (int)xq.y, v, false);
        v = __builtin_amdgcn_sdot4((int)w[i].z, (int)xq.z, v, false); d[i] = __builtin_amdgcn_sdot4((int)w[i].w, (int)xq.w, v, false);
    }
    const bool lo = m < 4, b1 = (m & 2) != 0, b0 = (m & 1) != 0;
    int e[4], f[2];
#pragma unroll
    for (int i = 0; i < 4; ++i) e[i] = (lo ? d[i] : d[i + 4]) + dppi<0x141>(lo ? d[i + 4] : d[i]);
#pragma unroll
    for (int i = 0; i < 2; ++i) f[i] = (b1 ? e[i + 2] : e[i]) + dppi<0x4E>(b1 ? e[i] : e[i + 2]);
    return (b0 ? f[1] : f[0]) + dppi<0xB1>(b0 ? f[0] : f[1]);
}
#define TOK(i) (t0 + (i) * ns)
#define IDX(t) (*(const unsigned*)((const unsigned char*)(eidx + (size_t)(t) * 64) + loff))
__device__ __forceinline__ void ph_g1(const Ctx& c, unsigned* bar, const unsigned char* xq, const float* sx, const unsigned char* Wd, const unsigned* eidx, bf16* apart) {
    const int lane = c.lane, g = lane >> 3, m = lane & 7; const bool inq0 = m < 4; const SliceMap sm = slice_map(c, bar);
    const int j = sm.j, ns = sm.nsw, t0 = sm.sw;
    const unsigned char* wsl = Wd + (size_t)j * (16384 * 128); const unsigned moff = 16u * m, loff = 4u * lane, soff = 2u * (16 * g + m);
    const unsigned char* xs = xq + 128 * j; bf16* as_ = apart + (size_t)j * T_ * 128;
#define XLD(t) (*(const u32x4*)(xs + (size_t)(t) * D_ + moff))
#define AST(t, o0, o1) do { const float sc_ = sx[t]; unsigned char* ap_ = (unsigned char*)(as_ + (size_t)(t) * 128) + soff; *(bf16*)ap_ = (bf16)f2bf((float)(o0) * sc_); *(bf16*)(ap_ + 16) = (bf16)f2bf((float)(o1) * sc_); } while (0)
    u32x4 W0[8], W1[8], W2[8], W3[8]; unsigned n1A = 0, n1B = 0, n2A = 0, n2B = 0; u32x4 xpA, xpB, xnA, xnB;
    if (TOK(0) < T_) { n2A = IDX(TOK(0)); xpA = XLD(TOK(0)); }
    if (TOK(1) < T_) { n2B = IDX(TOK(1)); xpB = XLD(TOK(1)); }
    if (TOK(0) < T_) { gather8<0>(W0, wsl, moff, n2A, inq0); gather8<1>(W1, wsl, moff, n2A, inq0); }
    if (TOK(1) < T_) { gather8<0>(W2, wsl, moff, n2B, inq0); gather8<1>(W3, wsl, moff, n2B, inq0); }
    if (TOK(2) < T_) n1A = IDX(TOK(2));
    if (TOK(3) < T_) n1B = IDX(TOK(3));
    const int NT = (T_ - t0 + ns - 1) / ns;
    int i = 0;
    for (; i + 5 < NT; i += 2) {
        const int tA = TOK(i), tB = TOK(i + 1), tA1 = TOK(i + 2), tB1 = TOK(i + 3), tA2 = TOK(i + 4), tB2 = TOK(i + 5);
        n2A = IDX(tA2); n2B = IDX(tB2); xnA = XLD(tA1); xnB = XLD(tB1);
        { const int o0 = g1_half(W0, xpA, m); gather8<0>(W0, wsl, moff, n1A, inq0);
          const int o1 = g1_half(W1, xpA, m); gather8<1>(W1, wsl, moff, n1A, inq0);
          AST(tA, o0, o1); }
        { const int o0 = g1_half(W2, xpB, m); gather8<0>(W2, wsl, moff, n1B, inq0);
          const int o1 = g1_half(W3, xpB, m); gather8<1>(W3, wsl, moff, n1B, inq0);
          AST(tB, o0, o1); }
        n1A = n2A; n1B = n2B; xpA = xnA; xpB = xnB;
    }
    for (; i < NT; i += 2) {
        const int tA = TOK(i), tB = TOK(i + 1), tA1 = TOK(i + 2), tB1 = TOK(i + 3), tA2 = TOK(i + 4), tB2 = TOK(i + 5);
        if (tA2 < T_) n2A = IDX(tA2);
        if (tB2 < T_) n2B = IDX(tB2);
        if (tA1 < T_) xnA = XLD(tA1);
        if (tB1 < T_) xnB = XLD(tB1);
        { const int o0 = g1_half(W0, xpA, m); if (tA1 < T_) gather8<0>(W0, wsl, moff, n1A, inq0);
          const int o1 = g1_half(W1, xpA, m); if (tA1 < T_) gather8<1>(W1, wsl, moff, n1A, inq0);
          AST(tA, o0, o1); }
        if (tB < T_) {
          const int o0 = g1_half(W2, xpB, m); if (tB1 < T_) gather8<0>(W2, wsl, moff, n1B, inq0);
          const int o1 = g1_half(W3, xpB, m); if (tB1 < T_) gather8<1>(W3, wsl, moff, n1B, inq0);
          AST(tB, o0, o1); }
        n1A = n2A; n1B = n2B; xpA = xnA; xpB = xnB;
    }
#undef XLD
#undef AST
}
__device__ __forceinline__ void ph_afin(const Ctx& c, const bf16* apart, const float* gate, const unsigned* eidx, const float* scd, const float* scu, unsigned char* aq, float* sa) {
    for (int it = blockIdx.x * NTHREADS + c.tid; it < T_ * 16; it += c.G * NTHREADS) {
        const int t = it >> 4, g = (it >> 1) & 7, m0 = (it & 1) * 4; const size_t k0 = (size_t)t * 128 + 16 * g + m0;
        float4 sl = {0.f, 0.f, 0.f, 0.f}, sh = {0.f, 0.f, 0.f, 0.f};
#pragma unroll
        for (int j = 0; j < 8; ++j) { const uint2 a0 = *(const uint2*)(apart + (size_t)j * T_ * 128 + k0), a1 = *(const uint2*)(apart + (size_t)j * T_ * 128 + k0 + 8);
            sl.x += __uint_as_float(a0.x << 16); sl.y += __uint_as_float(a0.x & 0xffff0000u); sl.z += __uint_as_float(a0.y << 16); sl.w += __uint_as_float(a0.y & 0xffff0000u);
            sh.x += __uint_as_float(a1.x << 16); sh.y += __uint_as_float(a1.x & 0xffff0000u); sh.z += __uint_as_float(a1.y << 16); sh.w += __uint_as_float(a1.y & 0xffff0000u); }
        const float4 gl = *(const float4*)(gate + k0), gh = *(const float4*)(gate + k0 + 8);
        const uint4 ep = *(const uint4*)(eidx + ((size_t)t * 8 + g) * 8 + m0);
        const unsigned ew[4] = {ep.x, ep.y, ep.z, ep.w}; const float lo[4] = {sl.x, sl.y, sl.z, sl.w}, hi[4] = {sh.x, sh.y, sh.z, sh.w}, gl4[4] = {gl.x, gl.y, gl.z, gl.w}, gh4[4] = {gh.x, gh.y, gh.z, gh.w};
        float al[4], ah[4]; float am = 0.f;
#pragma unroll
        for (int q = 0; q < 4; ++q) { const int e0 = ew[q] & 0xffff, e1 = ew[q] >> 16;
            const float u0 = lo[q] * scd[e0], u1 = hi[q] * scd[e1];
            al[q] = 0.5f * u0 * (1.f + erff(u0 * 0.7071067811865476f)) * gl4[q] * scu[e0]; ah[q] = 0.5f * u1 * (1.f + erff(u1 * 0.7071067811865476f)) * gh4[q] * scu[e1];
            am = fmaxf(am, fmaxf(fabsf(al[q]), fabsf(ah[q]))); }
        am = fmaxf(am, dppf<0xB1>(am)); am = fmaxf(am, dppf<0x4E>(am)); am = fmaxf(am, dppf<0x141>(am)); am = fmaxf(am, dppf<0x140>(am));
        am = fmaxf(am, 1e-30f); const float inv = 127.f / am;
        const unsigned pl = (unsigned)((__float2int_rn(al[0] * inv) & 0xff) | ((__float2int_rn(al[1] * inv) & 0xff) << 8) | ((__float2int_rn(al[2] * inv) & 0xff) << 16) | (__float2int_rn(al[3] * inv) << 24));
        const unsigned ph = (unsigned)((__float2int_rn(ah[0] * inv) & 0xff) | ((__float2int_rn(ah[1] * inv) & 0xff) << 8) | ((__float2int_rn(ah[2] * inv) & 0xff) << 16) | (__float2int_rn(ah[3] * inv) << 24));
        *(unsigned*)(aq + k0) = pl; *(unsigned*)(aq + k0 + 8) = ph;
        if ((it & 15) == 0) sa[t] = am * (1.f / 127.f);
    }
}
template <int R0> __device__ __forceinline__ void g2_set(int (&acc)[16], const u32x4 (&w)[8], unsigned ap) {
    const unsigned r0[4] = {w[R0].x, w[R0].y, w[R0].z, w[R0].w}, r1[4] = {w[R0 + 1].x, w[R0 + 1].y, w[R0 + 1].z, w[R0 + 1].w};
    const unsigned r2[4] = {w[R0 + 2].x, w[R0 + 2].y, w[R0 + 2].z, w[R0 + 2].w}, r3[4] = {w[R0 + 3].x, w[R0 + 3].y, w[R0 + 3].z, w[R0 + 3].w};
#pragma unroll
    for (int cq = 0; cq < 4; ++cq) {
        const unsigned t0 = __builtin_amdgcn_perm(r1[cq], r0[cq], 0x05010400u), t1 = __builtin_amdgcn_perm(r1[cq], r0[cq], 0x07030602u);
        const unsigned t2 = __builtin_amdgcn_perm(r3[cq], r2[cq], 0x05010400u), t3 = __builtin_amdgcn_perm(r3[cq], r2[cq], 0x07030602u);
        const unsigned o0 = __builtin_amdgcn_perm(t2, t0, 0x05040100u), o1 = __builtin_amdgcn_perm(t2, t0, 0x07060302u), o2 = __builtin_amdgcn_perm(t3, t1, 0x05040100u), o3 = __builtin_amdgcn_perm(t3, t1, 0x07060302u);
        acc[4 * cq + 0] = __builtin_amdgcn_sdot4((int)o0, (int)ap, acc[4 * cq + 0], false); acc[4 * cq + 1] = __builtin_amdgcn_sdot4((int)o1, (int)ap, acc[4 * cq + 1], false);
        acc[4 * cq + 2] = __builtin_amdgcn_sdot4((int)o2, (int)ap, acc[4 * cq + 2], false); acc[4 * cq + 3] = __builtin_amdgcn_sdot4((int)o3, (int)ap, acc[4 * cq + 3], false);
    }
}
template <int HF> __device__ __forceinline__ void g2_half(int (&acc)[16], const u32x4 (&w)[8], unsigned aw, bool inq0) {
    g2_set<0>(acc, w, bcast8<2 * HF>(aw, inq0)); g2_set<4>(acc, w, bcast8<2 * HF + 1>(aw, inq0));
}
__device__ __forceinline__ void g2_store(int (&acc)[16], int lane, float sa, bf16* fp) {
    int v8[8], v4[4];
#pragma unroll
    for (int i = 0; i < 8; ++i) { const auto r = __builtin_amdgcn_permlane32_swap((unsigned)acc[i], (unsigned)acc[i + 8], false, false); v8[i] = (int)r[0] + (int)r[1]; }
#pragma unroll
    for (int i = 0; i < 4; ++i) { const auto r = __builtin_amdgcn_permlane16_swap((unsigned)v8[i], (unsigned)v8[i + 4], false, false); v4[i] = (int)r[0] + (int)r[1]; }
    const bool up = (lane & 8) != 0;
    const int k0 = up ? v4[2] : v4[0], k1 = up ? v4[3] : v4[1], s0 = up ? v4[0] : v4[2], s1 = up ? v4[1] : v4[3];
    const int f0 = k0 + dppi<0x128>(s0), f1 = k1 + dppi<0x128>(s1);
    const int feat = ((lane >> 5) & 1) * 8 + ((lane >> 4) & 1) * 4 + ((lane >> 3) & 1) * 2;
    *(unsigned*)(fp + feat) = cvtpk((float)f0 * sa, (float)f1 * sa);
}
__device__ __forceinline__ void ph_g2(const Ctx& c, unsigned* bar, const unsigned char* Wu, const unsigned* eidx, const unsigned char* aq, const float* sa, bf16* ffn) {
    const int lane = c.lane, g = lane >> 3, m = lane & 7; const bool inq0 = m < 4; const SliceMap sm = slice_map(c, bar);
    const int j = sm.j, ns = sm.nsw, t0 = sm.sw;
    const unsigned char* wsl = Wu + (size_t)j * (16384 * 128); const unsigned moff = 16u * m, loff = 4u * lane, aoff = 16u * g + 4u * (m & 3), foff = 32u * m;
    bf16* fs = ffn + 128 * j;
#define ALD(t) (*(const unsigned*)(aq + (size_t)(t) * 128 + aoff))
#define FST(t, acc) g2_store(acc, lane, sa[t], (bf16*)((unsigned char*)(fs + (size_t)(t) * D_) + foff))
    u32x4 W0[8], W1[8], W2[8], W3[8]; unsigned n1A = 0, n1B = 0, n2A = 0, n2B = 0, apA = 0, apB = 0, anA = 0, anB = 0;
    if (TOK(0) < T_) { n2A = IDX(TOK(0)); apA = ALD(TOK(0)); }
    if (TOK(1) < T_) { n2B = IDX(TOK(1)); apB = ALD(TOK(1)); }
    if (TOK(0) < T_) { gather8<0>(W0, wsl, moff, n2A, inq0); gather8<1>(W1, wsl, moff, n2A, inq0); }
    if (TOK(1) < T_) { gather8<0>(W2, wsl, moff, n2B, inq0); gather8<1>(W3, wsl, moff, n2B, inq0); }
    if (TOK(2) < T_) n1A = IDX(TOK(2));
    if (TOK(3) < T_) n1B = IDX(TOK(3));
    const int NT = (T_ - t0 + ns - 1) / ns;
    int i = 0;
    for (; i + 5 < NT; i += 2) {
        const int tA = TOK(i), tB = TOK(i + 1), tA1 = TOK(i + 2), tB1 = TOK(i + 3), tA2 = TOK(i + 4), tB2 = TOK(i + 5);
        n2A = IDX(tA2); n2B = IDX(tB2); anA = ALD(tA1); anB = ALD(tB1);
        { int acc[16];
#pragma unroll
          for (int r = 0; r < 16; ++r) acc[r] = 0;
          g2_half<0>(acc, W0, apA, inq0); gather8<0>(W0, wsl, moff, n1A, inq0);
          g2_half<1>(acc, W1, apA, inq0); gather8<1>(W1, wsl, moff, n1A, inq0);
          FST(tA, acc); }
        { int acc[16];
#pragma unroll
          for (int r = 0; r < 16; ++r) acc[r] = 0;
          g2_half<0>(acc, W2, apB, inq0); gather8<0>(W2, wsl, moff, n1B, inq0);
          g2_half<1>(acc, W3, apB, inq0); gather8<1>(W3, wsl, moff, n1B, inq0);
          FST(tB, acc); }
        n1A = n2A; n1B = n2B; apA = anA; apB = anB;
    }
    for (; i < NT; i += 2) {
        const int tA = TOK(i), tB = TOK(i + 1), tA1 = TOK(i + 2), tB1 = TOK(i + 3), tA2 = TOK(i + 4), tB2 = TOK(i + 5);
        if (tA2 < T_) n2A = IDX(tA2);
        if (tB2 < T_) n2B = IDX(tB2);
        if (tA1 < T_) anA = ALD(tA1);
        if (tB1 < T_) anB = ALD(tB1);
        { int acc[16];
#pragma unroll
          for (int r = 0; r < 16; ++r) acc[r] = 0;
          g2_half<0>(acc, W0, apA, inq0); if (tA1 < T_) gather8<0>(W0, wsl, moff, n1A, inq0);
          g2_half<1>(acc, W1, apA, inq0); if (tA1 < T_) gather8<1>(W1, wsl, moff, n1A, inq0);
          FST(tA, acc); }
        if (tB < T_) { int acc[16];
#pragma unroll
          for (int r = 0; r < 16; ++r) acc[r] = 0;
          g2_half<0>(acc, W2, apB, inq0); if (tB1 < T_) gather8<0>(W2, wsl, moff, n1B, inq0);
          g2_half<1>(acc, W3, apB, inq0); if (tB1 < T_) gather8<1>(W3, wsl, moff, n1B, inq0);
          FST(tB, acc); }
        n1A = n2A; n1B = n2B; apA = anA; apB = anB;
    }
#undef ALD
#undef FST
}
#undef IDX
#undef TOK
__device__ __forceinline__ void ph_ln2(const Ctx& c, const bf16* hb  , const float2* st1, const float* g1, const float* b1, const bf16* ffn, float* out, const float* g, const float* bb) {
    constexpr int RB = 4;
    for (int row0 = c.gw * RB; row0 < T_; row0 += c.NGW * RB) {
        uint2 hv[RB][4], fv[RB][4];
#pragma unroll
        for (int r = 0; r < RB; ++r) { const uint2* hp = (const uint2*)(hb + (size_t)(row0 + r) * D_) + c.lane; const uint2* fp = (const uint2*)(ffn + (size_t)(row0 + r) * D_) + c.lane;
#pragma unroll
            for (int j = 0; j < 4; ++j) { hv[r][j] = hp[64 * j]; fv[r][j] = fp[64 * j]; } }
        float4 g1v[4], b1v[4];
#pragma unroll
        for (int j = 0; j < 4; ++j) { const int cc = (64 * j + c.lane) * 4; g1v[j] = *(const float4*)(g1 + cc); b1v[j] = *(const float4*)(b1 + cc);
            g1v[j].x *= ALPHA; g1v[j].y *= ALPHA; g1v[j].z *= ALPHA; g1v[j].w *= ALPHA; b1v[j].x *= ALPHA; b1v[j].y *= ALPHA; b1v[j].z *= ALPHA; b1v[j].w *= ALPHA; }
#pragma unroll
        for (int r = 0; r < RB; ++r) {
            float4 v[4]; float s = 0.f; const float2 ms = st1[row0 + r];
#pragma unroll
            for (int j = 0; j < 4; ++j) { const uint2 h = hv[r][j], f = fv[r][j];
                v[j].x = (__uint_as_float(h.x << 16) - ms.x) * ms.y * g1v[j].x + b1v[j].x + __uint_as_float(f.x << 16); v[j].y = (__uint_as_float(h.x & 0xffff0000u) - ms.x) * ms.y * g1v[j].y + b1v[j].y + __uint_as_float(f.x & 0xffff0000u);
                v[j].z = (__uint_as_float(h.y << 16) - ms.x) * ms.y * g1v[j].z + b1v[j].z + __uint_as_float(f.y << 16); v[j].w = (__uint_as_float(h.y & 0xffff0000u) - ms.x) * ms.y * g1v[j].w + b1v[j].w + __uint_as_float(f.y & 0xffff0000u);
                s += v[j].x + v[j].y + v[j].z + v[j].w; }
            const float mu = wave_sum(s) * (1.f / D_); float q = 0.f;
#pragma unroll
            for (int j = 0; j < 4; ++j) { v[j].x -= mu; v[j].y -= mu; v[j].z -= mu; v[j].w -= mu; q += v[j].x * v[j].x + v[j].y * v[j].y + v[j].z * v[j].z + v[j].w * v[j].w; }
            const float rstd = 1.f / sqrtf(wave_sum(q) * (1.f / D_) + LN_EPS);
            float4* op = (float4*)(out + (size_t)(row0 + r) * D_) + c.lane;
#pragma unroll
            for (int j = 0; j < 4; ++j) { const int cc = (64 * j + c.lane) * 4; const float4 gg = *(const float4*)(g + cc), b4 = *(const float4*)(bb + cc);
                float4 o; o.x = v[j].x * rstd * gg.x + b4.x; o.y = v[j].y * rstd * gg.y + b4.y; o.z = v[j].z * rstd * gg.z + b4.z; o.w = v[j].w * rstd * gg.w + b4.w;
                __builtin_nontemporal_store(o.x, &op[64 * j].x); __builtin_nontemporal_store(o.y, &op[64 * j].y); __builtin_nontemporal_store(o.z, &op[64 * j].z); __builtin_nontemporal_store(o.w, &op[64 * j].w); }
        }
    }
}
constexpr int NPH = 12;
__global__ void __launch_bounds__(NTHREADS, 2) mega(Args a) {
    extern __shared__ __attribute__((aligned(16))) unsigned char lds[];
    Ctx c; c.tid = threadIdx.x; c.lane = c.tid & 63; c.wave = __builtin_amdgcn_readfirstlane(c.tid >> 6); c.G = gridDim.x; c.gw = blockIdx.x * NWAVES + c.wave; c.NGW = c.G * NWAVES; c.lds = lds; c.ldsl = (LAS unsigned char*)lds;
    { const int bx = blockIdx.x; const int vcu = (c.G % 8 == 0) ? (bx % 8) * (c.G / 8) + bx / 8 : bx; c.gwx = vcu * NWAVES + c.wave; }
    unsigned char* ws = a.ws;
#define WoutT ((bf16*)(ws + WS_WOUT))
#define ipre ((float*)(ws + WS_GATE))
#define logf ((float*)(ws + WS_GATE) + (size_t)T_ * 4)
#define proj ((bf16*)(ws + WS_PROJ))
#define qry ((bf16*)(ws + WS_QRY))
#define mq ((bf16*)(ws + WS_MQ))
#define mk ((bf16*)(ws + WS_MK))
#define concat ((bf16*)(ws + WS_CONCAT))
#define xb ((bf16*)(ws + WS_XB))
    const int lo = a.ph_lo, hi = a.ph_hi;
#define IN(k) (lo <= (k) && (k) < hi)
    if (c.tid < 8) ((LAS unsigned*)(c.ldsl + MISC_OFF))[c.tid] = 0u;
    __syncthreads();
    XcdBarrier xbar; xbar.bar = (unsigned*)(ws + WS_BAR); xbar.x = xb_xcc_id(); xbar.st = (volatile LAS unsigned*)(c.ldsl + MISC_OFF);
    if (c.tid == 0) { const unsigned rank = xb_add(&xbar.bar[XB_XCNT(xbar.x)], 1u); xbar.st[2] = xbar.x; xbar.st[3] = rank; }
#define SEAM(k) do { if (IN(k) && IN((k) + 1)) xcd_barrier(xbar); } while (0)
#ifndef REP_PHASE
#define REP_PHASE -1
#endif
#define PH(id, ...) do { __VA_ARGS__; if (REP_PHASE == (id)) { xcd_barrier(xbar); __VA_ARGS__; } } while (0)
    if (IN(0)) { PH(0, { ph_prologue(c, a); }); } SEAM(0);
    if (IN(1)) { PH(1, { pg8::Gemm g{(const pg8::bf16_t*)(ws + WS_XB), (const pg8::bf16_t*)(ws + WS_WIN), T_, NPROJ, D_ / 2}; pg8::StaticOrder S; S.init(T_, NPROJ, c.G, (int)blockIdx.x);
        pg8::EpiI8Bf16 E{proj, NPROJ, (const float*)(ws + WS_SXA), (const float*)(ws + WS_SWN)};
        pg8::gemm_phase<pg8::EpiI8Bf16, pg8::StaticOrder, true, true>((PG8_LAS unsigned char*)lds, g, S, E); }); } SEAM(1);
    if (IN(2)) { PH(20, { ph_m1(c, a, proj, ipre, logf, mq, mk, (unsigned char*)a.out); __syncthreads(); }); PH(21, { ph_attn(c, proj, ws, (unsigned char*)a.out); }); } SEAM(2);
    if (IN(3)) { PH(30, { ph_attn_merge(c, ws, (const unsigned char*)a.out, concat); }); PH(31, { ph_m3(c, a, proj, ipre, logf, mq, mk, (const unsigned char*)a.out, concat); }); } SEAM(3);
    if (IN(4)) { PH(4, { pg8::Gemm g{concat, WoutT, T_, D_, D_}; pg8::StaticOrder S; S.init(T_, D_, c.G, (int)blockIdx.x);
        pg8::EpiResBf16 E{a.in[0], (bf16*)(ws + WS_Y1), ALPHA};
        pg8::gemm_phase<pg8::EpiResBf16, pg8::StaticOrder, true, true>((PG8_LAS unsigned char*)lds, g, S, E); }); } SEAM(4);
    if (IN(5)) { PH(5, { ph_ln1(c, (const bf16*)(ws + WS_Y1), a.in[10], a.in[11], (float2*)(ws + WS_ST1), (unsigned*)(ws + WS_XQ), (float*)(ws + WS_SX)); }); } SEAM(5);
    if (IN(6)) { PH(6, { pg8::Gemm g{(const pg8::bf16_t*)(ws + WS_XQ), (const pg8::bf16_t*)(ws + WS_WQ), T_, 2048, D_ / 2}; pg8::StaticOrder S; S.init(T_, 2048, c.G, (int)blockIdx.x);
        pg8::EpiI8Bf16 E{qry, 2048, (const float*)(ws + WS_SX), (const float*)(ws + WS_SWQ)};
        pg8::gemm_phase<pg8::EpiI8Bf16, pg8::StaticOrder, true, true>((PG8_LAS unsigned char*)lds, g, S, E);
        asm volatile("s_waitcnt vmcnt(0)" ::: "memory"); __syncthreads();
        ph_route(c, qry, (const bf16*)(ws + WS_SK), (unsigned*)(ws + WS_EIDX), (float*)(ws + WS_GATEV)); }); } SEAM(6);
    if (IN(8)) { PH(8, { ph_g1(c, xbar.bar, (const unsigned char*)(ws + WS_XQ), (const float*)(ws + WS_SX), (const unsigned char*)(ws + WS_WD), (const unsigned*)(ws + WS_EIDX), (bf16*)(ws + WS_APART)); }); } SEAM(8);
    if (IN(9)) { PH(9, { ph_afin(c, (const bf16*)(ws + WS_APART), (const float*)(ws + WS_GATEV), (const unsigned*)(ws + WS_EIDX), (const float*)(ws + WS_SCD), (const float*)(ws + WS_SCU), (unsigned char*)(ws + WS_AFIN), (float*)(ws + WS_SA)); }); } SEAM(9);
    if (IN(10)) { PH(10, { ph_g2(c, xbar.bar, (const unsigned char*)(ws + WS_WU), (const unsigned*)(ws + WS_EIDX), (const unsigned char*)(ws + WS_AFIN), (const float*)(ws + WS_SA), (bf16*)(ws + WS_FFN)); }); } SEAM(10);
    if (IN(11)) { PH(11, { ph_ln2(c, (const bf16*)(ws + WS_Y1), (const float2*)(ws + WS_ST1), a.in[10], a.in[11], (const bf16*)(ws + WS_FFN), a.out, a.in[16], a.in[17]); }); }
#undef PH
#undef WoutT
#undef ipre
#undef logf
#undef proj
#undef qry
#undef mq
#undef mk
#undef concat
#undef xb
#undef IN
#undef SEAM
}

#ifndef MK_PER_PHASE
#define MK_PER_PHASE 0
#endif
extern "C" void kernel_launch(void* const* d_in, const int* in_sizes, int n_in, void* d_out, int out_size, void* d_ws, size_t ws_size, hipStream_t stream) {
    static int grid = 0;
    if (grid == 0) {
        if (n_in != 18 || out_size != T_ * D_ || ws_size < WS_END) { fprintf(stderr, "kernel_launch: unexpected sizes n_in %d out %d ws %zu\n", n_in, out_size, ws_size); grid = -1; return; }
        int dev = 0, cus = 0, per_cu = 0;
        if (hipGetDevice(&dev) != hipSuccess || hipDeviceGetAttribute(&cus, hipDeviceAttributeMultiprocessorCount, dev) != hipSuccess) { fprintf(stderr, "kernel_launch: device query failed\n"); grid = -1; return; }
        if (hipFuncSetAttribute((const void*)mega, hipFuncAttributeMaxDynamicSharedMemorySize, LDS_BYTES) != hipSuccess) { fprintf(stderr, "kernel_launch: hipFuncSetAttribute failed\n"); grid = -1; return; }
        if (hipOccupancyMaxActiveBlocksPerMultiprocessor(&per_cu, (const void*)mega, NTHREADS, LDS_BYTES) != hipSuccess || per_cu < 1) { fprintf(stderr, "kernel_launch: occupancy query failed (%d)\n", per_cu); (void)hipGetLastError(); grid = -1; return; }
        grid = cus * per_cu;
        fprintf(stderr, "kernel_launch: %d CUs x %d workgroups = grid %d\n", cus, per_cu, grid);
    }
    if (grid < 0) return;
    if (hipMemsetAsync((char*)d_ws + WS_BAR, 0, 49152, stream) != hipSuccess) { fprintf(stderr, "kernel_launch: memset of the barrier words failed\n"); return; }
    Args a{};
    for (int i = 0; i < 18; ++i) a.in[i] = (const float*)d_in[i];
    a.out = (float*)d_out; a.ws = (unsigned char*)d_ws;
#if MK_PER_PHASE
    for (int p = 0; p < NPH; ++p) { a.ph_lo = p; a.ph_hi = p + 1; hipLaunchKernelGGL(mega, dim3(grid), dim3(NTHREADS), LDS_BYTES, stream, a); }
#else
    a.ph_lo = 0; a.ph_hi = NPH;
    void* params[] = {&a};
    const hipError_t e = hipLaunchCooperativeKernel((const void*)mega, dim3(grid), dim3(NTHREADS), params, LDS_BYTES, stream);
    if (e != hipSuccess) fprintf(stderr, "kernel_launch: cooperative launch failed: %s (grid %d)\n", hipGetErrorString(e), grid);
#endif
}
```

```cpp
#include <hip/hip_runtime.h>
#include <cstdio>
#include <cstdint>
#include <cmath>
namespace pg8 {
#define PG8_LAS __attribute__((address_space(3)))
typedef unsigned short bf16_t;
typedef short bf16x8 __attribute__((ext_vector_type(8)));
typedef float f32x4 __attribute__((ext_vector_type(4)));
typedef unsigned u32x4 __attribute__((ext_vector_type(4)));
typedef int i32x4 __attribute__((ext_vector_type(4)));
constexpr int BM = 256, BK = 64, HALF = 128, HTB = HALF * BK * 2  , STAGE_BYTES = 8 * HTB, NXCD = 8, WGM = 8;

__host__ __device__ __forceinline__ int lds_byte(int r, int c) { const int st = (r >> 4) * 2 + (c >> 5), rr = r & 15, cc = c & 31, ob = rr * 64 + cc * 2; return st * 1024 + (ob ^ (((ob >> 9) & 1) << 5)); }
__host__ __device__ __forceinline__ void stage_rc(int b, int& R, int& C) { const int st = b / 1024, sb = b % 1024, swz = sb ^ (((sb >> 9) & 1) << 5); R = (st >> 1) * 16 + swz / 64; C = (st & 1) * 32 + (swz % 64) / 2; }
__host__ __device__ __forceinline__ int perm32(int rho) { const int n = rho >> 4, i = rho & 15; return 8 * (i >> 2) + 4 * n + (i & 3); }

struct Unit { int pm, pn; };
struct Gemm { const bf16_t* A; const bf16_t* Bt; int M, N, K; };

struct StaticOrder {
    int nM, nN, nwg, G, c;
    __host__ __device__ void init(int M, int N, int G_, int c_) { nM = M / BM; nN = N / BM; nwg = nM * nN; G = G_; c = c_; }
    __host__ __device__ bool next(int i, Unit& u) const {
        const long L = (long)i * G + c; if (L >= nwg) return false;
        int wgid = (int)L; { const int q = nwg / NXCD, r = nwg % NXCD, xcd = wgid % NXCD, off = wgid / NXCD; wgid = (xcd < r ? xcd * (q + 1) : r * (q + 1) + (xcd - r) * q) + off; }
        const int nig = WGM * nN, gid = wgid / nig, fm = gid * WGM, gsz = (nM - fm) < WGM ? (nM - fm) : WGM;
        u.pm = fm + ((wgid % nig) % gsz); u.pn = (wgid % nig) / gsz; return true;
    }
    __device__ __forceinline__ void a_ready(const Unit&) const {}
    __device__ __forceinline__ void done(const Unit&) const {}
};

__device__ __forceinline__ unsigned cvt_pk_bf16(float lo, float hi) { unsigned r; asm volatile("v_cvt_pk_bf16_f32 %0, %1, %2" : "=v"(r) : "v"(lo), "v"(hi)); return r; }
typedef float f32x2 __attribute__((ext_vector_type(2)));
__device__ __forceinline__ f32x2 gelu_pk(f32x2 v) {
    const f32x2 av = __builtin_elementwise_abs(v), d = av * 0.2316418882f + 1.0f;
    f32x2 t; t.x = __builtin_amdgcn_rcpf(d.x); t.y = __builtin_amdgcn_rcpf(d.y);
    f32x2 q = t * 0.5307027145f + (-0.7265760135f); q = q * t + 0.7107068705f; q = q * t + (-0.142248368f); q = q * t + 0.127414796f; q = q * t;
    const f32x2 s = (v * v) * (-0.72134752044f);
    f32x2 e; e.x = __builtin_amdgcn_exp2f(s.x); e.y = __builtin_amdgcn_exp2f(s.y);
    const f32x2 m = v * (q * e), r = v - m;
    f32x2 o; o.x = v.x < 0.f ? m.x : r.x; o.y = v.y < 0.f ? m.y : r.y; return o;
}

template <int ACT  > struct EpiBf16 {
    static constexpr bool PERM = true, AFTER_DRAIN = false, I8 = false; static_assert(ACT == 0 || ACT == 1, "EpiBf16: ACT is 0 (none) or 1 (gelu_pk)");
    bf16_t* O; int ldc; const float* bias; int split_cols; size_t split_stride; float scale0;
    __device__ __forceinline__ void operator()(const f32x4 (&acc)[2][2][4][2], const Unit& u, int wr, int wc, int fr, int fq) const {
        const int row0 = u.pm * BM + wr * 64 + fr; int colt = u.pn * BM; bf16_t* base = O;
        float sc = 1.f; if (split_cols) { const int t = colt / split_cols; base += (size_t)t * split_stride; colt -= t * split_cols; if (t == 0) sc = scale0; }
        const int col0 = colt + wc * 32 + 8 * fq, bcol0 = u.pn * BM + wc * 32 + 8 * fq;
        f32x4 bv[2][2];
#pragma unroll
        for (int bj = 0; bj < 2; ++bj)
#pragma unroll
            for (int n = 0; n < 2; ++n) bv[bj][n] = bias ? *(const f32x4*)(bias + bcol0 + bj * HALF + 4 * n) : (f32x4){0.f, 0.f, 0.f, 0.f};
#pragma unroll
        for (int ai = 0; ai < 2; ++ai)
#pragma unroll
            for (int m = 0; m < 4; ++m) { bf16_t* rowp = base + (size_t)(row0 + ai * HALF + m * 16) * ldc + col0;
#pragma unroll
                for (int bj = 0; bj < 2; ++bj) { f32x4 v0 = acc[ai][bj][m][0] + bv[bj][0], v1 = acc[ai][bj][m][1] + bv[bj][1];
                    if (ACT == 1) { f32x2 a = gelu_pk((f32x2){v0[0], v0[1]}), b = gelu_pk((f32x2){v0[2], v0[3]}), c = gelu_pk((f32x2){v1[0], v1[1]}), d = gelu_pk((f32x2){v1[2], v1[3]});
                        v0 = (f32x4){a.x, a.y, b.x, b.y}; v1 = (f32x4){c.x, c.y, d.x, d.y}; }
                    v0 = v0 * sc; v1 = v1 * sc; u32x4 w; w.x = cvt_pk_bf16(v0[0], v0[1]); w.y = cvt_pk_bf16(v0[2], v0[3]); w.z = cvt_pk_bf16(v1[0], v1[1]); w.w = cvt_pk_bf16(v1[2], v1[3]);
                    *(u32x4*)(rowp + bj * HALF) = w; } }
    }
};
struct EpiResBf16 {
    static constexpr bool PERM = true, AFTER_DRAIN = false, I8 = false;
    const float* xres; bf16_t* out; float alpha;
    __device__ __forceinline__ void operator()(const f32x4 (&acc)[2][2][4][2], const Unit& u, int wr, int wc, int fr, int fq) const {
        const int col0 = u.pn * BM + wc * 32 + 8 * fq;
#pragma unroll
        for (int ai = 0; ai < 2; ++ai)
#pragma unroll
            for (int m = 0; m < 4; ++m) { const size_t off = (size_t)(u.pm * BM + ai * HALF + wr * 64 + m * 16 + fr) * 1024 + col0;
#pragma unroll
                for (int bj = 0; bj < 2; ++bj) { const f32x4 x0 = *(const f32x4*)(xres + off + bj * HALF), x1 = *(const f32x4*)(xres + off + bj * HALF + 4);
                    const f32x4 v0 = x0 * alpha + acc[ai][bj][m][0], v1 = x1 * alpha + acc[ai][bj][m][1];
                    u32x4 w; w.x = cvt_pk_bf16(v0[0], v0[1]); w.y = cvt_pk_bf16(v0[2], v0[3]); w.z = cvt_pk_bf16(v1[0], v1[1]); w.w = cvt_pk_bf16(v1[2], v1[3]);
                    *(u32x4*)(out + off + bj * HALF) = w; } }
    }
};
struct EpiI8Bf16 {
    static constexpr bool PERM = true, AFTER_DRAIN = false, I8 = true;
    bf16_t* O; int ldc; const float* sa; const float* sb;
    __device__ __forceinline__ void operator()(const i32x4 (&acc)[2][2][4][2], const Unit& u, int wr, int wc, int fr, int fq) const {
        const int row0 = u.pm * BM + wr * 64 + fr, col0 = u.pn * BM + wc * 32 + 8 * fq;
        f32x4 sbv[2][2];
#pragma unroll
        for (int bj = 0; bj < 2; ++bj)
#pragma unroll
            for (int n = 0; n < 2; ++n) sbv[bj][n] = *(const f32x4*)(sb + col0 + bj * HALF + 4 * n);
#pragma unroll
        for (int ai = 0; ai < 2; ++ai)
#pragma unroll
            for (int m = 0; m < 4; ++m) { const int r = row0 + ai * HALF + m * 16; const float sr = sa[r]; bf16_t* rowp = O + (size_t)r * ldc + col0;
#pragma unroll
                for (int bj = 0; bj < 2; ++bj) { const i32x4 a0 = acc[ai][bj][m][0], a1 = acc[ai][bj][m][1];
                    const f32x4 v0 = (f32x4){(float)a0[0], (float)a0[1], (float)a0[2], (float)a0[3]} * sbv[bj][0] * sr, v1 = (f32x4){(float)a1[0], (float)a1[1], (float)a1[2], (float)a1[3]} * sbv[bj][1] * sr;
                    u32x4 w; w.x = cvt_pk_bf16(v0[0], v0[1]); w.y = cvt_pk_bf16(v0[2], v0[3]); w.z = cvt_pk_bf16(v1[0], v1[1]); w.w = cvt_pk_bf16(v1[2], v1[3]);
                    *(u32x4*)(rowp + bj * HALF) = w; } }
    }
};
__device__ __forceinline__ f32x4 mma16(bf16x8 a, bf16x8 b, f32x4 c) { return __builtin_amdgcn_mfma_f32_16x16x32_bf16(a, b, c, 0, 0, 0); }
__device__ __forceinline__ i32x4 mma16(bf16x8 a, bf16x8 b, i32x4 c) { return __builtin_amdgcn_mfma_i32_16x16x64_i8(__builtin_bit_cast(i32x4, a), __builtin_bit_cast(i32x4, b), c, 0, 0, 0); }
template <bool I8> struct AccT { typedef f32x4 type; };
template <> struct AccT<true> { typedef i32x4 type; };
template <class Epi, class Sched, bool ALIGN_EPI = false, bool SP2 = false>
__device__ __forceinline__ void gemm_phase(PG8_LAS unsigned char* lds, const Gemm g, const Sched& S, const Epi& E) {
    const int tid = threadIdx.x, wid = __builtin_amdgcn_readfirstlane(tid >> 6), lane = tid & 63, wr = wid >> 2, wc = wid & 3, fr = lane & 15, fq = lane >> 4;
    const int K = g.K, nt = K / BK;
    unsigned voffA[2], voffB[2];
#pragma unroll
    for (int i = 0; i < 2; ++i) { int R, C; stage_rc(tid * 16 + i * 8192, R, C); const int Rb = Epi::PERM ? ((R & ~31) + perm32(R & 31)) : R;
        voffA[i] = (unsigned)(R * K + C) * 2u; voffB[i] = (unsigned)(Rb * K + C) * 2u; }
    const size_t kstep = (size_t)(BK * 2);
    const size_t hstep = (size_t)HALF * K * 2;
    const size_t tstep = 2 * hstep;
    const unsigned ldsw = (unsigned)wid * 1024u;
    const int aoff = lds_byte(wr * 64 + fr, fq * 8), boff = lds_byte(wc * 32 + fr, fq * 8);
#define PG8_SA(b, h) (((b) * 2 + (h)) * HTB)
#define PG8_SB(b, h) ((4 + (b) * 2 + (h)) * HTB)
#define PG8_STAGE(bufoff, gbase, voff) do { _Pragma("unroll") for (int _i = 0; _i < 2; ++_i) \
        __builtin_amdgcn_global_load_lds((const unsigned*)((const char*)(gbase) + (voff)[_i]), (PG8_LAS unsigned*)(lds + (bufoff) + ldsw + _i * 8192), 16, 0, 0); } while (0)
#define PG8_LDA(dst, b, h) do { _Pragma("unroll") for (int m = 0; m < 4; ++m) _Pragma("unroll") for (int k = 0; k < 2; ++k) dst[m][k] = *(const PG8_LAS bf16x8*)(lds + PG8_SA(b, h) + aoff + m * 2048 + k * 1024); } while (0)
#define PG8_LDB(dst, b, h) do { _Pragma("unroll") for (int n = 0; n < 2; ++n) _Pragma("unroll") for (int k = 0; k < 2; ++k) dst[n][k] = *(const PG8_LAS bf16x8*)(lds + PG8_SB(b, h) + boff + n * 2048 + k * 1024); } while (0)
#define PG8_MMA(ai, bj, At, Bt) do { __builtin_amdgcn_s_setprio(1); _Pragma("unroll") for (int m = 0; m < 4; ++m) _Pragma("unroll") for (int n = 0; n < 2; ++n) _Pragma("unroll") for (int k = 0; k < 2; ++k) \
        acc[ai][bj][m][n] = mma16(Bt[n][k], At[m][k], acc[ai][bj][m][n]); __builtin_amdgcn_s_setprio(0); } while (0)
#define PG8_WAIT_V(n) asm volatile("s_waitcnt vmcnt(" #n ")" ::: "memory")
#define PG8_WAIT_L(n) asm volatile("s_waitcnt lgkmcnt(" #n ")" ::: "memory")
#define PG8_BAR __builtin_amdgcn_s_barrier()
#define PG8_SCHED __builtin_amdgcn_sched_barrier(0)
    Unit cur, nxt; int ui = 0;
    if (!S.next(0, cur)) return;
    typedef typename AccT<Epi::I8>::type acc_t; const acc_t acc_zero = {0, 0, 0, 0};
    acc_t acc[2][2][4][2];
#pragma unroll
    for (int a = 0; a < 2; ++a)
#pragma unroll
        for (int b = 0; b < 2; ++b)
#pragma unroll
            for (int m = 0; m < 4; ++m)
#pragma unroll
                for (int n = 0; n < 2; ++n) acc[a][b][m][n] = acc_zero;
    bf16x8 At[4][2], B0[2][2], B1[2][2];
    const char* cA = (const char*)g.A + (size_t)cur.pm * tstep; const char* cB = (const char*)g.Bt + (size_t)cur.pn * tstep;
    S.a_ready(cur);
    if constexpr (SP2) {
        PG8_STAGE(PG8_SB(0, 0), cB, voffB); PG8_STAGE(PG8_SB(0, 1), cB + hstep, voffB); PG8_STAGE(PG8_SA(0, 0), cA, voffA); PG8_STAGE(PG8_SA(0, 1), cA + hstep, voffA);
        if (wr == 1) PG8_BAR;
        PG8_WAIT_V(2); PG8_BAR;
        PG8_STAGE(PG8_SB(1, 0), cB + kstep, voffB); PG8_STAGE(PG8_SA(1, 0), cA + kstep, voffA); PG8_STAGE(PG8_SB(1, 1), cB + hstep + kstep, voffB);
        PG8_WAIT_V(6); PG8_BAR;
    } else {
        PG8_STAGE(PG8_SB(0, 0), cB, voffB); PG8_STAGE(PG8_SA(0, 0), cA, voffA); PG8_STAGE(PG8_SB(0, 1), cB + hstep, voffB); PG8_STAGE(PG8_SA(0, 1), cA + hstep, voffA);
        if (wr == 1) PG8_BAR;
        PG8_WAIT_V(4); PG8_BAR;
        PG8_STAGE(PG8_SB(1, 0), cB + kstep, voffB); PG8_STAGE(PG8_SA(1, 0), cA + kstep, voffA); PG8_STAGE(PG8_SB(1, 1), cB + hstep + kstep, voffB);
        PG8_WAIT_V(6); PG8_BAR;
    }
    for (;;) {
        const bool has_next = S.next(ui + 1, nxt);
        const char* nA = has_next ? (const char*)g.A + (size_t)nxt.pm * tstep : cA; const char* nB = has_next ? (const char*)g.Bt + (size_t)nxt.pn * tstep : cB;
        for (int t = 0; t < nt; t += 2) {
            const bool last = (t == nt - 2);
            const char* a1 = cA + (size_t)(t + 1) * kstep;
            const char* a2 = last ? nA : cA + (size_t)(t + 2) * kstep; const char* b2 = last ? nB : cB + (size_t)(t + 2) * kstep;
            const char* a3 = a2 + kstep; const char* b3 = b2 + kstep;
            if (last && has_next) S.a_ready(nxt);
            if constexpr (SP2) {
            PG8_LDB(B0, 0, 0); PG8_LDB(B1, 0, 1); PG8_SCHED; PG8_LDA(At, 0, 0); PG8_STAGE(PG8_SA(1, 1), a1 + hstep, voffA);
            PG8_WAIT_V(8); PG8_WAIT_L(0); PG8_BAR; PG8_MMA(0, 0, At, B0); PG8_MMA(0, 1, At, B1); PG8_BAR; PG8_SCHED;
            PG8_LDA(At, 0, 1); PG8_STAGE(PG8_SB(0, 0), b2, voffB); PG8_STAGE(PG8_SB(0, 1), b2 + hstep, voffB); PG8_STAGE(PG8_SA(0, 0), a2, voffA);
            PG8_WAIT_V(8); PG8_WAIT_L(0); PG8_BAR; PG8_MMA(1, 0, At, B0); PG8_MMA(1, 1, At, B1); PG8_BAR; PG8_SCHED;
            PG8_LDB(B0, 1, 0); PG8_LDB(B1, 1, 1); PG8_SCHED; PG8_LDA(At, 1, 0); PG8_STAGE(PG8_SA(0, 1), a2 + hstep, voffA);
            PG8_WAIT_V(8); PG8_WAIT_L(0); PG8_BAR; PG8_MMA(0, 0, At, B0); PG8_MMA(0, 1, At, B1); PG8_BAR; PG8_SCHED;
            PG8_LDA(At, 1, 1); PG8_STAGE(PG8_SB(1, 0), b3, voffB); PG8_STAGE(PG8_SB(1, 1), b3 + hstep, voffB); PG8_STAGE(PG8_SA(1, 0), a3, voffA);
            PG8_WAIT_V(8); PG8_WAIT_L(0); PG8_BAR; PG8_MMA(1, 0, At, B0); PG8_MMA(1, 1, At, B1); PG8_BAR; PG8_SCHED;
            } else {
            PG8_LDB(B0, 0, 0); PG8_SCHED; PG8_LDA(At, 0, 0); PG8_STAGE(PG8_SA(1, 1), a1 + hstep, voffA);
            PG8_WAIT_L(8); PG8_BAR; PG8_WAIT_L(0); PG8_MMA(0, 0, At, B0); PG8_BAR; PG8_SCHED;
            PG8_LDB(B1, 0, 1); PG8_STAGE(PG8_SB(0, 0), b2, voffB);
            PG8_BAR; PG8_WAIT_L(0); PG8_MMA(0, 1, At, B1); PG8_BAR;
            PG8_LDA(At, 0, 1); PG8_STAGE(PG8_SA(0, 0), a2, voffA);
            PG8_BAR; PG8_WAIT_L(0); PG8_MMA(1, 0, At, B0); PG8_BAR; PG8_SCHED;
            PG8_STAGE(PG8_SB(0, 1), b2 + hstep, voffB);
            PG8_WAIT_V(6); PG8_BAR; PG8_MMA(1, 1, At, B1); PG8_BAR;
            PG8_LDB(B0, 1, 0); PG8_SCHED; PG8_LDA(At, 1, 0); PG8_STAGE(PG8_SA(0, 1), a2 + hstep, voffA);
            PG8_WAIT_L(8); PG8_BAR; PG8_WAIT_L(0); PG8_MMA(0, 0, At, B0); PG8_BAR; PG8_SCHED;
            PG8_LDB(B1, 1, 1); PG8_STAGE(PG8_SB(1, 0), b3, voffB);
            PG8_BAR; PG8_WAIT_L(0); PG8_MMA(0, 1, At, B1); PG8_BAR;
            PG8_LDA(At, 1, 1); PG8_STAGE(PG8_SA(1, 0), a3, voffA);
            PG8_BAR; PG8_WAIT_L(0); PG8_MMA(1, 0, At, B0); PG8_BAR; PG8_SCHED;
            PG8_STAGE(PG8_SB(1, 1), b3 + hstep, voffB);
            PG8_WAIT_V(6); PG8_BAR; PG8_MMA(1, 1, At, B1); PG8_BAR;
            }
        }
        if constexpr (ALIGN_EPI) { if (wr == 0) PG8_BAR; }
        if constexpr (!Epi::AFTER_DRAIN) { E(acc, cur, wr, wc, fr, fq); S.done(cur); }
        if (!has_next) break;
#pragma unroll
        for (int a = 0; a < 2; ++a)
#pragma unroll
            for (int b = 0; b < 2; ++b)
#pragma unroll
                for (int m = 0; m < 4; ++m)
#pragma unroll
                    for (int n = 0; n < 2; ++n) acc[a][b][m][n] = acc_zero;
        cur = nxt; cA = nA; cB = nB; ++ui;
        if constexpr (ALIGN_EPI) { if (wr == 1) PG8_BAR; }
    }
    PG8_WAIT_V(0);
    if constexpr (!ALIGN_EPI) { if (wr == 0) PG8_BAR; }
    PG8_BAR;
    if constexpr (Epi::AFTER_DRAIN) { E.fused(acc, cur, wr, wc, fr, fq, lds, wid, lane); S.done(cur); }
#undef PG8_SA
#undef PG8_SB
#undef PG8_STAGE
#undef PG8_LDA
#undef PG8_LDB
#undef PG8_MMA
#undef PG8_WAIT_V
#undef PG8_WAIT_L
#undef PG8_BAR
#undef PG8_SCHED
}
}
typedef unsigned short bf16;
#define LAS __attribute__((address_space(3)))
constexpr int B_ = 16, S_ = 2048, D_ = 1024, T_ = B_ * S_;
constexpr int INC = 3080, NPROJ = 3072;
constexpr int C_QA = 0, C_KA = 512, C_VA = 1024, C_XM = 1536, C_VM = 2048, C_OM = 2560;
constexpr float ALPHA = 1.189207115002721f;
constexpr float LN_EPS = 1e-5f;
constexpr size_t MiB = 1u << 20;
constexpr int NWAVES = 8, NTHREADS = 512;
constexpr int LDS_BYTES = 147456;

constexpr size_t WS_WIN = 1 * MiB;
constexpr size_t WS_SWN = 768 * 1024, WS_SXA = 800 * 1024;
constexpr size_t WS_WOUT = 7 * MiB;
constexpr size_t WS_WQ = 9 * MiB;
constexpr size_t WS_SWQ = 780 * 1024;
constexpr size_t WS_GATE = 13 * MiB;
constexpr size_t WS_PROJ = 16 * MiB;
constexpr size_t WS_QRY = 16 * MiB;
constexpr size_t WS_Y1 = 336 * MiB;
constexpr size_t WS_ST1 = 305 * MiB;
constexpr size_t WS_MQ = 208 * MiB, WS_MK = 240 * MiB;
constexpr size_t WS_CONCAT = 272 * MiB;
constexpr size_t WS_XB = 336 * MiB;
constexpr size_t WS_SK = 15 * MiB + 512 * 1024;
constexpr size_t WS_EIDX = 144 * MiB, WS_GATEV = 160 * MiB;
constexpr size_t WS_AFIN = 176 * MiB;
constexpr size_t WS_SA = 192 * MiB;
constexpr size_t WS_FFN = 208 * MiB;
constexpr size_t WS_APART = 208 * MiB;
constexpr size_t WS_XQ = 272 * MiB, WS_SX = 304 * MiB;
constexpr size_t WS_WD = 400 * MiB, WS_WU = 432 * MiB;
constexpr size_t WS_SCD = 640 * 1024, WS_SCU = 704 * 1024;
constexpr size_t WS_PO01 = 336 * MiB;
constexpr size_t OUT_DBUF = 40 * MiB, OUT_NLOC = 72 * MiB, OUT_CSC = 73 * MiB;
constexpr size_t WS_WMT = 0;
constexpr size_t OUT_PO2 = 0, OUT_PML = 32 * MiB;
constexpr size_t WS_END = 464 * MiB;
typedef short bf16x8 __attribute__((ext_vector_type(8)));
typedef float f32x16 __attribute__((ext_vector_type(16)));

__device__ __forceinline__ float bf2f(bf16 v) { return __uint_as_float((unsigned)v << 16); }
__device__ __forceinline__ unsigned f2bf(float f) { unsigned u = __float_as_uint(f); return (u + 0x7fffu + ((u >> 16) & 1u)) >> 16; }
__device__ __forceinline__ unsigned pk2(float lo, float hi) { return f2bf(lo) | (f2bf(hi) << 16); }
#define WAVE_FENCE() asm volatile("s_waitcnt lgkmcnt(0)" ::: "memory")
template <int CTRL> __device__ __forceinline__ float dppf_(float v) { return __int_as_float(__builtin_amdgcn_mov_dpp(__float_as_int(v), CTRL, 0xF, 0xF, true)); }
__device__ __forceinline__ float wave_sum(float v) {
    v += dppf_<0xB1>(v); v += dppf_<0x4E>(v); v += dppf_<0x141>(v); v += dppf_<0x140>(v);
    { const auto r = __builtin_amdgcn_permlane16_swap(__float_as_uint(v), __float_as_uint(v), false, false); v = __uint_as_float(r[0]) + __uint_as_float(r[1]); }
    { const auto r = __builtin_amdgcn_permlane32_swap(__float_as_uint(v), __float_as_uint(v), false, false); v = __uint_as_float(r[0]) + __uint_as_float(r[1]); }
    return v;
}
__device__ __forceinline__ float wave_max(float v) {
    v = fmaxf(v, dppf_<0xB1>(v)); v = fmaxf(v, dppf_<0x4E>(v)); v = fmaxf(v, dppf_<0x141>(v)); v = fmaxf(v, dppf_<0x140>(v));
    { const auto r = __builtin_amdgcn_permlane16_swap(__float_as_uint(v), __float_as_uint(v), false, false); v = fmaxf(__uint_as_float(r[0]), __uint_as_float(r[1])); }
    { const auto r = __builtin_amdgcn_permlane32_swap(__float_as_uint(v), __float_as_uint(v), false, false); v = fmaxf(__uint_as_float(r[0]), __uint_as_float(r[1])); }
    return v;
}
#define RLX_AGENT __ATOMIC_RELAXED, __HIP_MEMORY_SCOPE_AGENT
#define XB_TMO      128
#define XB_XCNT(j)  (256  + 64 * (j))
#define XB_XSUB(j)  (1280 + 64 * (j))
#define XB_XGEN(j)  (2304 + 64 * (j))
#define XB_TOP      3328
#define XB_TOPGEN   3392
#define XCD_BAR_WORDS 3456
#define XB_SPIN_CAP (1u << 18)

__device__ __forceinline__ unsigned xb_ld(unsigned* p)              { return __hip_atomic_load(p, __ATOMIC_RELAXED, __HIP_MEMORY_SCOPE_AGENT); }
__device__ __forceinline__ unsigned xb_add(unsigned* p, unsigned v) { return __hip_atomic_fetch_add(p, v, __ATOMIC_RELAXED, __HIP_MEMORY_SCOPE_AGENT); }
__device__ __forceinline__ unsigned xb_xcc_id() { return (unsigned)__builtin_amdgcn_s_getreg((3 << 11) | 20) & 0xFu; }
#define XB_SPIN(cond, bar) do { unsigned _sp = 0; while (cond) { __builtin_amdgcn_s_sleep(1); \
    if ((++_sp & 255u) == 0u) { if (xb_ld(&(bar)[XB_TMO])) break; if (_sp > XB_SPIN_CAP) { atomicAdd(&(bar)[XB_TMO], 1u); break; } } } } while (0)

struct XcdBarrier {
    unsigned* bar; unsigned x;
    volatile LAS unsigned* st;
};

__device__ __forceinline__ XcdBarrier xcd_barrier_post(unsigned* bar, volatile LAS unsigned* st) {
    XcdBarrier b; b.bar = bar; b.x = xb_xcc_id(); b.st = st;
    if (threadIdx.x == 0) (void)xb_add(&bar[XB_XCNT(b.x)], 1u);
    return b;
}
__device__ __forceinline__ void xcd_barrier_complete(unsigned* bar, unsigned x, unsigned& nloc, unsigned& nx) {
    const unsigned G = gridDim.x * gridDim.y * gridDim.z;
    unsigned sum, cnt, mine, sp = 0u;
    for (;;) {
        sum = 0u; cnt = 0u; mine = 0u;
#pragma unroll
        for (unsigned j = 0; j < 16; ++j) { const unsigned c = xb_ld(&bar[XB_XCNT(j)]); sum += c; cnt += (c > 0u) ? 1u : 0u; mine = (j == x) ? c : mine; }
        if (sum == G) break;
        __builtin_amdgcn_s_sleep(1);
        if ((++sp & 255u) == 0u) { if (xb_ld(&bar[XB_TMO])) break; if (sp > XB_SPIN_CAP) { atomicAdd(&bar[XB_TMO], 1u); break; } }
    }
    nloc = mine > 0u ? mine : 1u; nx = cnt > 0u ? cnt : 1u;
}

__device__ __forceinline__ void xcd_barrier(const XcdBarrier& b) {
    asm volatile("s_waitcnt vmcnt(0)" ::: "memory");
    __syncthreads();
    if (threadIdx.x == 0) {
        unsigned* bar = b.bar;
        __builtin_amdgcn_s_waitcnt(0);
        unsigned nloc = b.st[0], nx = b.st[1];
        if (nloc == 0u) { xcd_barrier_complete(bar, b.x, nloc, nx); b.st[0] = nloc; b.st[1] = nx; }
        const unsigned old = xb_add(&bar[XB_XSUB(b.x)], 1u);
        const unsigned gen = old / nloc;
        if (old + 1u == (gen + 1u) * nloc) {
            __builtin_amdgcn_fence(__ATOMIC_RELEASE, "agent");
            asm volatile("s_waitcnt vmcnt(0)" ::: "memory");
            const unsigned og = xb_add(&bar[XB_TOP], 1u);
            const unsigned tg = og / nx;
            if (og + 1u == (tg + 1u) * nx) xb_add(&bar[XB_TOPGEN], 1u);
            else XB_SPIN(xb_ld(&bar[XB_TOPGEN]) == tg, bar);
            __builtin_amdgcn_fence(__ATOMIC_ACQUIRE, "agent");
            xb_add(&bar[XB_XGEN(b.x)], 1u);
            asm volatile("s_waitcnt vmcnt(0)" ::: "memory");
        } else {
            XB_SPIN(xb_ld(&bar[XB_XGEN(b.x)]) == gen, bar);
            __builtin_amdgcn_fence(__ATOMIC_ACQUIRE, "agent");
            asm volatile("s_waitcnt vmcnt(0)" ::: "memory");
        }
    }
    __syncthreads();
}

constexpr size_t WS_BAR = 512 * 1024;
constexpr size_t WS_CMX = 512 * 1024 + 16384;
constexpr int MISC_OFF = 131072 + 512;
struct Args { const float* in[18]; float* out; unsigned char* ws; int ph_lo, ph_hi; };
struct Ctx { int tid, lane, wave, G, gw, NGW, gwx; unsigned char* lds; LAS unsigned char* ldsl; };

__device__ __forceinline__ void transpose_item(const float* W, int ldw, int K, int nblk, bf16* WT, float* scr, int item, int lane) {
    const int kb = item / nblk, nb = item % nblk, k0 = 64 * kb, n0 = 32 * nb;
#pragma unroll 8
    for (int i = 0; i < 32; ++i) { const int kk = 2 * i + (lane >> 5); scr[kk * 33 + (lane & 31)] = W[(size_t)(k0 + kk) * ldw + n0 + (lane & 31)]; }
    WAVE_FENCE();
    const int c = lane & 7;
#pragma unroll
    for (int j = 0; j < 4; ++j) { const int n = (lane >> 3) + 8 * j; const float* s = scr + (8 * c) * 33 + n;
        uint4 o; o.x = pk2(s[0 * 33], s[1 * 33]); o.y = pk2(s[2 * 33], s[3 * 33]); o.z = pk2(s[4 * 33], s[5 * 33]); o.w = pk2(s[6 * 33], s[7 * 33]);
        *(uint4*)(WT + (size_t)(n0 + n) * K + k0 + 8 * c) = o; }
    WAVE_FENCE();
}
__device__ __forceinline__ void ph_prologue(const Ctx& c, const Args& a) {
    const float* x = a.in[0]; const float* w_in = a.in[1]; const float* b_ig = a.in[6]; const float* b_fg = a.in[7];
    bf16* WoutT = (bf16*)(a.ws + WS_WOUT); unsigned* xq8 = (unsigned*)(a.ws + WS_XB); float* sxa = (float*)(a.ws + WS_SXA);
    float* ipre = (float*)(a.ws + WS_GATE); float* logf = ipre + (size_t)T_ * 4;
    float* scr = (float*)(c.lds + c.wave * 8448); float* wgs = (float*)(c.lds + 69632);
    for (int i = c.tid; i < 8192; i += NTHREADS) wgs[i] = w_in[(size_t)(i >> 3) * INC + NPROJ + (i & 7)];
    constexpr int I_IN = 16 * 96, I_OUT = 16 * 32, I_Q = 16 * 64;
    unsigned* cmx = (unsigned*)(a.ws + WS_CMX); unsigned* ccnt = cmx + NPROJ + 2048;
    for (int it = c.gw; it < I_IN + I_Q; it += c.NGW) {
        const bool isq = it >= I_IN; const int r = isq ? it - I_IN : it, nblk = isq ? 64 : 96, ldw = isq ? 2048 : INC; const float* W = isq ? a.in[12] : w_in;
        const int kb = r / nblk, nb = r % nblk, k0 = 64 * kb, n0 = 32 * nb, cl = c.lane & 31, kh = c.lane >> 5; float am = 0.f;
#pragma unroll 8
        for (int i = 0; i < 32; ++i) am = fmaxf(am, fabsf(W[(size_t)(k0 + 2 * i + kh) * ldw + n0 + cl]));
        am = fmaxf(am, __shfl_xor(am, 32));
        unsigned prev = 0u;
        if (c.lane < 32) prev = atomicMax(cmx + (isq ? NPROJ : 0) + n0 + cl, __float_as_uint(am));
        asm volatile("s_waitcnt vmcnt(0)" : "+v"(prev) :: "memory");
        if (c.lane == 0) __hip_atomic_fetch_add(ccnt + (isq ? 96 : 0) + nb, 1u, __ATOMIC_RELAXED, __HIP_MEMORY_SCOPE_AGENT);
    }
    for (int it = c.gw; it < I_OUT; it += c.NGW) transpose_item(a.in[9], D_, D_, 32, WoutT, scr, it, c.lane);
    for (int it = c.gw; it < 64; it += c.NGW) {
        const int mat = it >> 5, h = (it >> 3) & 3, r = it & 7;
        transpose_item(a.in[4 + mat] + (size_t)h * 128 * 128, 128, 128, 4, (bf16*)(a.ws + WS_WMT) + (size_t)(mat * 4 + h) * 128 * 128, scr, r, c.lane);
    }
    { const float4* sk = (const float4*)a.in[13]; uint2* skb = (uint2*)(a.ws + WS_SK);
      for (int i = blockIdx.x * NTHREADS + c.tid; i < 8 * 2 * 128 * 128 / 4; i += c.G * NTHREADS) { const float4 v = sk[i]; uint2 o; o.x = pk2(v.x, v.y); o.y = pk2(v.z, v.w); skb[i] = o; } }
    for (int r0 = c.gw * 4; r0 < 2 * 16384; r0 += c.NGW * 4) {
      float4 vv[4][4];
#pragma unroll
      for (int rr = 0; rr < 4; ++rr) { const int r = r0 + rr; const float4* src = (const float4*)(a.in[14 + (r >> 14)] + (size_t)(r & 16383) * D_) + c.lane;
#pragma unroll
          for (int j = 0; j < 4; ++j) vv[rr][j] = src[64 * j]; }
#pragma unroll
      for (int rr = 0; rr < 4; ++rr) {
        const int r = r0 + rr, tb = r >> 14, e = r & 16383;
        float4 v[4]; float mx = 0.f;
#pragma unroll
        for (int j = 0; j < 4; ++j) { v[j] = vv[rr][j]; mx = fmaxf(mx, fmaxf(fmaxf(fabsf(v[j].x), fabsf(v[j].y)), fmaxf(fabsf(v[j].z), fabsf(v[j].w)))); }
        mx = fmaxf(wave_max(mx), 1e-30f);
        const float inv = 127.f / mx;
        if (c.lane == 0) ((float*)(a.ws + (tb ? WS_SCU : WS_SCD)))[e] = mx * (1.f / 127.f);
        unsigned* dst = (unsigned*)(a.ws + (tb ? WS_WU : WS_WD));
#pragma unroll
        for (int j = 0; j < 4; ++j) { const int p = (__float2int_rn(v[j].x * inv) & 0xff) | ((__float2int_rn(v[j].y * inv) & 0xff) << 8) | ((__float2int_rn(v[j].z * inv) & 0xff) << 16) | (__float2int_rn(v[j].w * inv) << 24);
            dst[(size_t)(2 * j + (c.lane >> 5)) * (16384 * 32) + (size_t)e * 32 + (c.lane & 31)] = (unsigned)p; }
      }
    }
    __syncthreads();
    for (int rowb = c.gw * 4; rowb < T_; rowb += c.NGW * 4) {
      float4 xx[4][4];
#pragma unroll
      for (int rr = 0; rr < 4; ++rr) { const float4* xr = (const float4*)(x + (size_t)(rowb + rr) * D_) + c.lane;
#pragma unroll
          for (int j = 0; j < 4; ++j) xx[rr][j] = xr[64 * j]; }
      float g[4][8];
#pragma unroll
      for (int rr = 0; rr < 4; ++rr)
#pragma unroll
          for (int i = 0; i < 8; ++i) g[rr][i] = 0.f;
#pragma unroll
      for (int j = 0; j < 4; ++j) {
          const int k = (64 * j + c.lane) * 4;
#pragma unroll
          for (int i = 0; i < 4; ++i) { const float4 w0 = *(const float4*)(wgs + (k + i) * 8), w1 = *(const float4*)(wgs + (k + i) * 8 + 4);
#pragma unroll
              for (int rr = 0; rr < 4; ++rr) { const float4 v = xx[rr][j]; const float xv = (i == 0) ? v.x : (i == 1) ? v.y : (i == 2) ? v.z : v.w;
                  g[rr][0] += xv * w0.x; g[rr][1] += xv * w0.y; g[rr][2] += xv * w0.z; g[rr][3] += xv * w0.w; g[rr][4] += xv * w1.x; g[rr][5] += xv * w1.y; g[rr][6] += xv * w1.z; g[rr][7] += xv * w1.w; } }
      }
#pragma unroll
      for (int rr = 0; rr < 4; ++rr) {
          float am = 0.f;
#pragma unroll
          for (int j = 0; j < 4; ++j) { const float4 v = xx[rr][j]; am = fmaxf(am, fmaxf(fmaxf(fabsf(v.x), fabsf(v.y)), fmaxf(fabsf(v.z), fabsf(v.w)))); }
          am = fmaxf(wave_max(am), 1e-30f); const float inv = 127.f / am;
          if (c.lane == 0) sxa[rowb + rr] = am * (1.f / 127.f);
#pragma unroll
          for (int j = 0; j < 4; ++j) { const float4 v = xx[rr][j];
              xq8[(size_t)(rowb + rr) * 256 + 64 * j + c.lane] = (unsigned)((__float2int_rn(v.x * inv) & 0xff) | ((__float2int_rn(v.y * inv) & 0xff) << 8) | ((__float2int_rn(v.z * inv) & 0xff) << 16) | (__float2int_rn(v.w * inv) << 24)); }
      }
#pragma unroll
      for (int rr = 0; rr < 4; ++rr) {
        const int row = rowb + rr;
#pragma unroll
        for (int i = 0; i < 8; ++i) g[rr][i] = wave_sum(g[rr][i]);
        if (c.lane < 8) {
            float gv = g[rr][0];
#pragma unroll
            for (int i = 1; i < 8; ++i) gv = (c.lane == i) ? g[rr][i] : gv;
            if (c.lane < 4) ipre[(size_t)row * 4 + c.lane] = gv + b_ig[c.lane];
            else { const float z = gv + b_fg[c.lane - 4]; logf[(size_t)row * 4 + c.lane - 4] = fminf(z, 0.f) - log1pf(expf(-fabsf(z))); }
        }
      }
    }
    for (int it = c.gw; it < I_IN + I_Q; it += c.NGW) {
        const bool isq = it >= I_IN; const int r = isq ? it - I_IN : it, nblk = isq ? 64 : 96, ldw = isq ? 2048 : INC; const float* W = isq ? a.in[12] : w_in;
        const int kb = r / nblk, nb = r % nblk, k0 = 64 * kb, n0 = 32 * nb, cl = c.lane & 31, kh = c.lane >> 5;
        { unsigned spins = 0; while (__hip_atomic_load(ccnt + (isq ? 96 : 0) + nb, __ATOMIC_RELAXED, __HIP_MEMORY_SCOPE_AGENT) < 16u && ++spins < (1u << 22)) __builtin_amdgcn_s_sleep(2); }
        const float am = fmaxf(__uint_as_float(__hip_atomic_load(cmx + (isq ? NPROJ : 0) + n0 + cl, __ATOMIC_RELAXED, __HIP_MEMORY_SCOPE_AGENT)), 1e-30f), inv = 127.f / am;
        if (kb == 0 && c.lane < 32) ((float*)(a.ws + (isq ? WS_SWQ : WS_SWN)))[n0 + cl] = am * (1.f / 127.f);
        unsigned char* W8 = a.ws + (isq ? WS_WQ : WS_WIN);
#pragma unroll 8
        for (int i = 0; i < 32; ++i) { const int kk = 2 * i + kh; scr[kk * 33 + cl] = W[(size_t)(k0 + kk) * ldw + n0 + cl] * inv; }
        WAVE_FENCE();
        const int c8 = c.lane & 7;
#pragma unroll
        for (int j = 0; j < 4; ++j) { const int n = (c.lane >> 3) + 8 * j; const float* sp = scr + (8 * c8) * 33 + n;
            uint2 o; o.x = (unsigned)((__float2int_rn(sp[0]) & 0xff) | ((__float2int_rn(sp[33]) & 0xff) << 8) | ((__float2int_rn(sp[66]) & 0xff) << 16) | (__float2int_rn(sp[99]) << 24));
            o.y = (unsigned)((__float2int_rn(sp[132]) & 0xff) | ((__float2int_rn(sp[165]) & 0xff) << 8) | ((__float2int_rn(sp[198]) & 0xff) << 16) | (__float2int_rn(sp[231]) << 24));
            *(uint2*)(W8 + (size_t)(n0 + n) * D_ + k0 + 8 * c8) = o; }
        WAVE_FENCE();
    }
}

typedef short s16x4 __attribute__((ext_vector_type(4)));
typedef unsigned u32x4 __attribute__((ext_vector_type(4)));
typedef unsigned u32x2 __attribute__((ext_vector_type(2)));
typedef float f32x4 __attribute__((ext_vector_type(4)));
typedef float f32x2_t __attribute__((ext_vector_type(2))); typedef __bf16 bf16x2_t __attribute__((ext_vector_type(2)));
__device__ __forceinline__ unsigned cvtpk(float lo, float hi) { const f32x2_t v = {lo, hi}; const bf16x2_t b = __builtin_convertvector(v, bf16x2_t); return __builtin_bit_cast(unsigned, b); }
__device__ __forceinline__ bf16x8 pack8(const f32x16& p, int b0) {
    union { unsigned u[4]; bf16x8 v; } x;
    x.u[0] = cvtpk(p[b0 + 0], p[b0 + 1]); x.u[1] = cvtpk(p[b0 + 2], p[b0 + 3]); x.u[2] = cvtpk(p[b0 + 4], p[b0 + 5]); x.u[3] = cvtpk(p[b0 + 6], p[b0 + 7]); return x.v;
}
__device__ __forceinline__ s16x4 tr_read(LAS unsigned char* p) { return __builtin_amdgcn_ds_read_tr16_b64_v4i16((LAS s16x4*)p); }
constexpr int AT_VP = 192, AT_OP = 144;
template <int T0> __device__ __forceinline__ void attn_task(LAS unsigned char* vl, const bf16* proj, unsigned char* ws, unsigned char* ob, int lane, int br, int b, int h, int d, int r, int m0) {
    const int col = lane & 31, hh = lane >> 5, i16 = lane & 15, grp = lane >> 4;
    const float CS = 0.125f * 1.4426950408889634f;
    const bf16* base = proj + (size_t)b * S_ * NPROJ + h * 64 + 8 * hh;
    const int tq = (m0 + col) * d + r;
    bf16x8 bq[4];
#pragma unroll
    for (int s = 0; s < 4; ++s) bq[s] = *(const bf16x8*)(base + (size_t)tq * NPROJ + C_QA + 16 * s);
    bf16x8 ka[5][4];
#pragma unroll
    for (int tau = T0; tau < 5; ++tau) { const bf16* kp = base + (size_t)((m0 - 128 + 32 * tau + col) * d + r) * NPROJ + C_KA;
#pragma unroll
        for (int s = 0; s < 4; ++s) ka[tau][s] = *(const bf16x8*)(kp + 16 * s); }
    f32x16 sc[5];
#pragma unroll
    for (int tau = T0; tau < 5; ++tau) {
        f32x16 acc;
#pragma unroll
        for (int i = 0; i < 16; ++i) acc[i] = 0.f;
#pragma unroll
        for (int s = 0; s < 4; ++s) acc = __builtin_amdgcn_mfma_f32_32x32x16_bf16(ka[tau][s], bq[s], acc, 0, 0, 0);
#pragma unroll
        for (int i = 0; i < 16; ++i) { const int cr = (i & 3) + 8 * (i >> 2) + 4 * hh;
            const bool ok = (tau == 0) ? (cr >= col) : ((tau == 4) ? (cr <= col) : true);
            sc[tau][i] = ok ? acc[i] * CS : -INFINITY; }
    }
    u32x4 vv[5][4];
#pragma unroll
    for (int tau = T0; tau < 5; ++tau)
#pragma unroll
        for (int q = 0; q < 4; ++q) { const int id = lane + 64 * q, row = id >> 3, ch = id & 7;
            vv[tau][q] = *(const u32x4*)(proj + (size_t)(b * S_ + (m0 - 128 + 32 * tau + row) * d + r) * NPROJ + C_VA + h * 64 + 8 * ch); }
    float mx = -INFINITY;
#pragma unroll
    for (int tau = T0; tau < 5; ++tau)
#pragma unroll
        for (int i = 0; i < 16; ++i) mx = fmaxf(mx, sc[tau][i]);
    mx = fmaxf(mx, __shfl_xor(mx, 32));
    float l = 0.f;
#pragma unroll
    for (int tau = T0; tau < 5; ++tau)
#pragma unroll
        for (int i = 0; i < 16; ++i) { const float p = __builtin_amdgcn_exp2f(sc[tau][i] - mx); sc[tau][i] = p; l += p; }
    l += __shfl_xor(l, 32);
    f32x16 o[2];
#pragma unroll
    for (int i = 0; i < 16; ++i) { o[0][i] = 0.f; o[1][i] = 0.f; }
#pragma unroll
    for (int tau = T0; tau < 5; ++tau) {
#pragma unroll
        for (int q = 0; q < 4; ++q) { const int id = lane + 64 * q, row = id >> 3, ch = id & 7; *(LAS u32x4*)(vl + row * AT_VP + ch * 16) = vv[tau][q]; }
        WAVE_FENCE();
        const bf16x8 pb0 = pack8(sc[tau], 0), pb1 = pack8(sc[tau], 8);
#pragma unroll
        for (int dt = 0; dt < 2; ++dt)
#pragma unroll
            for (int ks = 0; ks < 2; ++ks) {
                LAS unsigned char* ap = vl + (16 * ks + 4 * hh + (i16 >> 2)) * AT_VP + (32 * dt + 16 * (grp & 1) + 4 * (i16 & 3)) * 2;
                const s16x4 lo = tr_read(ap), hi = tr_read(ap + 8 * AT_VP);
                const bf16x8 av = {lo[0], lo[1], lo[2], lo[3], hi[0], hi[1], hi[2], hi[3]};
                o[dt] = __builtin_amdgcn_mfma_f32_32x32x16_bf16(av, ks ? pb1 : pb0, o[dt], 0, 0, 0);
            }
        WAVE_FENCE();
    }
#pragma unroll
    for (int dt = 0; dt < 2; ++dt)
#pragma unroll
        for (int q4 = 0; q4 < 4; ++q4) { u32x2 w; w.x = cvtpk(o[dt][4 * q4], o[dt][4 * q4 + 1]); w.y = cvtpk(o[dt][4 * q4 + 2], o[dt][4 * q4 + 3]);
            *(LAS u32x2*)(vl + col * AT_OP + (32 * dt + 8 * q4 + 4 * hh) * 2) = w; }
    WAVE_FENCE();
    bf16* pO = (br < 2) ? (bf16*)(ws + WS_PO01 + (size_t)br * 32 * MiB) : (bf16*)(ob + OUT_PO2);
#pragma unroll
    for (int q = 0; q < 4; ++q) { const int id = lane + 64 * q, row = id >> 3, ch = id & 7;
        const u32x4 v = *(LAS u32x4*)(vl + row * AT_OP + ch * 16);
        *(u32x4*)(pO + ((size_t)(b * S_ + (m0 + row) * d + r) * 8 + h) * 64 + 8 * ch) = v; }
    if (hh == 0) ((float2*)(ob + OUT_PML))[((size_t)br * T_ + b * S_ + tq) * 8 + h] = make_float2(mx, l);
    WAVE_FENCE();
}
__device__ __forceinline__ void ph_attn(const Ctx& c, const bf16* proj, unsigned char* ws, unsigned char* ob) {
    LAS unsigned char* vl = c.ldsl + c.wave * 6144;
    for (int task = c.gwx; task < 3 * B_ * 8 * 64; task += c.NGW) {
        const int bh = task / 192, rem = task % 192, br = rem >> 6, rq = rem & 63;
        const int dsh = 2 * br, d = 1 << dsh, nqsh = 6 - dsh;
        const int r = rq >> nqsh, m0 = (rq & ((1 << nqsh) - 1)) * 32, b = bh >> 3, h = bh & 7;
        switch (m0 >= 128 ? 0 : (128 - m0) >> 5) {
            case 0: attn_task<0>(vl, proj, ws, ob, c.lane, br, b, h, d, r, m0); break;
            case 1: attn_task<1>(vl, proj, ws, ob, c.lane, br, b, h, d, r, m0); break;
            case 2: attn_task<2>(vl, proj, ws, ob, c.lane, br, b, h, d, r, m0); break;
            case 3: attn_task<3>(vl, proj, ws, ob, c.lane, br, b, h, d, r, m0); break;
            default: attn_task<4>(vl, proj, ws, ob, c.lane, br, b, h, d, r, m0); break;
        }
    }
}
__device__ __forceinline__ void ph_attn_merge(const Ctx& c, const unsigned char* ws, const unsigned char* ob, bf16* concat) {
    const int lane = c.lane, h = lane >> 3, c8 = lane & 7;
    const float2* pML = (const float2*)(ob + OUT_PML);
    constexpr int TB = 4;
    for (int t0 = c.gw * TB; t0 < T_; t0 += c.NGW * TB) {
        uint4 v[TB][3]; float2 ml[TB][3];
#pragma unroll
        for (int i = 0; i < TB; ++i)
#pragma unroll
            for (int br = 0; br < 3; ++br) { const bf16* pO = (br < 2) ? (const bf16*)(ws + WS_PO01 + (size_t)br * 32 * MiB) : (const bf16*)(ob + OUT_PO2);
                v[i][br] = *(const uint4*)(pO + ((size_t)(t0 + i) * 8 + h) * 64 + 8 * c8); ml[i][br] = pML[((size_t)br * T_ + t0 + i) * 8 + h]; }
#pragma unroll
        for (int i = 0; i < TB; ++i) {
            const float M = fmaxf(ml[i][0].x, fmaxf(ml[i][1].x, ml[i][2].x));
            const float w0 = __builtin_amdgcn_exp2f(ml[i][0].x - M), w1 = __builtin_amdgcn_exp2f(ml[i][1].x - M), w2 = __builtin_amdgcn_exp2f(ml[i][2].x - M);
            const float inv = 1.f / (ml[i][0].y * w0 + ml[i][1].y * w1 + ml[i][2].y * w2);
            const unsigned* a0 = (const unsigned*)&v[i][0]; const unsigned* a1 = (const unsigned*)&v[i][1]; const unsigned* a2 = (const unsigned*)&v[i][2];
            uint4 o; unsigned* op = (unsigned*)&o;
#pragma unroll
            for (int e = 0; e < 4; ++e) {
                const float lo = (w0 * __uint_as_float(a0[e] << 16) + w1 * __uint_as_float(a1[e] << 16) + w2 * __uint_as_float(a2[e] << 16)) * inv;
                const float hi = (w0 * __uint_as_float(a0[e] & 0xffff0000u) + w1 * __uint_as_float(a1[e] & 0xffff0000u) + w2 * __uint_as_float(a2[e] & 0xffff0000u)) * inv;
                op[e] = pk2(lo, hi);
            }
            *(uint4*)(concat + (size_t)(t0 + i) * D_ + h * 64 + 8 * c8) = o;
        }
    }
}
constexpr int ML_XP = 272, ML_VP = 320;
struct ChunkGates { float bc0, bc1, u0, u1, incl; };
__device__ __forceinline__ ChunkGates chunk_gates(const float* ipre, const float* logf, int bt0, int h, int lane) {
    const float lf0 = logf[(size_t)(bt0 + 2 * lane) * 4 + h], lf1 = logf[(size_t)(bt0 + 2 * lane + 1) * 4 + h];
    const float ip0 = ipre[(size_t)(bt0 + 2 * lane) * 4 + h], ip1 = ipre[(size_t)(bt0 + 2 * lane + 1) * 4 + h];
    float incl = lf0 + lf1;
#pragma unroll
    for (int o = 1; o < 64; o <<= 1) { const float n = __shfl_up(incl, o); if (lane >= o) incl += n; }
    ChunkGates g; g.incl = incl; g.bc1 = incl; g.bc0 = incl - lf1; g.u0 = ip0 - g.bc0; g.u1 = ip1 - g.bc1; return g;
}
__device__ __forceinline__ bf16x8 tr_pair(LAS unsigned char* p, int hi_off) { const s16x4 lo = tr_read(p), hi = tr_read(p + hi_off); return (bf16x8){lo[0], lo[1], lo[2], lo[3], hi[0], hi[1], hi[2], hi[3]}; }

__device__ __forceinline__ void ph_m1(const Ctx& c, const Args& a, const bf16* proj, const float* ipre, const float* logf, bf16* mq, bf16* mk, unsigned char* ob) {
    const float* conv_w = a.in[2]; const float* conv_b = a.in[3];
    const bf16* WmT = (const bf16*)(a.ws + WS_WMT);
    bf16* Dbuf = (bf16*)(ob + OUT_DBUF); float* nloc = (float*)(ob + OUT_NLOC); float* csc = (float*)(ob + OUT_CSC);
    LAS unsigned char* XC = c.ldsl; LAS unsigned char* KS = c.ldsl + 34816; LAS unsigned char* VS = c.ldsl + 75776;
    LAS float* wkt = (LAS float*)(c.ldsl + 116736); LAS float* nred = (LAS float*)(c.ldsl + 117760);
    const int tid = c.tid, lane = c.lane, wave = c.wave, col = lane & 31, hh = lane >> 5, i16 = lane & 15, grp = lane >> 4;
    for (int u = blockIdx.x; u < 1024; u += c.G) {
        const int bh = u >> 4, cc = u & 15, b = bh >> 2, h = bh & 3, bt0 = b * S_ + cc * 128;
        if (wave == 0) {
            const ChunkGates g = chunk_gates(ipre, logf, bt0, h, lane);
            const float umax = wave_max(fmaxf(g.u0, g.u1)), bL = __shfl(g.incl, 63);
            wkt[2 * lane] = expf(g.u0 - umax); wkt[2 * lane + 1] = expf(g.u1 - umax);
            if (lane == 0) { csc[2 * u] = bL; csc[2 * u + 1] = bL + umax; }
        }
        {
            const int ch = tid & 127, ts = (tid >> 7) * 32, cidx = h * 128 + ch;
            const float w0 = conv_w[cidx], w1 = conv_w[512 + cidx], w2 = conv_w[1024 + cidx], w3 = conv_w[1536 + cidx], cb = conv_b[cidx];
            const bf16* xp = proj + (size_t)bt0 * NPROJ + C_XM + cidx;
            const int tseq = cc * 128 + ts;
            float p3 = (tseq - 3 >= 0) ? bf2f(xp[(ptrdiff_t)(ts - 3) * NPROJ]) : 0.f, p2 = (tseq - 2 >= 0) ? bf2f(xp[(ptrdiff_t)(ts - 2) * NPROJ]) : 0.f, p1 = (tseq - 1 >= 0) ? bf2f(xp[(ptrdiff_t)(ts - 1) * NPROJ]) : 0.f;
            for (int i = 0; i < 32; ++i) {
                const float cur = bf2f(xp[(size_t)(ts + i) * NPROJ]);
                const float acc = cb + w0 * p3 + w1 * p2 + w2 * p1 + w3 * cur;
                *(LAS bf16*)(XC + (ts + i) * ML_XP + ch * 2) = (bf16)f2bf(acc / (1.f + expf(-acc)));
                p3 = p2; p2 = p1; p1 = cur;
            }
        }
#pragma unroll
        for (int q = 0; q < 4; ++q) { const int id = tid + 512 * q, row = id >> 4, ch = id & 15;
            *(LAS u32x4*)(VS + row * ML_VP + ch * 16) = *(const u32x4*)(proj + (size_t)(bt0 + row) * NPROJ + C_VM + h * 128 + 8 * ch); }
        __syncthreads();
        {
            const int tokt = wave & 3, mat = wave >> 2, tok = 32 * tokt + col;
            bf16x8 xf[8];
#pragma unroll
            for (int s2 = 0; s2 < 8; ++s2) xf[s2] = *(LAS bf16x8*)(XC + tok * ML_XP + (16 * s2 + 8 * hh) * 2);
            const float wkl = wkt[tok];
            const bf16* WT = WmT + (size_t)(mat * 4 + h) * 128 * 128 + (size_t)col * 128 + 8 * hh;
            bf16* og = (mat ? mk : mq) + (size_t)(bt0 + tok) * 512 + h * 128;
#pragma unroll
            for (int ft = 0; ft < 4; ++ft) {
                const bf16* wp = WT + (size_t)ft * 32 * 128; asm volatile("" : "+v"(wp));
                f32x16 acc;
#pragma unroll
                for (int i = 0; i < 16; ++i) acc[i] = 0.f;
#pragma unroll
                for (int s2 = 0; s2 < 8; ++s2) { const bf16x8 af = *(const bf16x8*)(wp + 16 * s2); acc = __builtin_amdgcn_mfma_f32_32x32x16_bf16(af, xf[s2], acc, 0, 0, 0); }
#pragma unroll
                for (int q4 = 0; q4 < 4; ++q4) {
                    const int f0 = 32 * ft + 8 * q4 + 4 * hh;
                    const float sc = mat ? 1.f : 0.08838834764831845f;
                    const float v0 = acc[4 * q4] * sc, v1 = acc[4 * q4 + 1] * sc, v2 = acc[4 * q4 + 2] * sc, v3 = acc[4 * q4 + 3] * sc;
                    u32x2 w; w.x = cvtpk(v0, v1); w.y = cvtpk(v2, v3);
                    *(u32x2*)(og + f0) = w;
                    if (mat) { u32x2 ws2; ws2.x = cvtpk(v0 * wkl, v1 * wkl); ws2.y = cvtpk(v2 * wkl, v3 * wkl); *(LAS u32x2*)(KS + tok * ML_VP + f0 * 2) = ws2; }
                }
            }
        }
        __syncthreads();
        {
            const int vt = wave >> 1, kt0 = 2 * (wave & 1);
            f32x16 d0, d1;
#pragma unroll
            for (int i = 0; i < 16; ++i) { d0[i] = 0.f; d1[i] = 0.f; }
            const int roff = (8 * hh + (i16 >> 2)) * ML_VP + (16 * (grp & 1) + 4 * (i16 & 3)) * 2;
#pragma unroll
            for (int st = 0; st < 8; ++st) {
                const bf16x8 av = tr_pair(VS + st * 16 * ML_VP + roff + vt * 64, 4 * ML_VP);
                const bf16x8 b0 = tr_pair(KS + st * 16 * ML_VP + roff + kt0 * 64, 4 * ML_VP), b1 = tr_pair(KS + st * 16 * ML_VP + roff + (kt0 + 1) * 64, 4 * ML_VP);
                d0 = __builtin_amdgcn_mfma_f32_32x32x16_bf16(av, b0, d0, 0, 0, 0); d1 = __builtin_amdgcn_mfma_f32_32x32x16_bf16(av, b1, d1, 0, 0, 0);
            }
            bf16* dp = Dbuf + (size_t)u * 16384 + (size_t)(32 * vt + 4 * hh) * 128 + 32 * kt0 + col;
#pragma unroll
            for (int i = 0; i < 16; ++i) { const int vr = (i & 3) + 8 * (i >> 2); dp[vr * 128] = (bf16)f2bf(d0[i]); dp[vr * 128 + 32] = (bf16)f2bf(d1[i]); }
            const int k = tid & 127, part = tid >> 7; float sacc = 0.f;
            for (int s2 = 0; s2 < 32; ++s2) sacc += bf2f(*(LAS bf16*)(KS + (32 * part + s2) * ML_VP + k * 2));
            nred[part * 128 + k] = sacc;
        }
        __syncthreads();
        if (tid < 128) nloc[(size_t)u * 128 + tid] = nred[tid] + nred[128 + tid] + nred[256 + tid] + nred[384 + tid];
        __syncthreads();
    }
}

__device__ __forceinline__ void ph_m3(const Ctx& c, const Args& a, const bf16* proj, const float* ipre, const float* logf, const bf16* mq, const bf16* mk, const unsigned char* ob, bf16* concat) {
    const float* mh_g = a.in[8];
    const bf16* Dbuf = (const bf16*)(ob + OUT_DBUF); const float* nloc = (const float*)(ob + OUT_NLOC); const float* csc = (const float*)(ob + OUT_CSC);
    LAS unsigned char* VS = c.ldsl; LAS unsigned char* CS = c.ldsl + 40960; LAS unsigned char* OST = CS; LAS unsigned char* KS = c.ldsl + 81920;
    LAS float* utab = (LAS float*)(c.ldsl + 75776); LAS float* mxt = utab + 128; LAS float* wit = utab + 256; LAS float* ednt = utab + 384; LAS float* nvec = utab + 512;
    LAS float* nrm = (LAS float*)(c.ldsl + 78848);
    LAS float* coef = (LAS float*)(c.ldsl + 116736);
    const int tid = c.tid, lane = c.lane, wave = c.wave, col = lane & 31, hh = lane >> 5, i16 = lane & 15, grp = lane >> 4;
    for (int ui = blockIdx.x; ui < 1024; ui += c.G) {
        const int bh = ui >> 4, cc = ((ui & 15) + 5 * (bh >> 4) + bh) & 15, b = bh >> 2, h = bh & 3, bt0 = b * S_ + cc * 128;
        float mc = 0.f;
        for (int c2 = 0; c2 < cc; ++c2) mc = fmaxf(csc[2 * (bh * 16 + c2)] + mc, csc[2 * (bh * 16 + c2) + 1]);
        const int tt = wave & 3, vh = wave >> 2, t = 32 * tt + col;
        bf16x8 bq[8];
        { const bf16* qp = mq + (size_t)(bt0 + t) * 512 + h * 128 + 8 * hh;
#pragma unroll
          for (int s2 = 0; s2 < 8; ++s2) bq[s2] = *(const bf16x8*)(qp + 16 * s2); }
        if (tid < 16) { float suf = 0.f; for (int c2 = cc - 1; c2 > tid; --c2) suf += csc[2 * (bh * 16 + c2)];
            coef[tid] = (tid < cc) ? expf(csc[2 * (bh * 16 + tid) + 1] + suf - mc) : 0.f; }
        if (wave == 1) {
            const ChunkGates g = chunk_gates(ipre, logf, bt0, h, lane);
            float incm = fmaxf(g.u0, g.u1);
#pragma unroll
            for (int o = 1; o < 64; o <<= 1) { const float n = __shfl_up(incm, o); if (lane >= o) incm = fmaxf(incm, n); }
            float exm = __shfl_up(incm, 1); if (lane == 0) exm = -INFINITY;
            const float M0 = fmaxf(mc, fmaxf(exm, g.u0)), M1 = fmaxf(mc, incm);
            utab[2 * lane] = g.u0; utab[2 * lane + 1] = g.u1; mxt[2 * lane] = M0; mxt[2 * lane + 1] = M1;
            wit[2 * lane] = expf(mc - M0); wit[2 * lane + 1] = expf(mc - M1); ednt[2 * lane] = expf(-(g.bc0 + M0)); ednt[2 * lane + 1] = expf(-(g.bc1 + M1));
        }
#pragma unroll
        for (int q = 0; q < 4; ++q) { const int id = tid + 512 * q, row = id >> 4, ch = id & 15;
            *(LAS u32x4*)(VS + row * ML_VP + ch * 16) = *(const u32x4*)(proj + (size_t)(bt0 + row) * NPROJ + C_VM + h * 128 + 8 * ch);
            *(LAS u32x4*)(KS + row * ML_XP + ch * 16) = *(const u32x4*)(mk + (size_t)(bt0 + row) * 512 + h * 128 + 8 * ch); }
        __syncthreads();
#pragma unroll
        for (int q = 0; q < 4; ++q) {
            const int id = tid + 512 * q, row = id >> 4, ch = id & 15;
            float acc[8] = {0.f, 0.f, 0.f, 0.f, 0.f, 0.f, 0.f, 0.f};
            for (int c2 = 0; c2 < cc; ++c2) {
                const float cf = coef[c2]; const u32x4 dv = *(const u32x4*)(Dbuf + (size_t)(bh * 16 + c2) * 16384 + row * 128 + 8 * ch);
                acc[0] += cf * __uint_as_float(dv.x << 16); acc[1] += cf * __uint_as_float(dv.x & 0xffff0000u); acc[2] += cf * __uint_as_float(dv.y << 16); acc[3] += cf * __uint_as_float(dv.y & 0xffff0000u);
                acc[4] += cf * __uint_as_float(dv.z << 16); acc[5] += cf * __uint_as_float(dv.z & 0xffff0000u); acc[6] += cf * __uint_as_float(dv.w << 16); acc[7] += cf * __uint_as_float(dv.w & 0xffff0000u);
            }
            u32x4 o; o.x = cvtpk(acc[0], acc[1]); o.y = cvtpk(acc[2], acc[3]); o.z = cvtpk(acc[4], acc[5]); o.w = cvtpk(acc[6], acc[7]);
            *(LAS u32x4*)(CS + row * ML_XP + ch * 16) = o;
        }
        if (tid < 128) { float nv = 0.f; for (int c2 = 0; c2 < cc; ++c2) nv += coef[c2] * nloc[(size_t)(bh * 16 + c2) * 128 + tid]; nvec[tid] = nv; }
        __syncthreads();
        const float Mt = mxt[t], wint = wit[t], edn = ednt[t];
        f32x16 acc[2];
#pragma unroll
        for (int vtl = 0; vtl < 2; ++vtl) {
#pragma unroll
            for (int i = 0; i < 16; ++i) acc[vtl][i] = 0.f;
#pragma unroll
            for (int s2 = 0; s2 < 8; ++s2) { const bf16x8 af = *(LAS bf16x8*)(CS + (64 * vh + 32 * vtl + col) * ML_XP + (16 * s2 + 8 * hh) * 2); acc[vtl] = __builtin_amdgcn_mfma_f32_32x32x16_bf16(af, bq[s2], acc[vtl], 0, 0, 0); }
#pragma unroll
            for (int i = 0; i < 16; ++i) acc[vtl][i] *= wint;
        }
        float qn = 0.f;
#pragma unroll
        for (int s2 = 0; s2 < 8; ++s2) {
            const f32x4 n0 = *(LAS f32x4*)(nvec + 16 * s2 + 8 * hh), n1 = *(LAS f32x4*)(nvec + 16 * s2 + 8 * hh + 4);
            const unsigned* qw = (const unsigned*)&bq[s2];
            qn += __uint_as_float(qw[0] << 16) * n0[0] + __uint_as_float(qw[0] & 0xffff0000u) * n0[1] + __uint_as_float(qw[1] << 16) * n0[2] + __uint_as_float(qw[1] & 0xffff0000u) * n0[3];
            qn += __uint_as_float(qw[2] << 16) * n1[0] + __uint_as_float(qw[2] & 0xffff0000u) * n1[1] + __uint_as_float(qw[3] << 16) * n1[2] + __uint_as_float(qw[3] & 0xffff0000u) * n1[3];
        }
        qn += __shfl_xor(qn, 32);
        float dsum = 0.f;
        for (int st = 0; st <= tt; ++st) {
            f32x16 sT;
#pragma unroll
            for (int i = 0; i < 16; ++i) sT[i] = 0.f;
#pragma unroll
            for (int s2 = 0; s2 < 8; ++s2) { const bf16x8 kf = *(LAS bf16x8*)(KS + (32 * st + col) * ML_XP + (16 * s2 + 8 * hh) * 2); sT = __builtin_amdgcn_mfma_f32_32x32x16_bf16(kf, bq[s2], sT, 0, 0, 0); }
            f32x16 p;
#pragma unroll
            for (int q4 = 0; q4 < 4; ++q4) {
                const f32x4 uu = *(LAS f32x4*)(utab + 32 * st + 8 * q4 + 4 * hh);
#pragma unroll
                for (int e = 0; e < 4; ++e) { const int cr = 8 * q4 + 4 * hh + e; const bool ok = (st < tt) || (cr <= col);
                    const float pv = ok ? expf(uu[e] - Mt) * sT[4 * q4 + e] : 0.f; p[4 * q4 + e] = pv; dsum += pv; }
            }
            const bf16x8 pb0 = pack8(p, 0), pb1 = pack8(p, 8);
#pragma unroll
            for (int vtl = 0; vtl < 2; ++vtl)
#pragma unroll
                for (int ks = 0; ks < 2; ++ks) {
                    const bf16x8 av = tr_pair(VS + (32 * st + 16 * ks + 4 * hh + (i16 >> 2)) * ML_VP + (64 * vh + 32 * vtl + 16 * (grp & 1) + 4 * (i16 & 3)) * 2, 8 * ML_VP);
                    acc[vtl] = __builtin_amdgcn_mfma_f32_32x32x16_bf16(av, ks ? pb1 : pb0, acc[vtl], 0, 0, 0);
                }
        }
        dsum += __shfl_xor(dsum, 32);
        const float den = wint * qn + dsum, inv = 1.f / fmaxf(fabsf(den), edn);
        float s1 = 0.f, s2q = 0.f;
#pragma unroll
        for (int vtl = 0; vtl < 2; ++vtl)
#pragma unroll
            for (int i = 0; i < 16; ++i) { const float hv = acc[vtl][i] * inv; acc[vtl][i] = hv; s1 += hv; s2q += hv * hv; }
        s1 += __shfl_xor(s1, 32); s2q += __shfl_xor(s2q, 32);
        if (hh == 0) { nrm[(vh * 128 + t) * 2] = s1; nrm[(vh * 128 + t) * 2 + 1] = s2q; }
        __syncthreads();
        s1 += nrm[((vh ^ 1) * 128 + t) * 2]; s2q += nrm[((vh ^ 1) * 128 + t) * 2 + 1];
        const float mu = s1 * (1.f / 128.f), var = fmaxf(s2q * (1.f / 128.f) - mu * mu, 0.f), rstd = 1.f / sqrtf(var + LN_EPS);
        const bf16* omp = proj + (size_t)(bt0 + t) * NPROJ + C_OM + h * 128;
#pragma unroll
        for (int vtl = 0; vtl < 2; ++vtl)
#pragma unroll
            for (int q4 = 0; q4 < 4; ++q4) {
                const int v0 = 64 * vh + 32 * vtl + 8 * q4 + 4 * hh;
                const u32x2 ow = *(const u32x2*)(omp + v0); const f32x4 gg = *(const f32x4*)(mh_g + h * 128 + v0);
                const float o0 = __uint_as_float(ow.x << 16), o1 = __uint_as_float(ow.x & 0xffff0000u), o2 = __uint_as_float(ow.y << 16), o3 = __uint_as_float(ow.y & 0xffff0000u);
                const float r0 = (acc[vtl][4 * q4] - mu) * rstd * gg[0] / (1.f + expf(-o0)), r1 = (acc[vtl][4 * q4 + 1] - mu) * rstd * gg[1] / (1.f + expf(-o1));
                const float r2 = (acc[vtl][4 * q4 + 2] - mu) * rstd * gg[2] / (1.f + expf(-o2)), r3 = (acc[vtl][4 * q4 + 3] - mu) * rstd * gg[3] / (1.f + expf(-o3));
                u32x2 w; w.x = cvtpk(r0, r1); w.y = cvtpk(r2, r3);
                *(LAS u32x2*)(OST + t * ML_XP + v0 * 2) = w;
            }
        __syncthreads();
#pragma unroll
        for (int q = 0; q < 4; ++q) { const int id = tid + 512 * q, row = id >> 4, ch = id & 15;
            *(u32x4*)(concat + (size_t)(bt0 + row) * D_ + 512 + h * 128 + 8 * ch) = *(LAS u32x4*)(OST + row * ML_XP + ch * 16); }
        __syncthreads();
    }
}
__device__ __forceinline__ void ph_ln1(const Ctx& c, const bf16* y1, const float* g, const float* bb, float2* st1, unsigned* xq, float* sx) {
    constexpr int RB = 4;
    for (int row0 = c.gw * RB; row0 < T_; row0 += c.NGW * RB) {
      uint2 yv[RB][4];
#pragma unroll
      for (int r = 0; r < RB; ++r) { const uint2* p = (const uint2*)(y1 + (size_t)(row0 + r) * D_) + c.lane;
#pragma unroll
          for (int j = 0; j < 4; ++j) yv[r][j] = p[64 * j]; }
#pragma unroll
      for (int r = 0; r < RB; ++r) {
        const int row = row0 + r; float4 v[4]; float s = 0.f;
#pragma unroll
        for (int j = 0; j < 4; ++j) { const uint2 w = yv[r][j]; v[j].x = __uint_as_float(w.x << 16); v[j].y = __uint_as_float(w.x & 0xffff0000u); v[j].z = __uint_as_float(w.y << 16); v[j].w = __uint_as_float(w.y & 0xffff0000u);
            s += v[j].x + v[j].y + v[j].z + v[j].w; }
        const float mu = wave_sum(s) * (1.f / D_); float q = 0.f;
#pragma unroll
        for (int j = 0; j < 4; ++j) { v[j].x -= mu; v[j].y -= mu; v[j].z -= mu; v[j].w -= mu; q += v[j].x * v[j].x + v[j].y * v[j].y + v[j].z * v[j].z + v[j].w * v[j].w; }
        const float rstd = 1.f / sqrtf(wave_sum(q) * (1.f / D_) + LN_EPS);
        float4 ov[4]; float am = 0.f;
#pragma unroll
        for (int j = 0; j < 4; ++j) { const int cc = (64 * j + c.lane) * 4; const float4 gg = *(const float4*)(g + cc), b4 = *(const float4*)(bb + cc);
            float4 o; o.x = v[j].x * rstd * gg.x + b4.x; o.y = v[j].y * rstd * gg.y + b4.y; o.z = v[j].z * rstd * gg.z + b4.z; o.w = v[j].w * rstd * gg.w + b4.w;
            ov[j] = o; am = fmaxf(am, fmaxf(fmaxf(fabsf(o.x), fabsf(o.y)), fmaxf(fabsf(o.z), fabsf(o.w)))); }
        am = fmaxf(wave_max(am), 1e-30f); const float inv = 127.f / am;
        if (c.lane == 0) { sx[row] = am * (1.f / 127.f); st1[row] = make_float2(mu, rstd); }
#pragma unroll
        for (int j = 0; j < 4; ++j) xq[(size_t)row * 256 + 64 * j + c.lane] = (unsigned)((__float2int_rn(ov[j].x * inv) & 0xff) | ((__float2int_rn(ov[j].y * inv) & 0xff) << 8) | ((__float2int_rn(ov[j].z * inv) & 0xff) << 16) | (__float2int_rn(ov[j].w * inv) << 24));
      }
    }
}
__device__ __forceinline__ int kmax(int a, int b) { int r; asm("v_max_f32 %0, %1, %2" : "=v"(r) : "v"(a), "v"(b)); return r; }
__device__ __forceinline__ int kmin(int a, int b) { int r; asm("v_min_f32 %0, %1, %2" : "=v"(r) : "v"(a), "v"(b)); return r; }
__device__ __forceinline__ void ced(int& a, int& b) { const int hi = kmax(a, b), lo = kmin(a, b); a = hi; b = lo; }
__device__ __forceinline__ void sort16_desc(int (&k)[16]) {
    ced(k[0], k[1]); ced(k[2], k[3]); ced(k[4], k[5]); ced(k[6], k[7]); ced(k[8], k[9]); ced(k[10], k[11]); ced(k[12], k[13]); ced(k[14], k[15]);
    ced(k[0], k[2]); ced(k[1], k[3]); ced(k[4], k[6]); ced(k[5], k[7]); ced(k[8], k[10]); ced(k[9], k[11]); ced(k[12], k[14]); ced(k[13], k[15]);
    ced(k[1], k[2]); ced(k[5], k[6]); ced(k[0], k[4]); ced(k[3], k[7]); ced(k[9], k[10]); ced(k[13], k[14]); ced(k[8], k[12]); ced(k[11], k[15]);
    ced(k[2], k[6]); ced(k[1], k[5]); ced(k[10], k[14]); ced(k[9], k[13]); ced(k[0], k[8]); ced(k[7], k[15]);
    ced(k[2], k[4]); ced(k[3], k[5]); ced(k[10], k[12]); ced(k[11], k[13]);
    ced(k[1], k[2]); ced(k[3], k[4]); ced(k[5], k[6]); ced(k[9], k[10]); ced(k[11], k[12]); ced(k[13], k[14]);
    ced(k[4], k[12]); ced(k[2], k[10]); ced(k[6], k[14]); ced(k[1], k[9]); ced(k[5], k[13]); ced(k[3], k[11]);
    ced(k[4], k[8]); ced(k[6], k[10]); ced(k[5], k[9]); ced(k[7], k[11]);
    ced(k[2], k[4]); ced(k[6], k[8]); ced(k[10], k[12]); ced(k[3], k[5]); ced(k[7], k[9]); ced(k[11], k[13]);
    ced(k[1], k[2]); ced(k[3], k[4]); ced(k[5], k[6]); ced(k[7], k[8]); ced(k[9], k[10]); ced(k[11], k[12]); ced(k[13], k[14]);
}
__device__ __forceinline__ void merge16_desc(int (&k)[16]) {
#pragma unroll
    for (int stride = 8; stride > 0; stride >>= 1)
#pragma unroll
        for (int i = 0; i < 16; ++i) { const int j = i ^ stride; if (j > i) ced(k[i], k[j]); }
}
__device__ __forceinline__ void top16_of(int (&a)[16], const int (&b)[16]) {
#pragma unroll
    for (int i = 0; i < 16; ++i) a[i] = kmax(a[i], b[15 - i]);
    merge16_desc(a);
}
__device__ __forceinline__ void top16_tile(const f32x16& acc, int kt, int hh, int (&top)[16]) {
    int g[16];
#pragma unroll
    for (int i = 0; i < 16; ++i) { const int idx = 32 * kt + (i & 3) + 8 * (i >> 2) + 4 * hh; g[i] = (__float_as_int(acc[i]) & ~127) | idx; }
    sort16_desc(g);
    if (kt == 0) {
#pragma unroll
        for (int i = 0; i < 16; ++i) top[i] = g[i];
    } else top16_of(top, g);
}
__device__ __forceinline__ void ph_route(const Ctx& c, const bf16* qry, const bf16* SK, unsigned* eidx, float* gate) {
    const int lane = c.lane, col = lane & 31, hh = lane >> 5;
    pg8::StaticOrder S; S.init(T_, 2048, c.G, (int)blockIdx.x); pg8::Unit u;
    for (int ui = 0; S.next(ui, u); ++ui) {
        const int h = u.pn, t0 = u.pm * 256 + 32 * c.wave;
        int top[2][16];
#pragma unroll
        for (int p = 0; p < 2; ++p) {
            bf16x8 bq[8];
            const bf16* qrow = qry + (size_t)(t0 + col) * 2048 + h * 256 + p * 128 + 8 * hh;
#pragma unroll
            for (int s = 0; s < 8; ++s) bq[s] = *(const bf16x8*)(qrow + 16 * s);
            const bf16* krow = SK + ((size_t)(h * 2 + p) * 128 + col) * 128 + 8 * hh;
#pragma unroll
            for (int kt = 0; kt < 4; ++kt) {
                f32x16 acc;
                const bf16* kr = krow + (size_t)kt * 32 * 128; asm volatile("" : "+v"(kr));
#pragma unroll
                for (int i = 0; i < 16; ++i) acc[i] = 0.f;
#pragma unroll
                for (int s = 0; s < 8; ++s) { const bf16x8 ka = *(const bf16x8*)(kr + 16 * s); acc = __builtin_amdgcn_mfma_f32_32x32x16_bf16(ka, bq[s], acc, 0, 0, 0); }
                top16_tile(acc, kt, hh, top[p]);
            }
            { int g[16];
#pragma unroll
              for (int i = 0; i < 16; ++i) g[i] = __shfl_xor(top[p][i], 32);
              top16_of(top[p], g); }
        }
        float f1[16], f2[16]; int i1[16], i2[16];
#pragma unroll
        for (int i = 0; i < 16; ++i) { f1[i] = __int_as_float(top[0][i]); i1[i] = (top[0][i] & 127) << 7; f2[i] = __int_as_float(top[1][i]); i2[i] = top[1][i] & 127; }
#define CK(a, b) ((__float_as_int(f1[a] + f2[b]) & ~0x3fff) | i1[a] | i2[b])
        int k0[16], k1[16], k2[16];
#pragma unroll
        for (int b = 0; b < 16; ++b) k0[b] = CK(0, b);
#pragma unroll
        for (int b = 0; b < 8; ++b) { k1[b] = CK(1, b); k1[8 + b] = CK(15 - b, 0); }
        merge16_desc(k1);
        k2[0] = CK(2, 0); k2[1] = CK(2, 1); k2[2] = CK(2, 2); k2[3] = CK(2, 3); k2[4] = CK(2, 4); k2[5] = CK(3, 0); k2[6] = CK(3, 1); k2[7] = CK(3, 2); k2[8] = CK(3, 3);
        k2[9] = CK(4, 0); k2[10] = CK(4, 1); k2[11] = CK(4, 2); k2[12] = CK(5, 0); k2[13] = CK(5, 1); k2[14] = CK(6, 0); k2[15] = CK(6, 1);
        sort16_desc(k2);
        k2[15] = kmax(k2[15], CK(7, 0)); k2[14] = kmax(k2[14], CK(7, 1));
        merge16_desc(k2);
        top16_of(k0, k1);
        top16_of(k0, k2);
#undef CK
        int p0[16];
#pragma unroll
        for (int i = 0; i < 16; ++i) { p0[i] = k0[i] & 0x3fff; k0[i] &= ~0x3fff; }
        float e[16]; float den = 0.f; const float m = __int_as_float(k0[0]);
#pragma unroll
        for (int i = 0; i < 16; ++i) { e[i] = __builtin_amdgcn_exp2f((__int_as_float(k0[i]) - m) * 1.4426950408889634f); den += e[i]; }
        const float inv = 1.f / den;
        float4 og[2];
        og[0].x = (hh ? e[8] : e[0]) * inv; og[0].y = (hh ? e[9] : e[1]) * inv; og[0].z = (hh ? e[10] : e[2]) * inv; og[0].w = (hh ? e[11] : e[3]) * inv;
        og[1].x = (hh ? e[12] : e[4]) * inv; og[1].y = (hh ? e[13] : e[5]) * inv; og[1].z = (hh ? e[14] : e[6]) * inv; og[1].w = (hh ? e[15] : e[7]) * inv;
        const size_t ob = (size_t)(t0 + col) * 128 + h * 16 + hh * 8;
        *(float4*)(gate + ob) = og[0]; *(float4*)(gate + ob + 4) = og[1];
        { uint4 o;
            o.x = (unsigned)(hh ? p0[4] : p0[0]) | ((unsigned)(hh ? p0[12] : p0[8]) << 16); o.y = (unsigned)(hh ? p0[5] : p0[1]) | ((unsigned)(hh ? p0[13] : p0[9]) << 16);
            o.z = (unsigned)(hh ? p0[6] : p0[2]) | ((unsigned)(hh ? p0[14] : p0[10]) << 16); o.w = (unsigned)(hh ? p0[7] : p0[3]) | ((unsigned)(hh ? p0[15] : p0[11]) << 16);
            *(uint4*)(eidx + ((size_t)(t0 + col) * 8 + h) * 8 + 4 * hh) = o; }
    }
}
typedef __bf16 v2bf __attribute__((ext_vector_type(2)));
__device__ __forceinline__ float dot2bf(unsigned a, unsigned b, float c) { return __builtin_amdgcn_fdot2_f32_bf16(__builtin_bit_cast(v2bf, a), __builtin_bit_cast(v2bf, b), c, false); }
template <int CTRL> __device__ __forceinline__ float dppf(float v) { return __int_as_float(__builtin_amdgcn_mov_dpp(__float_as_int(v), CTRL, 0xF, 0xF, true)); }
__device__ __forceinline__ float sum8(float v) { v += dppf<0xB1>(v); v += dppf<0x4E>(v); v += dppf<0x141>(v); return v; }
struct SliceMap { int j, sw, nsw; };
__device__ __forceinline__ SliceMap slice_map(const Ctx& c, unsigned* bar) {
    volatile LAS unsigned* st = (volatile LAS unsigned*)(c.ldsl + MISC_OFF);
    if (c.tid == 0) { unsigned even = (c.G % 8 == 0) ? 1u : 0u;
        for (unsigned j = 0; j < 16; ++j) { const unsigned cnt = xb_ld(&bar[XB_XCNT(j)]); if (cnt != (j < 8 ? (unsigned)c.G / 8u : 0u)) even = 0u; }
        st[4] = even; }
    __syncthreads();
    SliceMap m; m.nsw = c.G;
    if (st[4]) { m.j = (int)st[2]; m.sw = (int)st[3] * NWAVES + c.wave; }
    else { const bool sl = (c.G % 8) == 0; m.j = sl ? (int)(blockIdx.x & 7) : (c.gw & 7); m.sw = sl ? (int)(blockIdx.x >> 3) * NWAVES + c.wave : (c.gw >> 3); }
    m.j = __builtin_amdgcn_readfirstlane(m.j); m.sw = __builtin_amdgcn_readfirstlane(m.sw);
    __syncthreads();
    return m;
}
typedef float f32x2 __attribute__((ext_vector_type(2)));
template <int S> __device__ __forceinline__ unsigned bcast8(unsigned v, bool inq0) {
    const unsigned q = (unsigned)__builtin_amdgcn_mov_dpp((int)v, (S & 3) * 0x55, 0xF, 0xF, true);
    const unsigned r = (unsigned)__builtin_amdgcn_mov_dpp((int)q, 0x141, 0xF, 0xF, true);
    return ((S < 4) == inq0) ? q : r;
}
template <int HF> __device__ __forceinline__ void gather8(u32x4 (&w)[8], const unsigned char* wslice, unsigned moff, unsigned idw, bool inq0) {
#define G8ROW(R) { const unsigned b = bcast8<R>(idw, inq0); const unsigned id = HF ? (b >> 16) : (b & 0xffffu); w[R] = *(const u32x4*)(wslice + ((id << 7) + moff)); }
    G8ROW(0) G8ROW(1) G8ROW(2) G8ROW(3) G8ROW(4) G8ROW(5) G8ROW(6) G8ROW(7)
#undef G8ROW
}
template <int CTRL> __device__ __forceinline__ int dppi(int v) { return __builtin_amdgcn_mov_dpp(v, CTRL, 0xF, 0xF, true); }
__device__ __forceinline__ int g1_half(const u32x4 (&w)[8], const u32x4 xq, int m) {
    int d[8];
#pragma unroll
    for (int i = 0; i < 8; ++i) {
        int v = __builtin_amdgcn_sdot4((int)w[i].x, (int)xq.x, 0, false); v = __builtin_amdgcn_sdot4((int)w[i].y, (int)xq.y, v, false);
        v = __builtin_amdgcn_sdot4((int)w[i].z, (int)xq.z, v, false); d[i] = __builtin_amdgcn_sdot4((int)w[i].w, (int)xq.w, v, false);
    }
    const bool lo = m < 4, b1 = (m & 2) != 0, b0 = (m & 1) != 0;
    int e[4], f[2];
#pragma unroll
    for (int i = 0; i < 4; ++i) e[i] = (lo ? d[i] : d[i + 4]) + dppi<0x141>(lo ? d[i + 4] : d[i]);
#pragma unroll
    for (int i = 0; i < 2; ++i) f[i] = (b1 ? e[i + 2] : e[i]) + dppi<0x4E>(b1 ? e[i] : e[i + 2]);
    return (b0 ? f[1] : f[0]) + dppi<0xB1>(b0 ? f[0] : f[1]);
}
#define TOK(i) (t0 + (i) * ns)
#define IDX(t) (*(const unsigned*)((const unsigned char*)(eidx + (size_t)(t) * 64) + loff))
__device__ __forceinline__ void ph_g1(const Ctx& c, unsigned* bar, const unsigned char* xq, const float* sx, const unsigned char* Wd, const unsigned* eidx, bf16* apart) {
    const int lane = c.lane, g = lane >> 3, m = lane & 7; const bool inq0 = m < 4; const SliceMap sm = slice_map(c, bar);
    const int j = sm.j, ns = sm.nsw, t0 = sm.sw;
    const unsigned char* wsl = Wd + (size_t)j * (16384 * 128); const unsigned moff = 16u * m, loff = 4u * lane, soff = 2u * (16 * g + m);
    const unsigned char* xs = xq + 128 * j; bf16* as_ = apart + (size_t)j * T_ * 128;
#define XLD(t) (*(const u32x4*)(xs + (size_t)(t) * D_ + moff))
#define AST(t, o0, o1) do { const float sc_ = sx[t]; unsigned char* ap_ = (unsigned char*)(as_ + (size_t)(t) * 128) + soff; *(bf16*)ap_ = (bf16)f2bf((float)(o0) * sc_); *(bf16*)(ap_ + 16) = (bf16)f2bf((float)(o1) * sc_); } while (0)
    u32x4 W0[8], W1[8], W2[8], W3[8]; unsigned n1A = 0, n1B = 0, n2A = 0, n2B = 0; u32x4 xpA, xpB, xnA, xnB;
    if (TOK(0) < T_) { n2A = IDX(TOK(0)); xpA = XLD(TOK(0)); }
    if (TOK(1) < T_) { n2B = IDX(TOK(1)); xpB = XLD(TOK(1)); }
    if (TOK(0) < T_) { gather8<0>(W0, wsl, moff, n2A, inq0); gather8<1>(W1, wsl, moff, n2A, inq0); }
    if (TOK(1) < T_) { gather8<0>(W2, wsl, moff, n2B, inq0); gather8<1>(W3, wsl, moff, n2B, inq0); }
    if (TOK(2) < T_) n1A = IDX(TOK(2));
    if (TOK(3) < T_) n1B = IDX(TOK(3));
    const int NT = (T_ - t0 + ns - 1) / ns;
    int i = 0;
    for (; i + 5 < NT; i += 2) {
        const int tA = TOK(i), tB = TOK(i + 1), tA1 = TOK(i + 2), tB1 = TOK(i + 3), tA2 = TOK(i + 4), tB2 = TOK(i + 5);
        n2A = IDX(tA2); n2B = IDX(tB2); xnA = XLD(tA1); xnB = XLD(tB1);
        { const int o0 = g1_half(W0, xpA, m); gather8<0>(W0, wsl, moff, n1A, inq0);
          const int o1 = g1_half(W1, xpA, m); gather8<1>(W1, wsl, moff, n1A, inq0);
          AST(tA, o0, o1); }
        { const int o0 = g1_half(W2, xpB, m); gather8<0>(W2, wsl, moff, n1B, inq0);
          const int o1 = g1_half(W3, xpB, m); gather8<1>(W3, wsl, moff, n1B, inq0);
          AST(tB, o0, o1); }
        n1A = n2A; n1B = n2B; xpA = xnA; xpB = xnB;
    }
    for (; i < NT; i += 2) {
        const int tA = TOK(i), tB = TOK(i + 1), tA1 = TOK(i + 2), tB1 = TOK(i + 3), tA2 = TOK(i + 4), tB2 = TOK(i + 5);
        if (tA2 < T_) n2A = IDX(tA2);
        if (tB2 < T_) n2B = IDX(tB2);
        if (tA1 < T_) xnA = XLD(tA1);
        if (tB1 < T_) xnB = XLD(tB1);
        { const int o0 = g1_half(W0, xpA, m); if (tA1 < T_) gather8<0>(W0, wsl, moff, n1A, inq0);
          const int o1 = g1_half(W1, xpA, m); if (tA1 < T_) gather8<1>(W1, wsl, moff, n1A, inq0);
          AST(tA, o0, o1); }
        if (tB < T_) {
          const int o0 = g1_half(W2, xpB, m); if (tB1 < T_) gather8<0>(W2, wsl, moff, n1B, inq0);
          const int o1 = g1_half(W3, xpB, m); if (tB1 < T_) gather8<1>(W3, wsl, moff, n1B, inq0);
          AST(tB, o0, o1); }
        n1A = n2A; n1B = n2B; xpA = xnA; xpB = xnB;
    }
#undef XLD
#undef AST
}
__device__ __forceinline__ void ph_afin(const Ctx& c, const bf16* apart, const float* gate, const unsigned* eidx, const float* scd, const float* scu, unsigned char* aq, float* sa) {
    for (int it = blockIdx.x * NTHREADS + c.tid; it < T_ * 16; it += c.G * NTHREADS) {
        const int t = it >> 4, g = (it >> 1) & 7, m0 = (it & 1) * 4; const size_t k0 = (size_t)t * 128 + 16 * g + m0;
        float4 sl = {0.f, 0.f, 0.f, 0.f}, sh = {0.f, 0.f, 0.f, 0.f};
#pragma unroll
        for (int j = 0; j < 8; ++j) { const uint2 a0 = *(const uint2*)(apart + (size_t)j * T_ * 128 + k0), a1 = *(const uint2*)(apart + (size_t)j * T_ * 128 + k0 + 8);
            sl.x += __uint_as_float(a0.x << 16); sl.y += __uint_as_float(a0.x & 0xffff0000u); sl.z += __uint_as_float(a0.y << 16); sl.w += __uint_as_float(a0.y & 0xffff0000u);
            sh.x += __uint_as_float(a1.x << 16); sh.y += __uint_as_float(a1.x & 0xffff0000u); sh.z += __uint_as_float(a1.y << 16); sh.w += __uint_as_float(a1.y & 0xffff0000u); }
        const float4 gl = *(const float4*)(gate + k0), gh = *(const float4*)(gate + k0 + 8);
        const uint4 ep = *(const uint4*)(eidx + ((size_t)t * 8 + g) * 8 + m0);
        const unsigned ew[4] = {ep.x, ep.y, ep.z, ep.w}; const float lo[4] = {sl.x, sl.y, sl.z, sl.w}, hi[4] = {sh.x, sh.y, sh.z, sh.w}, gl4[4] = {gl.x, gl.y, gl.z, gl.w}, gh4[4] = {gh.x, gh.y, gh.z, gh.w};
        float al[4], ah[4]; float am = 0.f;
#pragma unroll
        for (int q = 0; q < 4; ++q) { const int e0 = ew[q] & 0xffff, e1 = ew[q] >> 16;
            const float u0 = lo[q] * scd[e0], u1 = hi[q] * scd[e1];
            al[q] = 0.5f * u0 * (1.f + erff(u0 * 0.7071067811865476f)) * gl4[q] * scu[e0]; ah[q] = 0.5f * u1 * (1.f + erff(u1 * 0.7071067811865476f)) * gh4[q] * scu[e1];
            am = fmaxf(am, fmaxf(fabsf(al[q]), fabsf(ah[q]))); }
        am = fmaxf(am, dppf<0xB1>(am)); am = fmaxf(am, dppf<0x4E>(am)); am = fmaxf(am, dppf<0x141>(am)); am = fmaxf(am, dppf<0x140>(am));
        am = fmaxf(am, 1e-30f); const float inv = 127.f / am;
        const unsigned pl = (unsigned)((__float2int_rn(al[0] * inv) & 0xff) | ((__float2int_rn(al[1] * inv) & 0xff) << 8) | ((__float2int_rn(al[2] * inv) & 0xff) << 16) | (__float2int_rn(al[3] * inv) << 24));
        const unsigned ph = (unsigned)((__float2int_rn(ah[0] * inv) & 0xff) | ((__float2int_rn(ah[1] * inv) & 0xff) << 8) | ((__float2int_rn(ah[2] * inv) & 0xff) << 16) | (__float2int_rn(ah[3] * inv) << 24));
        *(unsigned*)(aq + k0) = pl; *(unsigned*)(aq + k0 + 8) = ph;
        if ((it & 15) == 0) sa[t] = am * (1.f / 127.f);
    }
}
template <int R0> __device__ __forceinline__ void g2_set(int (&acc)[16], const u32x4 (&w)[8], unsigned ap) {
    const unsigned r0[4] = {w[R0].x, w[R0].y, w[R0].z, w[R0].w}, r1[4] = {w[R0 + 1].x, w[R0 + 1].y, w[R0 + 1].z, w[R0 + 1].w};
    const unsigned r2[4] = {w[R0 + 2].x, w[R0 + 2].y, w[R0 + 2].z, w[R0 + 2].w}, r3[4] = {w[R0 + 3].x, w[R0 + 3].y, w[R0 + 3].z, w[R0 + 3].w};
#pragma unroll
    for (int cq = 0; cq < 4; ++cq) {
        const unsigned t0 = __builtin_amdgcn_perm(r1[cq], r0[cq], 0x05010400u), t1 = __builtin_amdgcn_perm(r1[cq], r0[cq], 0x07030602u);
        const unsigned t2 = __builtin_amdgcn_perm(r3[cq], r2[cq], 0x05010400u), t3 = __builtin_amdgcn_perm(r3[cq], r2[cq], 0x07030602u);
        const unsigned o0 = __builtin_amdgcn_perm(t2, t0, 0x05040100u), o1 = __builtin_amdgcn_perm(t2, t0, 0x07060302u), o2 = __builtin_amdgcn_perm(t3, t1, 0x05040100u), o3 = __builtin_amdgcn_perm(t3, t1, 0x07060302u);
        acc[4 * cq + 0] = __builtin_amdgcn_sdot4((int)o0, (int)ap, acc[4 * cq + 0], false); acc[4 * cq + 1] = __builtin_amdgcn_sdot4((int)o1, (int)ap, acc[4 * cq + 1], false);
        acc[4 * cq + 2] = __builtin_amdgcn_sdot4((int)o2, (int)ap, acc[4 * cq + 2], false); acc[4 * cq + 3] = __builtin_amdgcn_sdot4((int)o3, (int)ap, acc[4 * cq + 3], false);
    }
}
template <int HF> __device__ __forceinline__ void g2_half(int (&acc)[16], const u32x4 (&w)[8], unsigned aw, bool inq0) {
    g2_set<0>(acc, w, bcast8<2 * HF>(aw, inq0)); g2_set<4>(acc, w, bcast8<2 * HF + 1>(aw, inq0));
}
__device__ __forceinline__ void g2_store(int (&acc)[16], int lane, float sa, bf16* fp) {
    int v8[8], v4[4];
#pragma unroll
    for (int i = 0; i < 8; ++i) { const auto r = __builtin_amdgcn_permlane32_swap((unsigned)acc[i], (unsigned)acc[i + 8], false, false); v8[i] = (int)r[0] + (int)r[1]; }
#pragma unroll
    for (int i = 0; i < 4; ++i) { const auto r = __builtin_amdgcn_permlane16_swap((unsigned)v8[i], (unsigned)v8[i + 4], false, false); v4[i] = (int)r[0] + (int)r[1]; }
    const bool up = (lane & 8) != 0;
    const int k0 = up ? v4[2] : v4[0], k1 = up ? v4[3] : v4[1], s0 = up ? v4[0] : v4[2], s1 = up ? v4[1] : v4[3];
    const int f0 = k0 + dppi<0x128>(s0), f1 = k1 + dppi<0x128>(s1);
    const int feat = ((lane >> 5) & 1) * 8 + ((lane >> 4) & 1) * 4 + ((lane >> 3) & 1) * 2;
    *(unsigned*)(fp + feat) = cvtpk((float)f0 * sa, (float)f1 * sa);
}
__device__ __forceinline__ void ph_g2(const Ctx& c, unsigned* bar, const unsigned char* Wu, const unsigned* eidx, const unsigned char* aq, const float* sa, bf16* ffn) {
    const int lane = c.lane, g = lane >> 3, m = lane & 7; const bool inq0 = m < 4; const SliceMap sm = slice_map(c, bar);
    const int j = sm.j, ns = sm.nsw, t0 = sm.sw;
    const unsigned char* wsl = Wu + (size_t)j * (16384 * 128); const unsigned moff = 16u * m, loff = 4u * lane, aoff = 16u * g + 4u * (m & 3), foff = 32u * m;
    bf16* fs = ffn + 128 * j;
#define ALD(t) (*(const unsigned*)(aq + (size_t)(t) * 128 + aoff))
#define FST(t, acc) g2_store(acc, lane, sa[t], (bf16*)((unsigned char*)(fs + (size_t)(t) * D_) + foff))
    u32x4 W0[8], W1[8], W2[8], W3[8]; unsigned n1A = 0, n1B = 0, n2A = 0, n2B = 0, apA = 0, apB = 0, anA = 0, anB = 0;
    if (TOK(0) < T_) { n2A = IDX(TOK(0)); apA = ALD(TOK(0)); }
    if (TOK(1) < T_) { n2B = IDX(TOK(1)); apB = ALD(TOK(1)); }
    if (TOK(0) < T_) { gather8<0>(W0, wsl, moff, n2A, inq0); gather8<1>(W1, wsl, moff, n2A, inq0); }
    if (TOK(1) < T_) { gather8<0>(W2, wsl, moff, n2B, inq0); gather8<1>(W3, wsl, moff, n2B, inq0); }
    if (TOK(2) < T_) n1A = IDX(TOK(2));
    if (TOK(3) < T_) n1B = IDX(TOK(3));
    const int NT = (T_ - t0 + ns - 1) / ns;
    int i = 0;
    for (; i + 5 < NT; i += 2) {
        const int tA = TOK(i), tB = TOK(i + 1), tA1 = TOK(i + 2), tB1 = TOK(i + 3), tA2 = TOK(i + 4), tB2 = TOK(i + 5);
        n2A = IDX(tA2); n2B = IDX(tB2); anA = ALD(tA1); anB = ALD(tB1);
        { int acc[16];
#pragma unroll
          for (int r = 0; r < 16; ++r) acc[r] = 0;
          g2_half<0>(acc, W0, apA, inq0); gather8<0>(W0, wsl, moff, n1A, inq0);
          g2_half<1>(acc, W1, apA, inq0); gather8<1>(W1, wsl, moff, n1A, inq0);
          FST(tA, acc); }
        { int acc[16];
#pragma unroll
          for (int r = 0; r < 16; ++r) acc[r] = 0;
          g2_half<0>(acc, W2, apB, inq0); gather8<0>(W2, wsl, moff, n1B, inq0);
          g2_half<1>(acc, W3, apB, inq0); gather8<1>(W3, wsl, moff, n1B, inq0);
          FST(tB, acc); }
        n1A = n2A; n1B = n2B; apA = anA; apB = anB;
    }
    for (; i < NT; i += 2) {
        const int tA = TOK(i), tB = TOK(i + 1), tA1 = TOK(i + 2), tB1 = TOK(i + 3), tA2 = TOK(i + 4), tB2 = TOK(i + 5);
        if (tA2 < T_) n2A = IDX(tA2);
        if (tB2 < T_) n2B = IDX(tB2);
        if (tA1 < T_) anA = ALD(tA1);
        if (tB1 < T_) anB = ALD(tB1);
        { int acc[16];
#pragma unroll
          for (int r = 0; r < 16; ++r) acc[r] = 0;
          g2_half<0>(acc, W0, apA, inq0); if (tA1 < T_) gather8<0>(W0, wsl, moff, n1A, inq0);
          g2_half<1>(acc, W1, apA, inq0); if (tA1 < T_) gather8<1>(W1, wsl, moff, n1A, inq0);
          FST(tA, acc); }
        if (tB < T_) { int acc[16];
#pragma unroll
          for (int r = 0; r < 16; ++r) acc[r] = 0;
          g2_half<0>(acc, W2, apB, inq0); if (tB1 < T_) gather8<0>(W2, wsl, moff, n1B, inq0);
          g2_half<1>(acc, W3, apB, inq0); if (tB1 < T_) gather8<1>(W3, wsl, moff, n1B, inq0);
          FST(tB, acc); }
        n1A = n2A; n1B = n2B; apA = anA; apB = anB;
    }
#undef ALD
#undef FST
}
#undef IDX
#undef TOK
__device__ __forceinline__ void ph_ln2(const Ctx& c, const bf16* hb  , const float2* st1, const float* g1, const float* b1, const bf16* ffn, float* out, const float* g, const float* bb) {
    constexpr int RB = 4;
    for (int row0 = c.gw * RB; row0 < T_; row0 += c.NGW * RB) {
        uint2 hv[RB][4], fv[RB][4];
#pragma unroll
        for (int r = 0; r < RB; ++r) { const uint2* hp = (const uint2*)(hb + (size_t)(row0 + r) * D_) + c.lane; const uint2* fp = (const uint2*)(ffn + (size_t)(row0 + r) * D_) + c.lane;
#pragma unroll
            for (int j = 0; j < 4; ++j) { hv[r][j] = hp[64 * j]; fv[r][j] = fp[64 * j]; } }
        float4 g1v[4], b1v[4];
#pragma unroll
        for (int j = 0; j < 4; ++j) { const int cc = (64 * j + c.lane) * 4; g1v[j] = *(const float4*)(g1 + cc); b1v[j] = *(const float4*)(b1 + cc);
            g1v[j].x *= ALPHA; g1v[j].y *= ALPHA; g1v[j].z *= ALPHA; g1v[j].w *= ALPHA; b1v[j].x *= ALPHA; b1v[j].y *= ALPHA; b1v[j].z *= ALPHA; b1v[j].w *= ALPHA; }
#pragma unroll
        for (int r = 0; r < RB; ++r) {
            float4 v[4]; float s = 0.f; const float2 ms = st1[row0 + r];
#pragma unroll
            for (int j = 0; j < 4; ++j) { const uint2 h = hv[r][j], f = fv[r][j];
                v[j].x = (__uint_as_float(h.x << 16) - ms.x) * ms.y * g1v[j].x + b1v[j].x + __uint_as_float(f.x << 16); v[j].y = (__uint_as_float(h.x & 0xffff0000u) - ms.x) * ms.y * g1v[j].y + b1v[j].y + __uint_as_float(f.x & 0xffff0000u);
                v[j].z = (__uint_as_float(h.y << 16) - ms.x) * ms.y * g1v[j].z + b1v[j].z + __uint_as_float(f.y << 16); v[j].w = (__uint_as_float(h.y & 0xffff0000u) - ms.x) * ms.y * g1v[j].w + b1v[j].w + __uint_as_float(f.y & 0xffff0000u);
                s += v[j].x + v[j].y + v[j].z + v[j].w; }
            const float mu = wave_sum(s) * (1.f / D_); float q = 0.f;
#pragma unroll
            for (int j = 0; j < 4; ++j) { v[j].x -= mu; v[j].y -= mu; v[j].z -= mu; v[j].w -= mu; q += v[j].x * v[j].x + v[j].y * v[j].y + v[j].z * v[j].z + v[j].w * v[j].w; }
            const float rstd = 1.f / sqrtf(wave_sum(q) * (1.f / D_) + LN_EPS);
            float4* op = (float4*)(out + (size_t)(row0 + r) * D_) + c.lane;
#pragma unroll
            for (int j = 0; j < 4; ++j) { const int cc = (64 * j + c.lane) * 4; const float4 gg = *(const float4*)(g + cc), b4 = *(const float4*)(bb + cc);
                float4 o; o.x = v[j].x * rstd * gg.x + b4.x; o.y = v[j].y * rstd * gg.y + b4.y; o.z = v[j].z * rstd * gg.z + b4.z; o.w = v[j].w * rstd * gg.w + b4.w;
                __builtin_nontemporal_store(o.x, &op[64 * j].x); __builtin_nontemporal_store(o.y, &op[64 * j].y); __builtin_nontemporal_store(o.z, &op[64 * j].z); __builtin_nontemporal_store(o.w, &op[64 * j].w); }
        }
    }
}
constexpr int NPH = 12;
__global__ void __launch_bounds__(NTHREADS, 2) mega(Args a) {
    extern __shared__ __attribute__((aligned(16))) unsigned char lds[];
    Ctx c; c.tid = threadIdx.x; c.lane = c.tid & 63; c.wave = __builtin_amdgcn_readfirstlane(c.tid >> 6); c.G = gridDim.x; c.gw = blockIdx.x * NWAVES + c.wave; c.NGW = c.G * NWAVES; c.lds = lds; c.ldsl = (LAS unsigned char*)lds;
    { const int bx = blockIdx.x; const int vcu = (c.G % 8 == 0) ? (bx % 8) * (c.G / 8) + bx / 8 : bx; c.gwx = vcu * NWAVES + c.wave; }
    unsigned char* ws = a.ws;
#define WoutT ((bf16*)(ws + WS_WOUT))
#define ipre ((float*)(ws + WS_GATE))
#define logf ((float*)(ws + WS_GATE) + (size_t)T_ * 4)
#define proj ((bf16*)(ws + WS_PROJ))
#define qry ((bf16*)(ws + WS_QRY))
#define mq ((bf16*)(ws + WS_MQ))
#define mk ((bf16*)(ws + WS_MK))
#define concat ((bf16*)(ws + WS_CONCAT))
#define xb ((bf16*)(ws + WS_XB))
    const int lo = a.ph_lo, hi = a.ph_hi;
#define IN(k) (lo <= (k) && (k) < hi)
    if (c.tid < 8) ((LAS unsigned*)(c.ldsl + MISC_OFF))[c.tid] = 0u;
    __syncthreads();
    XcdBarrier xbar; xbar.bar = (unsigned*)(ws + WS_BAR); xbar.x = xb_xcc_id(); xbar.st = (volatile LAS unsigned*)(c.ldsl + MISC_OFF);
    if (c.tid == 0) { const unsigned rank = xb_add(&xbar.bar[XB_XCNT(xbar.x)], 1u); xbar.st[2] = xbar.x; xbar.st[3] = rank; }
#define SEAM(k) do { if (IN(k) && IN((k) + 1)) xcd_barrier(xbar); } while (0)
#ifndef REP_PHASE
#define REP_PHASE -1
#endif
#define PH(id, ...) do { __VA_ARGS__; if (REP_PHASE == (id)) { xcd_barrier(xbar); __VA_ARGS__; } } while (0)
    if (IN(0)) { PH(0, { ph_prologue(c, a); }); } SEAM(0);
    if (IN(1)) { PH(1, { pg8::Gemm g{(const pg8::bf16_t*)(ws + WS_XB), (const pg8::bf16_t*)(ws + WS_WIN), T_, NPROJ, D_ / 2}; pg8::StaticOrder S; S.init(T_, NPROJ, c.G, (int)blockIdx.x);
        pg8::EpiI8Bf16 E{proj, NPROJ, (const float*)(ws + WS_SXA), (const float*)(ws + WS_SWN)};
        pg8::gemm_phase<pg8::EpiI8Bf16, pg8::StaticOrder, true, true>((PG8_LAS unsigned char*)lds, g, S, E); }); } SEAM(1);
    if (IN(2)) { PH(20, { ph_m1(c, a, proj, ipre, logf, mq, mk, (unsigned char*)a.out); __syncthreads(); }); PH(21, { ph_attn(c, proj, ws, (unsigned char*)a.out); }); } SEAM(2);
    if (IN(3)) { PH(30, { ph_attn_merge(c, ws, (const unsigned char*)a.out, concat); }); PH(31, { ph_m3(c, a, proj, ipre, logf, mq, mk, (const unsigned char*)a.out, concat); }); } SEAM(3);
    if (IN(4)) { PH(4, { pg8::Gemm g{concat, WoutT, T_, D_, D_}; pg8::StaticOrder S; S.init(T_, D_, c.G, (int)blockIdx.x);
        pg8::EpiResBf16 E{a.in[0], (bf16*)(ws + WS_Y1), ALPHA};
        pg8::gemm_phase<pg8::EpiResBf16, pg8::StaticOrder, true, true>((PG8_LAS unsigned char*)lds, g, S, E); }); } SEAM(4);
    if (IN(5)) { PH(5, { ph_ln1(c, (const bf16*)(ws + WS_Y1), a.in[10], a.in[11], (float2*)(ws + WS_ST1), (unsigned*)(ws + WS_XQ), (float*)(ws + WS_SX)); }); } SEAM(5);
    if (IN(6)) { PH(6, { pg8::Gemm g{(const pg8::bf16_t*)(ws + WS_XQ), (const pg8::bf16_t*)(ws + WS_WQ), T_, 2048, D_ / 2}; pg8::StaticOrder S; S.init(T_, 2048, c.G, (int)blockIdx.x);
        pg8::EpiI8Bf16 E{qry, 2048, (const float*)(ws + WS_SX), (const float*)(ws + WS_SWQ)};
        pg8::gemm_phase<pg8::EpiI8Bf16, pg8::StaticOrder, true, true>((PG8_LAS unsigned char*)lds, g, S, E);
        asm volatile("s_waitcnt vmcnt(0)" ::: "memory"); __syncthreads();
        ph_route(c, qry, (const bf16*)(ws + WS_SK), (unsigned*)(ws + WS_EIDX), (float*)(ws + WS_GATEV)); }); } SEAM(6);
    if (IN(8)) { PH(8, { ph_g1(c, xbar.bar, (const unsigned char*)(ws + WS_XQ), (const float*)(ws + WS_SX), (const unsigned char*)(ws + WS_WD), (const unsigned*)(ws + WS_EIDX), (bf16*)(ws + WS_APART)); }); } SEAM(8);
    if (IN(9)) { PH(9, { ph_afin(c, (const bf16*)(ws + WS_APART), (const float*)(ws + WS_GATEV), (const unsigned*)(ws + WS_EIDX), (const float*)(ws + WS_SCD), (const float*)(ws + WS_SCU), (unsigned char*)(ws + WS_AFIN), (float*)(ws + WS_SA)); }); } SEAM(9);
    if (IN(10)) { PH(10, { ph_g2(c, xbar.bar, (const unsigned char*)(ws + WS_WU), (const unsigned*)(ws + WS_EIDX), (const unsigned char*)(ws + WS_AFIN), (const float*)(ws + WS_SA), (bf16*)(ws + WS_FFN)); }); } SEAM(10);
    if (IN(11)) { PH(11, { ph_ln2(c, (const bf16*)(ws + WS_Y1), (const float2*)(ws + WS_ST1), a.in[10], a.in[11], (const bf16*)(ws + WS_FFN), a.out, a.in[16], a.in[17]); }); }
#undef PH
#undef WoutT
#undef ipre
#undef logf
#undef proj
#undef qry
#undef mq
#undef mk
#undef concat
#undef xb
#undef IN
#undef SEAM
}

#ifndef MK_PER_PHASE
#define MK_PER_PHASE 0
#endif
extern "C" void kernel_launch(void* const* d_in, const int* in_sizes, int n_in, void* d_out, int out_size, void* d_ws, size_t ws_size, hipStream_t stream) {
    static int grid = 0;
    if (grid == 0) {
        if (n_in != 18 || out_size != T_ * D_ || ws_size < WS_END) { fprintf(stderr, "kernel_launch: unexpected sizes n_in %d out %d ws %zu\n", n_in, out_size, ws_size); grid = -1; return; }
        int dev = 0, cus = 0, per_cu = 0;
        if (hipGetDevice(&dev) != hipSuccess || hipDeviceGetAttribute(&cus, hipDeviceAttributeMultiprocessorCount, dev) != hipSuccess) { fprintf(stderr, "kernel_launch: device query failed\n"); grid = -1; return; }
        if (hipFuncSetAttribute((const void*)mega, hipFuncAttributeMaxDynamicSharedMemorySize, LDS_BYTES) != hipSuccess) { fprintf(stderr, "kernel_launch: hipFuncSetAttribute failed\n"); grid = -1; return; }
        if (hipOccupancyMaxActiveBlocksPerMultiprocessor(&per_cu, (const void*)mega, NTHREADS, LDS_BYTES) != hipSuccess || per_cu < 1) { fprintf(stderr, "kernel_launch: occupancy query failed (%d)\n", per_cu); (void)hipGetLastError(); grid = -1; return; }
        grid = cus * per_cu;
        fprintf(stderr, "kernel_launch: %d CUs x %d workgroups = grid %d\n", cus, per_cu, grid);
    }
    if (grid < 0) return;
    if (hipMemsetAsync((char*)d_ws + WS_BAR, 0, 49152, stream) != hipSuccess) { fprintf(stderr, "kernel_launch: memset of the barrier words failed\n"); return; }
    Args a{};
    for (int i = 0; i < 18; ++i) a.in[i] = (const float*)d_in[i];
    a.out = (float*)d_out; a.ws = (unsigned char*)d_ws;
#if MK_PER_PHASE
    for (int p = 0; p < NPH; ++p) { a.ph_lo = p; a.ph_hi = p + 1; hipLaunchKernelGGL(mega, dim3(grid), dim3(NTHREADS), LDS_BYTES, stream, a); }
#else
    a.ph_lo = 0; a.ph_hi = NPH;
    void* params[] = {&a};
    const hipError_t e = hipLaunchCooperativeKernel((const void*)mega, dim3(grid), dim3(NTHREADS), params, LDS_BYTES, stream);
    if (e != hipSuccess) fprintf(stderr, "kernel_launch: cooperative launch failed: %s (grid %d)\n", hipGetErrorString(e), grid);
#endif
}
```

```cpp
#include <hip/hip_runtime.h>
#include <cstdio>
#include <cstdint>
#include <cmath>
namespace pg8 {
#define PG8_LAS __attribute__((address_space(3)))
typedef unsigned short bf16_t;
typedef short bf16x8 __attribute__((ext_vector_type(8)));
typedef float f32x4 __attribute__((ext_vector_type(4)));
typedef unsigned u32x4 __attribute__((ext_vector_type(4)));
typedef int i32x4 __attribute__((ext_vector_type(4)));
constexpr int BM = 256, BK = 64, HALF = 128, HTB = HALF * BK * 2  , STAGE_BYTES = 8 * HTB, NXCD = 8, WGM = 8;

__host__ __device__ __forceinline__ int lds_byte(int r, int c) { const int st = (r >> 4) * 2 + (c >> 5), rr = r & 15, cc = c & 31, ob = rr * 64 + cc * 2; return st * 1024 + (ob ^ (((ob >> 9) & 1) << 5)); }
__host__ __device__ __forceinline__ void stage_rc(int b, int& R, int& C) { const int st = b / 1024, sb = b % 1024, swz = sb ^ (((sb >> 9) & 1) << 5); R = (st >> 1) * 16 + swz / 64; C = (st & 1) * 32 + (swz % 64) / 2; }
__host__ __device__ __forceinline__ int perm32(int rho) { const int n = rho >> 4, i = rho & 15; return 8 * (i >> 2) + 4 * n + (i & 3); }

struct Unit { int pm, pn; };
struct Gemm { const bf16_t* A; const bf16_t* Bt; int M, N, K; };

struct StaticOrder {
    int nM, nN, nwg, G, c;
    __host__ __device__ void init(int M, int N, int G_, int c_) { nM = M / BM; nN = N / BM; nwg = nM * nN; G = G_; c = c_; }
    __host__ __device__ bool next(int i, Unit& u) const {
        const long L = (long)i * G + c; if (L >= nwg) return false;
        int wgid = (int)L; { const int q = nwg / NXCD, r = nwg % NXCD, xcd = wgid % NXCD, off = wgid / NXCD; wgid = (xcd < r ? xcd * (q + 1) : r * (q + 1) + (xcd - r) * q) + off; }
        const int nig = WGM * nN, gid = wgid / nig, fm = gid * WGM, gsz = (nM - fm) < WGM ? (nM - fm) : WGM;
        u.pm = fm + ((wgid % nig) % gsz); u.pn = (wgid % nig) / gsz; return true;
    }
    __device__ __forceinline__ void a_ready(const Unit&) const {}
    __device__ __forceinline__ void done(const Unit&) const {}
};

__device__ __forceinline__ unsigned cvt_pk_bf16(float lo, float hi) { unsigned r; asm volatile("v_cvt_pk_bf16_f32 %0, %1, %2" : "=v"(r) : "v"(lo), "v"(hi)); return r; }
typedef float f32x2 __attribute__((ext_vector_type(2)));
__device__ __forceinline__ f32x2 gelu_pk(f32x2 v) {
    const f32x2 av = __builtin_elementwise_abs(v), d = av * 0.2316418882f + 1.0f;
    f32x2 t; t.x = __builtin_amdgcn_rcpf(d.x); t.y = __builtin_amdgcn_rcpf(d.y);
    f32x2 q = t * 0.5307027145f + (-0.7265760135f); q = q * t + 0.7107068705f; q = q * t + (-0.142248368f); q = q * t + 0.127414796f; q = q * t;
    const f32x2 s = (v * v) * (-0.72134752044f);
    f32x2 e; e.x = __builtin_amdgcn_exp2f(s.x); e.y = __builtin_amdgcn_exp2f(s.y);
    const f32x2 m = v * (q * e), r = v - m;
    f32x2 o; o.x = v.x < 0.f ? m.x : r.x; o.y = v.y < 0.f ? m.y : r.y; return o;
}

template <int ACT  > struct EpiBf16 {
    static constexpr bool PERM = true, AFTER_DRAIN = false, I8 = false; static_assert(ACT == 0 || ACT == 1, "EpiBf16: ACT is 0 (none) or 1 (gelu_pk)");
    bf16_t* O; int ldc; const float* bias; int split_cols; size_t split_stride; float scale0;
    __device__ __forceinline__ void operator()(const f32x4 (&acc)[2][2][4][2], const Unit& u, int wr, int wc, int fr, int fq) const {
        const int row0 = u.pm * BM + wr * 64 + fr; int colt = u.pn * BM; bf16_t* base = O;
        float sc = 1.f; if (split_cols) { const int t = colt / split_cols; base += (size_t)t * split_stride; colt -= t * split_cols; if (t == 0) sc = scale0; }
        const int col0 = colt + wc * 32 + 8 * fq, bcol0 = u.pn * BM + wc * 32 + 8 * fq;
        f32x4 bv[2][2];
#pragma unroll
        for (int bj = 0; bj < 2; ++bj)
#pragma unroll
            for (int n = 0; n < 2; ++n) bv[bj][n] = bias ? *(const f32x4*)(bias + bcol0 + bj * HALF + 4 * n) : (f32x4){0.f, 0.f, 0.f, 0.f};
#pragma unroll
        for (int ai = 0; ai < 2; ++ai)
#pragma unroll
            for (int m = 0; m < 4; ++m) { bf16_t* rowp = base + (size_t)(row0 + ai * HALF + m * 16) * ldc + col0;
#pragma unroll
                for (int bj = 0; bj < 2; ++bj) { f32x4 v0 = acc[ai][bj][m][0] + bv[bj][0], v1 = acc[ai][bj][m][1] + bv[bj][1];
                    if (ACT == 1) { f32x2 a = gelu_pk((f32x2){v0[0], v0[1]}), b = gelu_pk((f32x2){v0[2], v0[3]}), c = gelu_pk((f32x2){v1[0], v1[1]}), d = gelu_pk((f32x2){v1[2], v1[3]});
                        v0 = (f32x4){a.x, a.y, b.x, b.y}; v1 = (f32x4){c.x, c.y, d.x, d.y}; }
                    v0 = v0 * sc; v1 = v1 * sc; u32x4 w; w.x = cvt_pk_bf16(v0[0], v0[1]); w.y = cvt_pk_bf16(v0[2], v0[3]); w.z = cvt_pk_bf16(v1[0], v1[1]); w.w = cvt_pk_bf16(v1[2], v1[3]);
                    *(u32x4*)(rowp + bj * HALF) = w; } }
    }
};
struct EpiResBf16 {
    static constexpr bool PERM = true, AFTER_DRAIN = false, I8 = false;
    const float* xres; bf16_t* out; float alpha;
    __device__ __forceinline__ void operator()(const f32x4 (&acc)[2][2][4][2], const Unit& u, int wr, int wc, int fr, int fq) const {
        const int col0 = u.pn * BM + wc * 32 + 8 * fq;
#pragma unroll
        for (int ai = 0; ai < 2; ++ai)
#pragma unroll
            for (int m = 0; m < 4; ++m) { const size_t off = (size_t)(u.pm * BM + ai * HALF + wr * 64 + m * 16 + fr) * 1024 + col0;
#pragma unroll
                for (int bj = 0; bj < 2; ++bj) { const f32x4 x0 = *(const f32x4*)(xres + off + bj * HALF), x1 = *(const f32x4*)(xres + off + bj * HALF + 4);
                    const f32x4 v0 = x0 * alpha + acc[ai][bj][m][0], v1 = x1 * alpha + acc[ai][bj][m][1];
                    u32x4 w; w.x = cvt_pk_bf16(v0[0], v0[1]); w.y = cvt_pk_bf16(v0[2], v0[3]); w.z = cvt_pk_bf16(v1[0], v1[1]); w.w = cvt_pk_bf16(v1[2], v1[3]);
                    *(u32x4*)(out + off + bj * HALF) = w; } }
    }
};
struct EpiI8Bf16 {
    static constexpr bool PERM = true, AFTER_DRAIN = false, I8 = true;
    bf16_t* O; int ldc; const float* sa; const float* sb;
    __device__ __forceinline__ void operator()(const i32x4 (&acc)[2][2][4][2], const Unit& u, int wr, int wc, int fr, int fq) const {
        const int row0 = u.pm * BM + wr * 64 + fr, col0 = u.pn * BM + wc * 32 + 8 * fq;
        f32x4 sbv[2][2];
#pragma unroll
        for (int bj = 0; bj < 2; ++bj)
#pragma unroll
            for (int n = 0; n < 2; ++n) sbv[bj][n] = *(const f32x4*)(sb + col0 + bj * HALF + 4 * n);
#pragma unroll
        for (int ai = 0; ai < 2; ++ai)
#pragma unroll
            for (int m = 0; m < 4; ++m) { const int r = row0 + ai * HALF + m * 16; const float sr = sa[r]; bf16_t* rowp = O + (size_t)r * ldc + col0;
#pragma unroll
                for (int bj = 0; bj < 2; ++bj) { const i32x4 a0 = acc[ai][bj][m][0], a1 = acc[ai][bj][m][1];
                    const f32x4 v0 = (f32x4){(float)a0[0], (float)a0[1], (float)a0[2], (float)a0[3]} * sbv[bj][0] * sr, v1 = (f32x4){(float)a1[0], (float)a1[1], (float)a1[2], (float)a1[3]} * sbv[bj][1] * sr;
                    u32x4 w; w.x = cvt_pk_bf16(v0[0], v0[1]); w.y = cvt_pk_bf16(v0[2], v0[3]); w.z = cvt_pk_bf16(v1[0], v1[1]); w.w = cvt_pk_bf16(v1[2], v1[3]);
                    *(u32x4*)(rowp + bj * HALF) = w; } }
    }
};
__device__ __forceinline__ f32x4 mma16(bf16x8 a, bf16x8 b, f32x4 c) { return __builtin_amdgcn_mfma_f32_16x16x32_bf16(a, b, c, 0, 0, 0); }
__device__ __forceinline__ i32x4 mma16(bf16x8 a, bf16x8 b, i32x4 c) { return __builtin_amdgcn_mfma_i32_16x16x64_i8(__builtin_bit_cast(i32x4, a), __builtin_bit_cast(i32x4, b), c, 0, 0, 0); }
template <bool I8> struct AccT { typedef f32x4 type; };
template <> struct AccT<true> { typedef i32x4 type; };
template <class Epi, class Sched, bool ALIGN_EPI = false, bool SP2 = false>
__device__ __forceinline__ void gemm_phase(PG8_LAS unsigned char* lds, const Gemm g, const Sched& S, const Epi& E) {
    const int tid = threadIdx.x, wid = __builtin_amdgcn_readfirstlane(tid >> 6), lane = tid & 63, wr = wid >> 2, wc = wid & 3, fr = lane & 15, fq = lane >> 4;
    const int K = g.K, nt = K / BK;
    unsigned voffA[2], voffB[2];
#pragma unroll
    for (int i = 0; i < 2; ++i) { int R, C; stage_rc(tid * 16 + i * 8192, R, C); const int Rb = Epi::PERM ? ((R & ~31) + perm32(R & 31)) : R;
        voffA[i] = (unsigned)(R * K + C) * 2u; voffB[i] = (unsigned)(Rb * K + C) * 2u; }
    const size_t kstep = (size_t)(BK * 2);
    const size_t hstep = (size_t)HALF * K * 2;
    const size_t tstep = 2 * hstep;
    const unsigned ldsw = (unsigned)wid * 1024u;
    const int aoff = lds_byte(wr * 64 + fr, fq * 8), boff = lds_byte(wc * 32 + fr, fq * 8);
#define PG8_SA(b, h) (((b) * 2 + (h)) * HTB)
#define PG8_SB(b, h) ((4 + (b) * 2 + (h)) * HTB)
#define PG8_STAGE(bufoff, gbase, voff) do { _Pragma("unroll") for (int _i = 0; _i < 2; ++_i) \
        __builtin_amdgcn_global_load_lds((const unsigned*)((const char*)(gbase) + (voff)[_i]), (PG8_LAS unsigned*)(lds + (bufoff) + ldsw + _i * 8192), 16, 0, 0); } while (0)
#define PG8_LDA(dst, b, h) do { _Pragma("unroll") for (int m = 0; m < 4; ++m) _Pragma("unroll") for (int k = 0; k < 2; ++k) dst[m][k] = *(const PG8_LAS bf16x8*)(lds + PG8_SA(b, h) + aoff + m * 2048 + k * 1024); } while (0)
#define PG8_LDB(dst, b, h) do { _Pragma("unroll") for (int n = 0; n < 2; ++n) _Pragma("unroll") for (int k = 0; k < 2; ++k) dst[n][k] = *(const PG8_LAS bf16x8*)(lds + PG8_SB(b, h) + boff + n * 2048 + k * 1024); } while (0)
#define PG8_MMA(ai, bj, At, Bt) do { __builtin_amdgcn_s_setprio(1); _Pragma("unroll") for (int m = 0; m < 4; ++m) _Pragma("unroll") for (int n = 0; n < 2; ++n) _Pragma("unroll") for (int k = 0; k < 2; ++k) \
        acc[ai][bj][m][n] = mma16(Bt[n][k], At[m][k], acc[ai][bj][m][n]); __builtin_amdgcn_s_setprio(0); } while (0)
#define PG8_WAIT_V(n) asm volatile("s_waitcnt vmcnt(" #n ")" ::: "memory")
#define PG8_WAIT_L(n) asm volatile("s_waitcnt lgkmcnt(" #n ")" ::: "memory")
#define PG8_BAR __builtin_amdgcn_s_barrier()
#define PG8_SCHED __builtin_amdgcn_sched_barrier(0)
    Unit cur, nxt; int ui = 0;
    if (!S.next(0, cur)) return;
    typedef typename AccT<Epi::I8>::type acc_t; const acc_t acc_zero = {0, 0, 0, 0};
    acc_t acc[2][2][4][2];
#pragma unroll
    for (int a = 0; a < 2; ++a)
#pragma unroll
        for (int b = 0; b < 2; ++b)
#pragma unroll
            for (int m = 0; m < 4; ++m)
#pragma unroll
                for (int n = 0; n < 2; ++n) acc[a][b][m][n] = acc_zero;
    bf16x8 At[4][2], B0[2][2], B1[2][2];
    const char* cA = (const char*)g.A + (size_t)cur.pm * tstep; const char* cB = (const char*)g.Bt + (size_t)cur.pn * tstep;
    S.a_ready(cur);
    if constexpr (SP2) {
        PG8_STAGE(PG8_SB(0, 0), cB, voffB); PG8_STAGE(PG8_SB(0, 1), cB + hstep, voffB); PG8_STAGE(PG8_SA(0, 0), cA, voffA); PG8_STAGE(PG8_SA(0, 1), cA + hstep, voffA);
        if (wr == 1) PG8_BAR;
        PG8_WAIT_V(2); PG8_BAR;
        PG8_STAGE(PG8_SB(1, 0), cB + kstep, voffB); PG8_STAGE(PG8_SA(1, 0), cA + kstep, voffA); PG8_STAGE(PG8_SB(1, 1), cB + hstep + kstep, voffB);
        PG8_WAIT_V(6); PG8_BAR;
    } else {
        PG8_STAGE(PG8_SB(0, 0), cB, voffB); PG8_STAGE(PG8_SA(0, 0), cA, voffA); PG8_STAGE(PG8_SB(0, 1), cB + hstep, voffB); PG8_STAGE(PG8_SA(0, 1), cA + hstep, voffA);
        if (wr == 1) PG8_BAR;
        PG8_WAIT_V(4); PG8_BAR;
        PG8_STAGE(PG8_SB(1, 0), cB + kstep, voffB); PG8_STAGE(PG8_SA(1, 0), cA + kstep, voffA); PG8_STAGE(PG8_SB(1, 1), cB + hstep + kstep, voffB);
        PG8_WAIT_V(6); PG8_BAR;
    }
    for (;;) {
        const bool has_next = S.next(ui + 1, nxt);
        const char* nA = has_next ? (const char*)g.A + (size_t)nxt.pm * tstep : cA; const char* nB = has_next ? (const char*)g.Bt + (size_t)nxt.pn * tstep : cB;
        for (int t = 0; t < nt; t += 2) {
            const bool last = (t == nt - 2);
            const char* a1 = cA + (size_t)(t + 1) * kstep;
            const char* a2 = last ? nA : cA + (size_t)(t + 2) * kstep; const char* b2 = last ? nB : cB + (size_t)(t + 2) * kstep;
            const char* a3 = a2 + kstep; const char* b3 = b2 + kstep;
            if (last && has_next) S.a_ready(nxt);
            if constexpr (SP2) {
            PG8_LDB(B0, 0, 0); PG8_LDB(B1, 0, 1); PG8_SCHED; PG8_LDA(At, 0, 0); PG8_STAGE(PG8_SA(1, 1), a1 + hstep, voffA);
            PG8_WAIT_V(8); PG8_WAIT_L(0); PG8_BAR; PG8_MMA(0, 0, At, B0); PG8_MMA(0, 1, At, B1); PG8_BAR; PG8_SCHED;
            PG8_LDA(At, 0, 1); PG8_STAGE(PG8_SB(0, 0), b2, voffB); PG8_STAGE(PG8_SB(0, 1), b2 + hstep, voffB); PG8_STAGE(PG8_SA(0, 0), a2, voffA);
            PG8_WAIT_V(8); PG8_WAIT_L(0); PG8_BAR; PG8_MMA(1, 0, At, B0); PG8_MMA(1, 1, At, B1); PG8_BAR; PG8_SCHED;
            PG8_LDB(B0, 1, 0); PG8_LDB(B1, 1, 1); PG8_SCHED; PG8_LDA(At, 1, 0); PG8_STAGE(PG8_SA(0, 1), a2 + hstep, voffA);
            PG8_WAIT_V(8); PG8_WAIT_L(0); PG8_BAR; PG8_MMA(0, 0, At, B0); PG8_MMA(0, 1, At, B1); PG8_BAR; PG8_SCHED;
            PG8_LDA(At, 1, 1); PG8_STAGE(PG8_SB(1, 0), b3, voffB); PG8_STAGE(PG8_SB(1, 1), b3 + hstep, voffB); PG8_STAGE(PG8_SA(1, 0), a3, voffA);
            PG8_WAIT_V(8); PG8_WAIT_L(0); PG8_BAR; PG8_MMA(1, 0, At, B0); PG8_MMA(1, 1, At, B1); PG8_BAR; PG8_SCHED;
            } else {
            PG8_LDB(B0, 0, 0); PG8_SCHED; PG8_LDA(At, 0, 0); PG8_STAGE(PG8_SA(1, 1), a1 + hstep, voffA);
            PG8_WAIT_L(8); PG8_BAR; PG8_WAIT_L(0); PG8_MMA(0, 0, At, B0); PG8_BAR; PG8_SCHED;
            PG8_LDB(B1, 0, 1); PG8_STAGE(PG8_SB(0, 0), b2, voffB);
            PG8_BAR; PG8_WAIT_L(0); PG8_MMA(0, 1, At, B1); PG8_BAR;
            PG8_LDA(At, 0, 1); PG8_STAGE(PG8_SA(0, 0), a2, voffA);
            PG8_BAR; PG8_WAIT_L(0); PG8_MMA(1, 0, At, B0); PG8_BAR; PG8_SCHED;
            PG8_STAGE(PG8_SB(0, 1), b2 + hstep, voffB);
            PG8_WAIT_V(6); PG8_BAR; PG8_MMA(1, 1, At, B1); PG8_BAR;
            PG8_LDB(B0, 1, 0); PG8_SCHED; PG8_LDA(At, 1, 0); PG8_STAGE(PG8_SA(0, 1), a2 + hstep, voffA);
            PG8_WAIT_L(8); PG8_BAR; PG8_WAIT_L(0); PG8_MMA(0, 0, At, B0); PG8_BAR; PG8_SCHED;
            PG8_LDB(B1, 1, 1); PG8_STAGE(PG8_SB(1, 0), b3, voffB);
            PG8_BAR; PG8_WAIT_L(0); PG8_MMA(0, 1, At, B1); PG8_BAR;
            PG8_LDA(At, 1, 1); PG8_STAGE(PG8_SA(1, 0), a3, voffA);
            PG8_BAR; PG8_WAIT_L(0); PG8_MMA(1, 0, At, B0); PG8_BAR; PG8_SCHED;
            PG8_STAGE(PG8_SB(1, 1), b3 + hstep, voffB);
            PG8_WAIT_V(6); PG8_BAR; PG8_MMA(1, 1, At, B1); PG8_BAR;
            }
        }
        if constexpr (ALIGN_EPI) { if (wr == 0) PG8_BAR; }
        if constexpr (!Epi::AFTER_DRAIN) { E(acc, cur, wr, wc, fr, fq); S.done(cur); }
        if (!has_next) break;
#pragma unroll
        for (int a = 0; a < 2; ++a)
#pragma unroll
            for (int b = 0; b < 2; ++b)
#pragma unroll
                for (int m = 0; m < 4; ++m)
#pragma unroll
                    for (int n = 0; n < 2; ++n) acc[a][b][m][n] = acc_zero;
        cur = nxt; cA = nA; cB = nB; ++ui;
        if constexpr (ALIGN_EPI) { if (wr == 1) PG8_BAR; }
    }
    PG8_WAIT_V(0);
    if constexpr (!ALIGN_EPI) { if (wr == 0) PG8_BAR; }
    PG8_BAR;
    if constexpr (Epi::AFTER_DRAIN) { E.fused(acc, cur, wr, wc, fr, fq, lds, wid, lane); S.done(cur); }
#undef PG8_SA
#undef PG8_SB
#undef PG8_STAGE
#undef PG8_LDA
#undef PG8_LDB
#undef PG8_MMA
#undef PG8_WAIT_V
#undef PG8_WAIT_L
#undef PG8_BAR
#undef PG8_SCHED
}
}
typedef unsigned short bf16;
#define LAS __attribute__((address_space(3)))
constexpr int B_ = 16, S_ = 2048, D_ = 1024, T_ = B_ * S_;
constexpr int INC = 3080, NPROJ = 3072;
constexpr int C_QA = 0, C_KA = 512, C_VA = 1024, C_XM = 1536, C_VM = 2048, C_OM = 2560;
constexpr float ALPHA = 1.189207115002721f;
constexpr float LN_EPS = 1e-5f;
constexpr size_t MiB = 1u << 20;
constexpr int NWAVES = 8, NTHREADS = 512;
constexpr int LDS_BYTES = 147456;

constexpr size_t WS_WIN = 1 * MiB;
constexpr size_t WS_SWN = 768 * 1024, WS_SXA = 800 * 1024;
constexpr size_t WS_WOUT = 7 * MiB;
constexpr size_t WS_WQ = 9 * MiB;
constexpr size_t WS_SWQ = 780 * 1024;
constexpr size_t WS_GATE = 13 * MiB;
constexpr size_t WS_PROJ = 16 * MiB;
constexpr size_t WS_QRY = 16 * MiB;
constexpr size_t WS_Y1 = 336 * MiB;
constexpr size_t WS_ST1 = 305 * MiB;
constexpr size_t WS_MQ = 208 * MiB, WS_MK = 240 * MiB;
constexpr size_t WS_CONCAT = 272 * MiB;
constexpr size_t WS_XB = 336 * MiB;
constexpr size_t WS_SK = 15 * MiB + 512 * 1024;
constexpr size_t WS_EIDX = 144 * MiB, WS_GATEV = 160 * MiB;
constexpr size_t WS_AFIN = 176 * MiB;
constexpr size_t WS_SA = 192 * MiB;
constexpr size_t WS_FFN = 208 * MiB;
constexpr size_t WS_APART = 208 * MiB;
constexpr size_t WS_XQ = 272 * MiB, WS_SX = 304 * MiB;
constexpr size_t WS_WD = 400 * MiB, WS_WU = 432 * MiB;
constexpr size_t WS_SCD = 640 * 1024, WS_SCU = 704 * 1024;
constexpr size_t WS_PO01 = 336 * MiB;
constexpr size_t OUT_DBUF = 40 * MiB, OUT_NLOC = 72 * MiB, OUT_CSC = 73 * MiB;
constexpr size_t WS_WMT = 0;
constexpr size_t OUT_PO2 = 0, OUT_PML = 32 * MiB;
constexpr size_t WS_END = 464 * MiB;
typedef short bf16x8 __attribute__((ext_vector_type(8)));
typedef float f32x16 __attribute__((ext_vector_type(16)));

__device__ __forceinline__ float bf2f(bf16 v) { return __uint_as_float((unsigned)v << 16); }
__device__ __forceinline__ unsigned f2bf(float f) { unsigned u = __float_as_uint(f); return (u + 0x7fffu + ((u >> 16) & 1u)) >> 16; }
__device__ __forceinline__ unsigned pk2(float lo, float hi) { return f2bf(lo) | (f2bf(hi) << 16); }
#define WAVE_FENCE() asm volatile("s_waitcnt lgkmcnt(0)" ::: "memory")
template <int CTRL> __device__ __forceinline__ float dppf_(float v) { return __int_as_float(__builtin_amdgcn_mov_dpp(__float_as_int(v), CTRL, 0xF, 0xF, true)); }
__device__ __forceinline__ float wave_sum(float v) {
    v += dppf_<0xB1>(v); v += dppf_<0x4E>(v); v += dppf_<0x141>(v); v += dppf_<0x140>(v);
    { const auto r = __builtin_amdgcn_permlane16_swap(__float_as_uint(v), __float_as_uint(v), false, false); v = __uint_as_float(r[0]) + __uint_as_float(r[1]); }
    { const auto r = __builtin_amdgcn_permlane32_swap(__float_as_uint(v), __float_as_uint(v), false, false); v = __uint_as_float(r[0]) + __uint_as_float(r[1]); }
    return v;
}
__device__ __forceinline__ float wave_max(float v) {
    v = fmaxf(v, dppf_<0xB1>(v)); v = fmaxf(v, dppf_<0x4E>(v)); v = fmaxf(v, dppf_<0x141>(v)); v = fmaxf(v, dppf_<0x140>(v));
    { const auto r = __builtin_amdgcn_permlane16_swap(__float_as_uint(v), __float_as_uint(v), false, false); v = fmaxf(__uint_as_float(r[0]), __uint_as_float(r[1])); }
    { const auto r = __builtin_amdgcn_permlane32_swap(__float_as_uint(v), __float_as_uint(v), false, false); v = fmaxf(__uint_as_float(r[0]), __uint_as_float(r[1])); }
    return v;
}
#define RLX_AGENT __ATOMIC_RELAXED, __HIP_MEMORY_SCOPE_AGENT
#define XB_TMO      128
#define XB_XCNT(j)  (256  + 64 * (j))
#define XB_XSUB(j)  (1280 + 64 * (j))
#define XB_XGEN(j)  (2304 + 64 * (j))
#define XB_TOP      3328
#define XB_TOPGEN   3392
#define XCD_BAR_WORDS 3456
#define XB_SPIN_CAP (1u << 18)

__device__ __forceinline__ unsigned xb_ld(unsigned* p)              { return __hip_atomic_load(p, __ATOMIC_RELAXED, __HIP_MEMORY_SCOPE_AGENT); }
__device__ __forceinline__ unsigned xb_add(unsigned* p, unsigned v) { return __hip_atomic_fetch_add(p, v, __ATOMIC_RELAXED, __HIP_MEMORY_SCOPE_AGENT); }
__device__ __forceinline__ unsigned xb_xcc_id() { return (unsigned)__builtin_amdgcn_s_getreg((3 << 11) | 20) & 0xFu; }
#define XB_SPIN(cond, bar) do { unsigned _sp = 0; while (cond) { __builtin_amdgcn_s_sleep(1); \
    if ((++_sp & 255u) == 0u) { if (xb_ld(&(bar)[XB_TMO])) break; if (_sp > XB_SPIN_CAP) { atomicAdd(&(bar)[XB_TMO], 1u); break; } } } } while (0)

struct XcdBarrier {
    unsigned* bar; unsigned x;
    volatile LAS unsigned* st;
};

__device__ __forceinline__ XcdBarrier xcd_barrier_post(unsigned* bar, volatile LAS unsigned* st) {
    XcdBarrier b; b.bar = bar; b.x = xb_xcc_id(); b.st = st;
    if (threadIdx.x == 0) (void)xb_add(&bar[XB_XCNT(b.x)], 1u);
    return b;
}
__device__ __forceinline__ void xcd_barrier_complete(unsigned* bar, unsigned x, unsigned& nloc, unsigned& nx) {
    const unsigned G = gridDim.x * gridDim.y * gridDim.z;
    unsigned sum, cnt, mine, sp = 0u;
    for (;;) {
        sum = 0u; cnt = 0u; mine = 0u;
#pragma unroll
        for (unsigned j = 0; j < 16; ++j) { const unsigned c = xb_ld(&bar[XB_XCNT(j)]); sum += c; cnt += (c > 0u) ? 1u : 0u; mine = (j == x) ? c : mine; }
        if (sum == G) break;
        __builtin_amdgcn_s_sleep(1);
        if ((++sp & 255u) == 0u) { if (xb_ld(&bar[XB_TMO])) break; if (sp > XB_SPIN_CAP) { atomicAdd(&bar[XB_TMO], 1u); break; } }
    }
    nloc = mine > 0u ? mine : 1u; nx = cnt > 0u ? cnt : 1u;
}

__device__ __forceinline__ void xcd_barrier(const XcdBarrier& b) {
    asm volatile("s_waitcnt vmcnt(0)" ::: "memory");
    __syncthreads();
    if (threadIdx.x == 0) {
        unsigned* bar = b.bar;
        __builtin_amdgcn_s_waitcnt(0);
        unsigned nloc = b.st[0], nx = b.st[1];
        if (nloc == 0u) { xcd_barrier_complete(bar, b.x, nloc, nx); b.st[0] = nloc; b.st[1] = nx; }
        const unsigned old = xb_add(&bar[XB_XSUB(b.x)], 1u);
        const unsigned gen = old / nloc;
        if (old + 1u == (gen + 1u) * nloc) {
            __builtin_amdgcn_fence(__ATOMIC_RELEASE, "agent");
            asm volatile("s_waitcnt vmcnt(0)" ::: "memory");
            const unsigned og = xb_add(&bar[XB_TOP], 1u);
            const unsigned tg = og / nx;
            if (og + 1u == (tg + 1u) * nx) xb_add(&bar[XB_TOPGEN], 1u);
            else XB_SPIN(xb_ld(&bar[XB_TOPGEN]) == tg, bar);
            __builtin_amdgcn_fence(__ATOMIC_ACQUIRE, "agent");
            xb_add(&bar[XB_XGEN(b.x)], 1u);
            asm volatile("s_waitcnt vmcnt(0)" ::: "memory");
        } else {
            XB_SPIN(xb_ld(&bar[XB_XGEN(b.x)]) == gen, bar);
            __builtin_amdgcn_fence(__ATOMIC_ACQUIRE, "agent");
            asm volatile("s_waitcnt vmcnt(0)" ::: "memory");
        }
    }
    __syncthreads();
}

constexpr size_t WS_BAR = 512 * 1024;
constexpr size_t WS_CMX = 512 * 1024 + 16384;
constexpr int MISC_OFF = 131072 + 512;
struct Args { const float* in[18]; float* out; unsigned char* ws; int ph_lo, ph_hi; };
struct Ctx { int tid, lane, wave, G, gw, NGW, gwx; unsigned char* lds; LAS unsigned char* ldsl; };

__device__ __forceinline__ void transpose_item(const float* W, int ldw, int K, int nblk, bf16* WT, float* scr, int item, int lane) {
    const int kb = item / nblk, nb = item % nblk, k0 = 64 * kb, n0 = 32 * nb;
#pragma unroll 8
    for (int i = 0; i < 32; ++i) { const int kk = 2 * i + (lane >> 5); scr[kk * 33 + (lane & 31)] = W[(size_t)(k0 + kk) * ldw + n0 + (lane & 31)]; }
    WAVE_FENCE();
    const int c = lane & 7;
#pragma unroll
    for (int j = 0; j < 4; ++j) { const int n = (lane >> 3) + 8 * j; const float* s = scr + (8 * c) * 33 + n;
        uint4 o; o.x = pk2(s[0 * 33], s[1 * 33]); o.y = pk2(s[2 * 33], s[3 * 33]); o.z = pk2(s[4 * 33], s[5 * 33]); o.w = pk2(s[6 * 33], s[7 * 33]);
        *(uint4*)(WT + (size_t)(n0 + n) * K + k0 + 8 * c) = o; }
    WAVE_FENCE();
}
__device__ __forceinline__ void ph_prologue(const Ctx& c, const Args& a) {
    const float* x = a.in[0]; const float* w_in = a.in[1]; const float* b_ig = a.in[6]; const float* b_fg = a.in[7];
    bf16* WoutT = (bf16*)(a.ws + WS_WOUT); unsigned* xq8 = (unsigned*)(a.ws + WS_XB); float* sxa = (float*)(a.ws + WS_SXA);
    float* ipre = (float*)(a.ws + WS_GATE); float* logf = ipre + (size_t)T_ * 4;
    float* scr = (float*)(c.lds + c.wave * 8448); float* wgs = (float*)(c.lds + 69632);
    for (int i = c.tid; i < 8192; i += NTHREADS) wgs[i] = w_in[(size_t)(i >> 3) * INC + NPROJ + (i & 7)];
    constexpr int I_IN = 16 * 96, I_OUT = 16 * 32, I_Q = 16 * 64;
    unsigned* cmx = (unsigned*)(a.ws + WS_CMX); unsigned* ccnt = cmx + NPROJ + 2048;
    for (int it = c.gw; it < I_IN + I_Q; it += c.NGW) {
        const bool isq = it >= I_IN; const int r = isq ? it - I_IN : it, nblk = isq ? 64 : 96, ldw = isq ? 2048 : INC; const float* W = isq ? a.in[12] : w_in;
        const int kb = r / nblk, nb = r % nblk, k0 = 64 * kb, n0 = 32 * nb, cl = c.lane & 31, kh = c.lane >> 5; float am = 0.f;
#pragma unroll 8
        for (int i = 0; i < 32; ++i) am = fmaxf(am, fabsf(W[(size_t)(k0 + 2 * i + kh) * ldw + n0 + cl]));
        am = fmaxf(am, __shfl_xor(am, 32));
        unsigned prev = 0u;
        if (c.lane < 32) prev = atomicMax(cmx + (isq ? NPROJ : 0) + n0 + cl, __float_as_uint(am));
        asm volatile("s_waitcnt vmcnt(0)" : "+v"(prev) :: "memory");
        if (c.lane == 0) __hip_atomic_fetch_add(ccnt + (isq ? 96 : 0) + nb, 1u, __ATOMIC_RELAXED, __HIP_MEMORY_SCOPE_AGENT);
    }
    for (int it = c.gw; it < I_OUT; it += c.NGW) transpose_item(a.in[9], D_, D_, 32, WoutT, scr, it, c.lane);
    for (int it = c.gw; it < 64; it += c.NGW) {
        const int mat = it >> 5, h = (it >> 3) & 3, r = it & 7;
        transpose_item(a.in[4 + mat] + (size_t)h * 128 * 128, 128, 128, 4, (bf16*)(a.ws + WS_WMT) + (size_t)(mat * 4 + h) * 128 * 128, scr, r, c.lane);
    }
    { const float4* sk = (const float4*)a.in[13]; uint2* skb = (uint2*)(a.ws + WS_SK);
      for (int i = blockIdx.x * NTHREADS + c.tid; i < 8 * 2 * 128 * 128 / 4; i += c.G * NTHREADS) { const float4 v = sk[i]; uint2 o; o.x = pk2(v.x, v.y); o.y = pk2(v.z, v.w); skb[i] = o; } }
    __syncthreads();
    for (int rowb = c.gw * 4; rowb < T_; rowb += c.NGW * 4) {
      float4 xx[4][4];
#pragma unroll
      for (int rr = 0; rr < 4; ++rr) { const float4* xr = (const float4*)(x + (size_t)(rowb + rr) * D_) + c.lane;
#pragma unroll
          for (int j = 0; j < 4; ++j) xx[rr][j] = xr[64 * j]; }
      float g[4][8];
#pragma unroll
      for (int rr = 0; rr < 4; ++rr)
#pragma unroll
          for (int i = 0; i < 8; ++i) g[rr][i] = 0.f;
#pragma unroll
      for (int j = 0; j < 4; ++j) {
          const int k = (64 * j + c.lane) * 4;
#pragma unroll
          for (int i = 0; i < 4; ++i) { const float4 w0 = *(const float4*)(wgs + (k + i) * 8), w1 = *(const float4*)(wgs + (k + i) * 8 + 4);
#pragma unroll
              for (int rr = 0; rr < 4; ++rr) { const float4 v = xx[rr][j]; const float xv = (i == 0) ? v.x : (i == 1) ? v.y : (i == 2) ? v.z : v.w;
                  g[rr][0] += xv * w0.x; g[rr][1] += xv * w0.y; g[rr][2] += xv * w0.z; g[rr][3] += xv * w0.w; g[rr][4] += xv * w1.x; g[rr][5] += xv * w1.y; g[rr][6] += xv * w1.z; g[rr][7] += xv * w1.w; } }
      }
#pragma unroll
      for (int rr = 0; rr < 4; ++rr) {
          float am = 0.f;
#pragma unroll
          for (int j = 0; j < 4; ++j) { const float4 v = xx[rr][j]; am = fmaxf(am, fmaxf(fmaxf(fabsf(v.x), fabsf(v.y)), fmaxf(fabsf(v.z), fabsf(v.w)))); }
          am = fmaxf(wave_max(am), 1e-30f); const float inv = 127.f / am;
          if (c.lane == 0) sxa[rowb + rr] = am * (1.f / 127.f);
#pragma unroll
          for (int j = 0; j < 4; ++j) { const float4 v = xx[rr][j];
              xq8[(size_t)(rowb + rr) * 256 + 64 * j + c.lane] = (unsigned)((__float2int_rn(v.x * inv) & 0xff) | ((__float2int_rn(v.y * inv) & 0xff) << 8) | ((__float2int_rn(v.z * inv) & 0xff) << 16) | (__float2int_rn(v.w * inv) << 24)); }
      }
#pragma unroll
      for (int rr = 0; rr < 4; ++rr) {
        const int row = rowb + rr;
#pragma unroll
        for (int i = 0; i < 8; ++i) g[rr][i] = wave_sum(g[rr][i]);
        if (c.lane < 8) {
            float gv = g[rr][0];
#pragma unroll
            for (int i = 1; i < 8; ++i) gv = (c.lane == i) ? g[rr][i] : gv;
            if (c.lane < 4) ipre[(size_t)row * 4 + c.lane] = gv + b_ig[c.lane];
            else { const float z = gv + b_fg[c.lane - 4]; logf[(size_t)row * 4 + c.lane - 4] = fminf(z, 0.f) - log1pf(expf(-fabsf(z))); }
        }
      }
    }
    for (int it = c.gw; it < I_IN + I_Q; it += c.NGW) {
        const bool isq = it >= I_IN; const int r = isq ? it - I_IN : it, nblk = isq ? 64 : 96, ldw = isq ? 2048 : INC; const float* W = isq ? a.in[12] : w_in;
        const int kb = r / nblk, nb = r % nblk, k0 = 64 * kb, n0 = 32 * nb, cl = c.lane & 31, kh = c.lane >> 5;
        { unsigned spins = 0; while (__hip_atomic_load(ccnt + (isq ? 96 : 0) + nb, __ATOMIC_RELAXED, __HIP_MEMORY_SCOPE_AGENT) < 16u && ++spins < (1u << 22)) __builtin_amdgcn_s_sleep(2); }
        const float am = fmaxf(__uint_as_float(__hip_atomic_load(cmx + (isq ? NPROJ : 0) + n0 + cl, __ATOMIC_RELAXED, __HIP_MEMORY_SCOPE_AGENT)), 1e-30f), inv = 127.f / am;
        if (kb == 0 && c.lane < 32) ((float*)(a.ws + (isq ? WS_SWQ : WS_SWN)))[n0 + cl] = am * (1.f / 127.f);
        unsigned char* W8 = a.ws + (isq ? WS_WQ : WS_WIN);
#pragma unroll 8
        for (int i = 0; i < 32; ++i) { const int kk = 2 * i + kh; scr[kk * 33 + cl] = W[(size_t)(k0 + kk) * ldw + n0 + cl] * inv; }
        WAVE_FENCE();
        const int c8 = c.lane & 7;
#pragma unroll
        for (int j = 0; j < 4; ++j) { const int n = (c.lane >> 3) + 8 * j; const float* sp = scr + (8 * c8) * 33 + n;
            uint2 o; o.x = (unsigned)((__float2int_rn(sp[0]) & 0xff) | ((__float2int_rn(sp[33]) & 0xff) << 8) | ((__float2int_rn(sp[66]) & 0xff) << 16) | (__float2int_rn(sp[99]) << 24));
            o.y = (unsigned)((__float2int_rn(sp[132]) & 0xff) | ((__float2int_rn(sp[165]) & 0xff) << 8) | ((__float2int_rn(sp[198]) & 0xff) << 16) | (__float2int_rn(sp[231]) << 24));
            *(uint2*)(W8 + (size_t)(n0 + n) * D_ + k0 + 8 * c8) = o; }
        WAVE_FENCE();
    }
}

__device__ __forceinline__ void quant_table_rows(const Ctx& c, const Args& a, int r0) {
      float4 vv[4][4];
#pragma unroll
      for (int rr = 0; rr < 4; ++rr) { const int r = r0 + rr; const float4* src = (const float4*)(a.in[14 + (r >> 14)] + (size_t)(r & 16383) * D_) + c.lane;
#pragma unroll
          for (int j = 0; j < 4; ++j) vv[rr][j] = src[64 * j]; }
#pragma unroll
      for (int rr = 0; rr < 4; ++rr) {
        const int r = r0 + rr, tb = r >> 14, e = r & 16383;
        float4 v[4]; float mx = 0.f;
#pragma unroll
        for (int j = 0; j < 4; ++j) { v[j] = vv[rr][j]; mx = fmaxf(mx, fmaxf(fmaxf(fabsf(v[j].x), fabsf(v[j].y)), fmaxf(fabsf(v[j].z), fabsf(v[j].w)))); }
        mx = fmaxf(wave_max(mx), 1e-30f);
        const float inv = 127.f / mx;
        if (c.lane == 0) ((float*)(a.ws + (tb ? WS_SCU : WS_SCD)))[e] = mx * (1.f / 127.f);
        unsigned* dst = (unsigned*)(a.ws + (tb ? WS_WU : WS_WD));
#pragma unroll
        for (int j = 0; j < 4; ++j) { const int p = (__float2int_rn(v[j].x * inv) & 0xff) | ((__float2int_rn(v[j].y * inv) & 0xff) << 8) | ((__float2int_rn(v[j].z * inv) & 0xff) << 16) | (__float2int_rn(v[j].w * inv) << 24);
            dst[(size_t)(2 * j + (c.lane >> 5)) * (16384 * 32) + (size_t)e * 32 + (c.lane & 31)] = (unsigned)p; }
      }
}
typedef short s16x4 __attribute__((ext_vector_type(4)));
typedef unsigned u32x4 __attribute__((ext_vector_type(4)));
typedef unsigned u32x2 __attribute__((ext_vector_type(2)));
typedef float f32x4 __attribute__((ext_vector_type(4)));
typedef float f32x2_t __attribute__((ext_vector_type(2))); typedef __bf16 bf16x2_t __attribute__((ext_vector_type(2)));
__device__ __forceinline__ unsigned cvtpk(float lo, float hi) { const f32x2_t v = {lo, hi}; const bf16x2_t b = __builtin_convertvector(v, bf16x2_t); return __builtin_bit_cast(unsigned, b); }
__device__ __forceinline__ bf16x8 pack8(const f32x16& p, int b0) {
    union { unsigned u[4]; bf16x8 v; } x;
    x.u[0] = cvtpk(p[b0 + 0], p[b0 + 1]); x.u[1] = cvtpk(p[b0 + 2], p[b0 + 3]); x.u[2] = cvtpk(p[b0 + 4], p[b0 + 5]); x.u[3] = cvtpk(p[b0 + 6], p[b0 + 7]); return x.v;
}
__device__ __forceinline__ s16x4 tr_read(LAS unsigned char* p) { return __builtin_amdgcn_ds_read_tr16_b64_v4i16((LAS s16x4*)p); }
constexpr int AT_VP = 192, AT_OP = 144;
template <int T0> __device__ __forceinline__ void attn_task(LAS unsigned char* vl, const bf16* proj, unsigned char* ws, unsigned char* ob, int lane, int br, int b, int h, int d, int r, int m0) {
    const int col = lane & 31, hh = lane >> 5, i16 = lane & 15, grp = lane >> 4;
    const float CS = 0.125f * 1.4426950408889634f;
    const bf16* base = proj + (size_t)b * S_ * NPROJ + h * 64 + 8 * hh;
    const int tq = (m0 + col) * d + r;
    bf16x8 bq[4];
#pragma unroll
    for (int s = 0; s < 4; ++s) bq[s] = *(const bf16x8*)(base + (size_t)tq * NPROJ + C_QA + 16 * s);
    bf16x8 ka[5][4];
#pragma unroll
    for (int tau = T0; tau < 5; ++tau) { const bf16* kp = base + (size_t)((m0 - 128 + 32 * tau + col) * d + r) * NPROJ + C_KA;
#pragma unroll
        for (int s = 0; s < 4; ++s) ka[tau][s] = *(const bf16x8*)(kp + 16 * s); }
    f32x16 sc[5];
#pragma unroll
    for (int tau = T0; tau < 5; ++tau) {
        f32x16 acc;
#pragma unroll
        for (int i = 0; i < 16; ++i) acc[i] = 0.f;
#pragma unroll
        for (int s = 0; s < 4; ++s) acc = __builtin_amdgcn_mfma_f32_32x32x16_bf16(ka[tau][s], bq[s], acc, 0, 0, 0);
#pragma unroll
        for (int i = 0; i < 16; ++i) { const int cr = (i & 3) + 8 * (i >> 2) + 4 * hh;
            const bool ok = (tau == 0) ? (cr >= col) : ((tau == 4) ? (cr <= col) : true);
            sc[tau][i] = ok ? acc[i] * CS : -INFINITY; }
    }
    u32x4 vv[5][4];
#pragma unroll
    for (int tau = T0; tau < 5; ++tau)
#pragma unroll
        for (int q = 0; q < 4; ++q) { const int id = lane + 64 * q, row = id >> 3, ch = id & 7;
            vv[tau][q] = *(const u32x4*)(proj + (size_t)(b * S_ + (m0 - 128 + 32 * tau + row) * d + r) * NPROJ + C_VA + h * 64 + 8 * ch); }
    float mx = -INFINITY;
#pragma unroll
    for (int tau = T0; tau < 5; ++tau)
#pragma unroll
        for (int i = 0; i < 16; ++i) mx = fmaxf(mx, sc[tau][i]);
    mx = fmaxf(mx, __shfl_xor(mx, 32));
    float l = 0.f;
#pragma unroll
    for (int tau = T0; tau < 5; ++tau)
#pragma unroll
        for (int i = 0; i < 16; ++i) { const float p = __builtin_amdgcn_exp2f(sc[tau][i] - mx); sc[tau][i] = p; l += p; }
    l += __shfl_xor(l, 32);
    f32x16 o[2];
#pragma unroll
    for (int i = 0; i < 16; ++i) { o[0][i] = 0.f; o[1][i] = 0.f; }
#pragma unroll
    for (int tau = T0; tau < 5; ++tau) {
#pragma unroll
        for (int q = 0; q < 4; ++q) { const int id = lane + 64 * q, row = id >> 3, ch = id & 7; *(LAS u32x4*)(vl + row * AT_VP + ch * 16) = vv[tau][q]; }
        WAVE_FENCE();
        const bf16x8 pb0 = pack8(sc[tau], 0), pb1 = pack8(sc[tau], 8);
#pragma unroll
        for (int dt = 0; dt < 2; ++dt)
#pragma unroll
            for (int ks = 0; ks < 2; ++ks) {
                LAS unsigned char* ap = vl + (16 * ks + 4 * hh + (i16 >> 2)) * AT_VP + (32 * dt + 16 * (grp & 1) + 4 * (i16 & 3)) * 2;
                const s16x4 lo = tr_read(ap), hi = tr_read(ap + 8 * AT_VP);
                const bf16x8 av = {lo[0], lo[1], lo[2], lo[3], hi[0], hi[1], hi[2], hi[3]};
                o[dt] = __builtin_amdgcn_mfma_f32_32x32x16_bf16(av, ks ? pb1 : pb0, o[dt], 0, 0, 0);
            }
        WAVE_FENCE();
    }
#pragma unroll
    for (int dt = 0; dt < 2; ++dt)
#pragma unroll
        for (int q4 = 0; q4 < 4; ++q4) { u32x2 w; w.x = cvtpk(o[dt][4 * q4], o[dt][4 * q4 + 1]); w.y = cvtpk(o[dt][4 * q4 + 2], o[dt][4 * q4 + 3]);
            *(LAS u32x2*)(vl + col * AT_OP + (32 * dt + 8 * q4 + 4 * hh) * 2) = w; }
    WAVE_FENCE();
    bf16* pO = (br < 2) ? (bf16*)(ws + WS_PO01 + (size_t)br * 32 * MiB) : (bf16*)(ob + OUT_PO2);
#pragma unroll
    for (int q = 0; q < 4; ++q) { const int id = lane + 64 * q, row = id >> 3, ch = id & 7;
        const u32x4 v = *(LAS u32x4*)(vl + row * AT_OP + ch * 16);
        *(u32x4*)(pO + ((size_t)(b * S_ + (m0 + row) * d + r) * 8 + h) * 64 + 8 * ch) = v; }
    if (hh == 0) ((float2*)(ob + OUT_PML))[((size_t)br * T_ + b * S_ + tq) * 8 + h] = make_float2(mx, l);
    WAVE_FENCE();
}
__device__ __forceinline__ void ph_attn(const Ctx& c, const bf16* proj, unsigned char* ws, unsigned char* ob) {
    LAS unsigned char* vl = c.ldsl + c.wave * 6144;
    for (int task = c.gwx; task < 3 * B_ * 8 * 64; task += c.NGW) {
        const int bh = task / 192, rem = task % 192, br = rem >> 6, rq = rem & 63;
        const int dsh = 2 * br, d = 1 << dsh, nqsh = 6 - dsh;
        const int r = rq >> nqsh, m0 = (rq & ((1 << nqsh) - 1)) * 32, b = bh >> 3, h = bh & 7;
        switch (m0 >= 128 ? 0 : (128 - m0) >> 5) {
            case 0: attn_task<0>(vl, proj, ws, ob, c.lane, br, b, h, d, r, m0); break;
            case 1: attn_task<1>(vl, proj, ws, ob, c.lane, br, b, h, d, r, m0); break;
            case 2: attn_task<2>(vl, proj, ws, ob, c.lane, br, b, h, d, r, m0); break;
            case 3: attn_task<3>(vl, proj, ws, ob, c.lane, br, b, h, d, r, m0); break;
            default: attn_task<4>(vl, proj, ws, ob, c.lane, br, b, h, d, r, m0); break;
        }
    }
}
__device__ __forceinline__ void ph_attn_merge(const Ctx& c, const unsigned char* ws, const unsigned char* ob, bf16* concat) {
    const int lane = c.lane, h = lane >> 3, c8 = lane & 7;
    const float2* pML = (const float2*)(ob + OUT_PML);
    constexpr int TB = 4;
    for (int t0 = c.gw * TB; t0 < T_; t0 += c.NGW * TB) {
        uint4 v[TB][3]; float2 ml[TB][3];
#pragma unroll
        for (int i = 0; i < TB; ++i)
#pragma unroll
            for (int br = 0; br < 3; ++br) { const bf16* pO = (br < 2) ? (const bf16*)(ws + WS_PO01 + (size_t)br * 32 * MiB) : (const bf16*)(ob + OUT_PO2);
                v[i][br] = *(const uint4*)(pO + ((size_t)(t0 + i) * 8 + h) * 64 + 8 * c8); ml[i][br] = pML[((size_t)br * T_ + t0 + i) * 8 + h]; }
#pragma unroll
        for (int i = 0; i < TB; ++i) {
            const float M = fmaxf(ml[i][0].x, fmaxf(ml[i][1].x, ml[i][2].x));
            const float w0 = __builtin_amdgcn_exp2f(ml[i][0].x - M), w1 = __builtin_amdgcn_exp2f(ml[i][1].x - M), w2 = __builtin_amdgcn_exp2f(ml[i][2].x - M);
            const float inv = 1.f / (ml[i][0].y * w0 + ml[i][1].y * w1 + ml[i][2].y * w2);
            const unsigned* a0 = (const unsigned*)&v[i][0]; const unsigned* a1 = (const unsigned*)&v[i][1]; const unsigned* a2 = (const unsigned*)&v[i][2];
            uint4 o; unsigned* op = (unsigned*)&o;
#pragma unroll
            for (int e = 0; e < 4; ++e) {
                const float lo = (w0 * __uint_as_float(a0[e] << 16) + w1 * __uint_as_float(a1[e] << 16) + w2 * __uint_as_float(a2[e] << 16)) * inv;
                const float hi = (w0 * __uint_as_float(a0[e] & 0xffff0000u) + w1 * __uint_as_float(a1[e] & 0xffff0000u) + w2 * __uint_as_float(a2[e] & 0xffff0000u)) * inv;
                op[e] = pk2(lo, hi);
            }
            *(uint4*)(concat + (size_t)(t0 + i) * D_ + h * 64 + 8 * c8) = o;
        }
    }
}
constexpr int ML_XP = 272, ML_VP = 320;
struct ChunkGates { float bc0, bc1, u0, u1, incl; };
__device__ __forceinline__ ChunkGates chunk_gates(const float* ipre, const float* logf, int bt0, int h, int lane) {
    const float lf0 = logf[(size_t)(bt0 + 2 * lane) * 4 + h], lf1 = logf[(size_t)(bt0 + 2 * lane + 1) * 4 + h];
    const float ip0 = ipre[(size_t)(bt0 + 2 * lane) * 4 + h], ip1 = ipre[(size_t)(bt0 + 2 * lane + 1) * 4 + h];
    float incl = lf0 + lf1;
#pragma unroll
    for (int o = 1; o < 64; o <<= 1) { const float n = __shfl_up(incl, o); if (lane >= o) incl += n; }
    ChunkGates g; g.incl = incl; g.bc1 = incl; g.bc0 = incl - lf1; g.u0 = ip0 - g.bc0; g.u1 = ip1 - g.bc1; return g;
}
__device__ __forceinline__ bf16x8 tr_pair(LAS unsigned char* p, int hi_off) { const s16x4 lo = tr_read(p), hi = tr_read(p + hi_off); return (bf16x8){lo[0], lo[1], lo[2], lo[3], hi[0], hi[1], hi[2], hi[3]}; }

__device__ __forceinline__ void ph_m1(const Ctx& c, const Args& a, const bf16* proj, const float* ipre, const float* logf, bf16* mq, bf16* mk, unsigned char* ob) {
    const float* conv_w = a.in[2]; const float* conv_b = a.in[3];
    const bf16* WmT = (const bf16*)(a.ws + WS_WMT);
    bf16* Dbuf = (bf16*)(ob + OUT_DBUF); float* nloc = (float*)(ob + OUT_NLOC); float* csc = (float*)(ob + OUT_CSC);
    LAS unsigned char* XC = c.ldsl; LAS unsigned char* KS = c.ldsl + 34816; LAS unsigned char* VS = c.ldsl + 75776;
    LAS float* wkt = (LAS float*)(c.ldsl + 116736); LAS float* nred = (LAS float*)(c.ldsl + 117760);
    const int tid = c.tid, lane = c.lane, wave = c.wave, col = lane & 31, hh = lane >> 5, i16 = lane & 15, grp = lane >> 4;
    int qr = c.gw * 4;
    for (int u = blockIdx.x; u < 1024; u += c.G) {
        const int bh = u >> 4, cc = u & 15, b = bh >> 2, h = bh & 3, bt0 = b * S_ + cc * 128;
        if (wave == 0) {
            const ChunkGates g = chunk_gates(ipre, logf, bt0, h, lane);
            const float umax = wave_max(fmaxf(g.u0, g.u1)), bL = __shfl(g.incl, 63);
            wkt[2 * lane] = expf(g.u0 - umax); wkt[2 * lane + 1] = expf(g.u1 - umax);
            if (lane == 0) { csc[2 * u] = bL; csc[2 * u + 1] = bL + umax; }
        }
        {
            const int ch = tid & 127, ts = (tid >> 7) * 32, cidx = h * 128 + ch;
            const float w0 = conv_w[cidx], w1 = conv_w[512 + cidx], w2 = conv_w[1024 + cidx], w3 = conv_w[1536 + cidx], cb = conv_b[cidx];
            const bf16* xp = proj + (size_t)bt0 * NPROJ + C_XM + cidx;
            const int tseq = cc * 128 + ts;
            float p3 = (tseq - 3 >= 0) ? bf2f(xp[(ptrdiff_t)(ts - 3) * NPROJ]) : 0.f, p2 = (tseq - 2 >= 0) ? bf2f(xp[(ptrdiff_t)(ts - 2) * NPROJ]) : 0.f, p1 = (tseq - 1 >= 0) ? bf2f(xp[(ptrdiff_t)(ts - 1) * NPROJ]) : 0.f;
            for (int i = 0; i < 32; ++i) {
                const float cur = bf2f(xp[(size_t)(ts + i) * NPROJ]);
                const float acc = cb + w0 * p3 + w1 * p2 + w2 * p1 + w3 * cur;
                *(LAS bf16*)(XC + (ts + i) * ML_XP + ch * 2) = (bf16)f2bf(acc / (1.f + expf(-acc)));
                p3 = p2; p2 = p1; p1 = cur;
            }
        }
#pragma unroll
        for (int q = 0; q < 4; ++q) { const int id = tid + 512 * q, row = id >> 4, ch = id & 15;
            *(LAS u32x4*)(VS + row * ML_VP + ch * 16) = *(const u32x4*)(proj + (size_t)(bt0 + row) * NPROJ + C_VM + h * 128 + 8 * ch); }
        __syncthreads();
        {
            const int tokt = wave & 3, mat = wave >> 2, tok = 32 * tokt + col;
            bf16x8 xf[8];
#pragma unroll
            for (int s2 = 0; s2 < 8; ++s2) xf[s2] = *(LAS bf16x8*)(XC + tok * ML_XP + (16 * s2 + 8 * hh) * 2);
            const float wkl = wkt[tok];
            const bf16* WT = WmT + (size_t)(mat * 4 + h) * 128 * 128 + (size_t)col * 128 + 8 * hh;
            bf16* og = (mat ? mk : mq) + (size_t)(bt0 + tok) * 512 + h * 128;
#pragma unroll
            for (int ft = 0; ft < 4; ++ft) {
                const bf16* wp = WT + (size_t)ft * 32 * 128; asm volatile("" : "+v"(wp));
                f32x16 acc;
#pragma unroll
                for (int i = 0; i < 16; ++i) acc[i] = 0.f;
#pragma unroll
                for (int s2 = 0; s2 < 8; ++s2) { const bf16x8 af = *(const bf16x8*)(wp + 16 * s2); acc = __builtin_amdgcn_mfma_f32_32x32x16_bf16(af, xf[s2], acc, 0, 0, 0); }
#pragma unroll
                for (int q4 = 0; q4 < 4; ++q4) {
                    const int f0 = 32 * ft + 8 * q4 + 4 * hh;
                    const float sc = mat ? 1.f : 0.08838834764831845f;
                    const float v0 = acc[4 * q4] * sc, v1 = acc[4 * q4 + 1] * sc, v2 = acc[4 * q4 + 2] * sc, v3 = acc[4 * q4 + 3] * sc;
                    u32x2 w; w.x = cvtpk(v0, v1); w.y = cvtpk(v2, v3);
                    *(u32x2*)(og + f0) = w;
                    if (mat) { u32x2 ws2; ws2.x = cvtpk(v0 * wkl, v1 * wkl); ws2.y = cvtpk(v2 * wkl, v3 * wkl); *(LAS u32x2*)(KS + tok * ML_VP + f0 * 2) = ws2; }
                }
            }
        }
        __syncthreads();
        {
            const int vt = wave >> 1, kt0 = 2 * (wave & 1);
            f32x16 d0, d1;
#pragma unroll
            for (int i = 0; i < 16; ++i) { d0[i] = 0.f; d1[i] = 0.f; }
            const int roff = (8 * hh + (i16 >> 2)) * ML_VP + (16 * (grp & 1) + 4 * (i16 & 3)) * 2;
#pragma unroll
            for (int st = 0; st < 8; ++st) {
                const bf16x8 av = tr_pair(VS + st * 16 * ML_VP + roff + vt * 64, 4 * ML_VP);
                const bf16x8 b0 = tr_pair(KS + st * 16 * ML_VP + roff + kt0 * 64, 4 * ML_VP), b1 = tr_pair(KS + st * 16 * ML_VP + roff + (kt0 + 1) * 64, 4 * ML_VP);
                d0 = __builtin_amdgcn_mfma_f32_32x32x16_bf16(av, b0, d0, 0, 0, 0); d1 = __builtin_amdgcn_mfma_f32_32x32x16_bf16(av, b1, d1, 0, 0, 0);
            }
            bf16* dp = Dbuf + (size_t)u * 16384 + (size_t)(32 * vt + 4 * hh) * 128 + 32 * kt0 + col;
#pragma unroll
            for (int i = 0; i < 16; ++i) { const int vr = (i & 3) + 8 * (i >> 2); dp[vr * 128] = (bf16)f2bf(d0[i]); dp[vr * 128 + 32] = (bf16)f2bf(d1[i]); }
            const int k = tid & 127, part = tid >> 7; float sacc = 0.f;
            for (int s2 = 0; s2 < 32; ++s2) sacc += bf2f(*(LAS bf16*)(KS + (32 * part + s2) * ML_VP + k * 2));
            nred[part * 128 + k] = sacc;
        }
        __syncthreads();
        if (tid < 128) nloc[(size_t)u * 128 + tid] = nred[tid] + nred[128 + tid] + nred[256 + tid] + nred[384 + tid];
        if (qr < 2 * 16384) { quant_table_rows(c, a, qr); qr += c.NGW * 4; }
        __syncthreads();
    }
    for (; qr < 2 * 16384; qr += c.NGW * 4) quant_table_rows(c, a, qr);
}

__device__ __forceinline__ void ph_m3(const Ctx& c, const Args& a, const bf16* proj, const float* ipre, const float* logf, const bf16* mq, const bf16* mk, const unsigned char* ob, bf16* concat) {
    const float* mh_g = a.in[8];
    const bf16* Dbuf = (const bf16*)(ob + OUT_DBUF); const float* nloc = (const float*)(ob + OUT_NLOC); const float* csc = (const float*)(ob + OUT_CSC);
    LAS unsigned char* VS = c.ldsl; LAS unsigned char* CS = c.ldsl + 40960; LAS unsigned char* OST = CS; LAS unsigned char* KS = c.ldsl + 81920;
    LAS float* utab = (LAS float*)(c.ldsl + 75776); LAS float* mxt = utab + 128; LAS float* wit = utab + 256; LAS float* ednt = utab + 384; LAS float* nvec = utab + 512;
    LAS float* nrm = (LAS float*)(c.ldsl + 78848);
    LAS float* coef = (LAS float*)(c.ldsl + 116736);
    const int tid = c.tid, lane = c.lane, wave = c.wave, col = lane & 31, hh = lane >> 5, i16 = lane & 15, grp = lane >> 4;
    for (int ui = blockIdx.x; ui < 1024; ui += c.G) {
        const int bh = ui >> 4, cc = ((ui & 15) + 5 * (bh >> 4) + bh) & 15, b = bh >> 2, h = bh & 3, bt0 = b * S_ + cc * 128;
        float mc = 0.f;
        for (int c2 = 0; c2 < cc; ++c2) mc = fmaxf(csc[2 * (bh * 16 + c2)] + mc, csc[2 * (bh * 16 + c2) + 1]);
        const int tt = wave & 3, vh = wave >> 2, t = 32 * tt + col;
        bf16x8 bq[8];
        { const bf16* qp = mq + (size_t)(bt0 + t) * 512 + h * 128 + 8 * hh;
#pragma unroll
          for (int s2 = 0; s2 < 8; ++s2) bq[s2] = *(const bf16x8*)(qp + 16 * s2); }
        if (tid < 16) { float suf = 0.f; for (int c2 = cc - 1; c2 > tid; --c2) suf += csc[2 * (bh * 16 + c2)];
            coef[tid] = (tid < cc) ? expf(csc[2 * (bh * 16 + tid) + 1] + suf - mc) : 0.f; }
        if (wave == 1) {
            const ChunkGates g = chunk_gates(ipre, logf, bt0, h, lane);
            float incm = fmaxf(g.u0, g.u1);
#pragma unroll
            for (int o = 1; o < 64; o <<= 1) { const float n = __shfl_up(incm, o); if (lane >= o) incm = fmaxf(incm, n); }
            float exm = __shfl_up(incm, 1); if (lane == 0) exm = -INFINITY;
            const float M0 = fmaxf(mc, fmaxf(exm, g.u0)), M1 = fmaxf(mc, incm);
            utab[2 * lane] = g.u0; utab[2 * lane + 1] = g.u1; mxt[2 * lane] = M0; mxt[2 * lane + 1] = M1;
            wit[2 * lane] = expf(mc - M0); wit[2 * lane + 1] = expf(mc - M1); ednt[2 * lane] = expf(-(g.bc0 + M0)); ednt[2 * lane + 1] = expf(-(g.bc1 + M1));
        }
#pragma unroll
        for (int q = 0; q < 4; ++q) { const int id = tid + 512 * q, row = id >> 4, ch = id & 15;
            *(LAS u32x4*)(VS + row * ML_VP + ch * 16) = *(const u32x4*)(proj + (size_t)(bt0 + row) * NPROJ + C_VM + h * 128 + 8 * ch);
            *(LAS u32x4*)(KS + row * ML_XP + ch * 16) = *(const u32x4*)(mk + (size_t)(bt0 + row) * 512 + h * 128 + 8 * ch); }
        __syncthreads();
#pragma unroll
        for (int q = 0; q < 4; ++q) {
            const int id = tid + 512 * q, row = id >> 4, ch = id & 15;
            float acc[8] = {0.f, 0.f, 0.f, 0.f, 0.f, 0.f, 0.f, 0.f};
            for (int c2 = 0; c2 < cc; ++c2) {
                const float cf = coef[c2]; const u32x4 dv = *(const u32x4*)(Dbuf + (size_t)(bh * 16 + c2) * 16384 + row * 128 + 8 * ch);
                acc[0] += cf * __uint_as_float(dv.x << 16); acc[1] += cf * __uint_as_float(dv.x & 0xffff0000u); acc[2] += cf * __uint_as_float(dv.y << 16); acc[3] += cf * __uint_as_float(dv.y & 0xffff0000u);
                acc[4] += cf * __uint_as_float(dv.z << 16); acc[5] += cf * __uint_as_float(dv.z & 0xffff0000u); acc[6] += cf * __uint_as_float(dv.w << 16); acc[7] += cf * __uint_as_float(dv.w & 0xffff0000u);
            }
            u32x4 o; o.x = cvtpk(acc[0], acc[1]); o.y = cvtpk(acc[2], acc[3]); o.z = cvtpk(acc[4], acc[5]); o.w = cvtpk(acc[6], acc[7]);
            *(LAS u32x4*)(CS + row * ML_XP + ch * 16) = o;
        }
        if (tid < 128) { float nv = 0.f; for (int c2 = 0; c2 < cc; ++c2) nv += coef[c2] * nloc[(size_t)(bh * 16 + c2) * 128 + tid]; nvec[tid] = nv; }
        __syncthreads();
        const float Mt = mxt[t], wint = wit[t], edn = ednt[t];
        f32x16 acc[2];
#pragma unroll
        for (int vtl = 0; vtl < 2; ++vtl) {
#pragma unroll
            for (int i = 0; i < 16; ++i) acc[vtl][i] = 0.f;
#pragma unroll
            for (int s2 = 0; s2 < 8; ++s2) { const bf16x8 af = *(LAS bf16x8*)(CS + (64 * vh + 32 * vtl + col) * ML_XP + (16 * s2 + 8 * hh) * 2); acc[vtl] = __builtin_amdgcn_mfma_f32_32x32x16_bf16(af, bq[s2], acc[vtl], 0, 0, 0); }
#pragma unroll
            for (int i = 0; i < 16; ++i) acc[vtl][i] *= wint;
        }
        float qn = 0.f;
#pragma unroll
        for (int s2 = 0; s2 < 8; ++s2) {
            const f32x4 n0 = *(LAS f32x4*)(nvec + 16 * s2 + 8 * hh), n1 = *(LAS f32x4*)(nvec + 16 * s2 + 8 * hh + 4);
            const unsigned* qw = (const unsigned*)&bq[s2];
            qn += __uint_as_float(qw[0] << 16) * n0[0] + __uint_as_float(qw[0] & 0xffff0000u) * n0[1] + __uint_as_float(qw[1] << 16) * n0[2] + __uint_as_float(qw[1] & 0xffff0000u) * n0[3];
            qn += __uint_as_float(qw[2] << 16) * n1[0] + __uint_as_float(qw[2] & 0xffff0000u) * n1[1] + __uint_as_float(qw[3] << 16) * n1[2] + __uint_as_float(qw[3] & 0xffff0000u) * n1[3];
        }
        qn += __shfl_xor(qn, 32);
        float dsum = 0.f;
        for (int st = 0; st <= tt; ++st) {
            f32x16 sT;
#pragma unroll
            for (int i = 0; i < 16; ++i) sT[i] = 0.f;
#pragma unroll
            for (int s2 = 0; s2 < 8; ++s2) { const bf16x8 kf = *(LAS bf16x8*)(KS + (32 * st + col) * ML_XP + (16 * s2 + 8 * hh) * 2); sT = __builtin_amdgcn_mfma_f32_32x32x16_bf16(kf, bq[s2], sT, 0, 0, 0); }
            f32x16 p;
#pragma unroll
            for (int q4 = 0; q4 < 4; ++q4) {
                const f32x4 uu = *(LAS f32x4*)(utab + 32 * st + 8 * q4 + 4 * hh);
#pragma unroll
                for (int e = 0; e < 4; ++e) { const int cr = 8 * q4 + 4 * hh + e; const bool ok = (st < tt) || (cr <= col);
                    const float pv = ok ? expf(uu[e] - Mt) * sT[4 * q4 + e] : 0.f; p[4 * q4 + e] = pv; dsum += pv; }
            }
            const bf16x8 pb0 = pack8(p, 0), pb1 = pack8(p, 8);
#pragma unroll
            for (int vtl = 0; vtl < 2; ++vtl)
#pragma unroll
                for (int ks = 0; ks < 2; ++ks) {
                    const bf16x8 av = tr_pair(VS + (32 * st + 16 * ks + 4 * hh + (i16 >> 2)) * ML_VP + (64 * vh + 32 * vtl + 16 * (grp & 1) + 4 * (i16 & 3)) * 2, 8 * ML_VP);
                    acc[vtl] = __builtin_amdgcn_mfma_f32_32x32x16_bf16(av, ks ? pb1 : pb0, acc[vtl], 0, 0, 0);
                }
        }
        dsum += __shfl_xor(dsum, 32);
        const float den = wint * qn + dsum, inv = 1.f / fmaxf(fabsf(den), edn);
        float s1 = 0.f, s2q = 0.f;
#pragma unroll
        for (int vtl = 0; vtl < 2; ++vtl)
#pragma unroll
            for (int i = 0; i < 16; ++i) { const float hv = acc[vtl][i] * inv; acc[vtl][i] = hv; s1 += hv; s2q += hv * hv; }
        s1 += __shfl_xor(s1, 32); s2q += __shfl_xor(s2q, 32);
        if (hh == 0) { nrm[(vh * 128 + t) * 2] = s1; nrm[(vh * 128 + t) * 2 + 1] = s2q; }
        __syncthreads();
        s1 += nrm[((vh ^ 1) * 128 + t) * 2]; s2q += nrm[((vh ^ 1) * 128 + t) * 2 + 1];
        const float mu = s1 * (1.f / 128.f), var = fmaxf(s2q * (1.f / 128.f) - mu * mu, 0.f), rstd = 1.f / sqrtf(var + LN_EPS);
        const bf16* omp = proj + (size_t)(bt0 + t) * NPROJ + C_OM + h * 128;
#pragma unroll
        for (int vtl = 0; vtl < 2; ++vtl)
#pragma unroll
            for (int q4 = 0; q4 < 4; ++q4) {
                const int v0 = 64 * vh + 32 * vtl + 8 * q4 + 4 * hh;
                const u32x2 ow = *(const u32x2*)(omp + v0); const f32x4 gg = *(const f32x4*)(mh_g + h * 128 + v0);
                const float o0 = __uint_as_float(ow.x << 16), o1 = __uint_as_float(ow.x & 0xffff0000u), o2 = __uint_as_float(ow.y << 16), o3 = __uint_as_float(ow.y & 0xffff0000u);
                const float r0 = (acc[vtl][4 * q4] - mu) * rstd * gg[0] / (1.f + expf(-o0)), r1 = (acc[vtl][4 * q4 + 1] - mu) * rstd * gg[1] / (1.f + expf(-o1));
                const float r2 = (acc[vtl][4 * q4 + 2] - mu) * rstd * gg[2] / (1.f + expf(-o2)), r3 = (acc[vtl][4 * q4 + 3] - mu) * rstd * gg[3] / (1.f + expf(-o3));
                u32x2 w; w.x = cvtpk(r0, r1); w.y = cvtpk(r2, r3);
                *(LAS u32x2*)(OST + t * ML_XP + v0 * 2) = w;
            }
        __syncthreads();
#pragma unroll
        for (int q = 0; q < 4; ++q) { const int id = tid + 512 * q, row = id >> 4, ch = id & 15;
            *(u32x4*)(concat + (size_t)(bt0 + row) * D_ + 512 + h * 128 + 8 * ch) = *(LAS u32x4*)(OST + row * ML_XP + ch * 16); }
        __syncthreads();
    }
}
__device__ __forceinline__ void ph_ln1(const Ctx& c, const bf16* y1, const float* g, const float* bb, float2* st1, unsigned* xq, float* sx) {
    constexpr int RB = 4;
    for (int row0 = c.gw * RB; row0 < T_; row0 += c.NGW * RB) {
      uint2 yv[RB][4];
#pragma unroll
      for (int r = 0; r < RB; ++r) { const uint2* p = (const uint2*)(y1 + (size_t)(row0 + r) * D_) + c.lane;
#pragma unroll
          for (int j = 0; j < 4; ++j) yv[r][j] = p[64 * j]; }
#pragma unroll
      for (int r = 0; r < RB; ++r) {
        const int row = row0 + r; float4 v[4]; float s = 0.f;
#pragma unroll
        for (int j = 0; j < 4; ++j) { const uint2 w = yv[r][j]; v[j].x = __uint_as_float(w.x << 16); v[j].y = __uint_as_float(w.x & 0xffff0000u); v[j].z = __uint_as_float(w.y << 16); v[j].w = __uint_as_float(w.y & 0xffff0000u);
            s += v[j].x + v[j].y + v[j].z + v[j].w; }
        const float mu = wave_sum(s) * (1.f / D_); float q = 0.f;
#pragma unroll
        for (int j = 0; j < 4; ++j) { v[j].x -= mu; v[j].y -= mu; v[j].z -= mu; v[j].w -= mu; q += v[j].x * v[j].x + v[j].y * v[j].y + v[j].z * v[j].z + v[j].w * v[j].w; }
        const float rstd = 1.f / sqrtf(wave_sum(q) * (1.f / D_) + LN_EPS);
        float4 ov[4]; float am = 0.f;
#pragma unroll
        for (int j = 0; j < 4; ++j) { const int cc = (64 * j + c.lane) * 4; const float4 gg = *(const float4*)(g + cc), b4 = *(const float4*)(bb + cc);
            float4 o; o.x = v[j].x * rstd * gg.x + b4.x; o.y = v[j].y * rstd * gg.y + b4.y; o.z = v[j].z * rstd * gg.z + b4.z; o.w = v[j].w * rstd * gg.w + b4.w;
            ov[j] = o; am = fmaxf(am, fmaxf(fmaxf(fabsf(o.x), fabsf(o.y)), fmaxf(fabsf(o.z), fabsf(o.w)))); }
        am = fmaxf(wave_max(am), 1e-30f); const float inv = 127.f / am;
        if (c.lane == 0) { sx[row] = am * (1.f / 127.f); st1[row] = make_float2(mu, rstd); }
#pragma unroll
        for (int j = 0; j < 4; ++j) xq[(size_t)row * 256 + 64 * j + c.lane] = (unsigned)((__float2int_rn(ov[j].x * inv) & 0xff) | ((__float2int_rn(ov[j].y * inv) & 0xff) << 8) | ((__float2int_rn(ov[j].z * inv) & 0xff) << 16) | (__float2int_rn(ov[j].w * inv) << 24));
      }
    }
}
__device__ __forceinline__ int kmax(int a, int b) { int r; asm("v_max_f32 %0, %1, %2" : "=v"(r) : "v"(a), "v"(b)); return r; }
__device__ __forceinline__ int kmin(int a, int b) { int r; asm("v_min_f32 %0, %1, %2" : "=v"(r) : "v"(a), "v"(b)); return r; }
__device__ __forceinline__ void ced(int& a, int& b) { const int hi = kmax(a, b), lo = kmin(a, b); a = hi; b = lo; }
__device__ __forceinline__ void sort16_desc(int (&k)[16]) {
    ced(k[0], k[1]); ced(k[2], k[3]); ced(k[4], k[5]); ced(k[6], k[7]); ced(k[8], k[9]); ced(k[10], k[11]); ced(k[12], k[13]); ced(k[14], k[15]);
    ced(k[0], k[2]); ced(k[1], k[3]); ced(k[4], k[6]); ced(k[5], k[7]); ced(k[8], k[10]); ced(k[9], k[11]); ced(k[12], k[14]); ced(k[13], k[15]);
    ced(k[1], k[2]); ced(k[5], k[6]); ced(k[0], k[4]); ced(k[3], k[7]); ced(k[9], k[10]); ced(k[13], k[14]); ced(k[8], k[12]); ced(k[11], k[15]);
    ced(k[2], k[6]); ced(k[1], k[5]); ced(k[10], k[14]); ced(k[9], k[13]); ced(k[0], k[8]); ced(k[7], k[15]);
    ced(k[2], k[4]); ced(k[3], k[5]); ced(k[10], k[12]); ced(k[11], k[13]);
    ced(k[1], k[2]); ced(k[3], k[4]); ced(k[5], k[6]); ced(k[9], k[10]); ced(k[11], k[12]); ced(k[13], k[14]);
    ced(k[4], k[12]); ced(k[2], k[10]); ced(k[6], k[14]); ced(k[1], k[9]); ced(k[5], k[13]); ced(k[3], k[11]);
    ced(k[4], k[8]); ced(k[6], k[10]); ced(k[5], k[9]); ced(k[7], k[11]);
    ced(k[2], k[4]); ced(k[6], k[8]); ced(k[10], k[12]); ced(k[3], k[5]); ced(k[7], k[9]); ced(k[11], k[13]);
    ced(k[1], k[2]); ced(k[3], k[4]); ced(k[5], k[6]); ced(k[7], k[8]); ced(k[9], k[10]); ced(k[11], k[12]); ced(k[13], k[14]);
}
__device__ __forceinline__ void merge16_desc(int (&k)[16]) {
#pragma unroll
    for (int stride = 8; stride > 0; stride >>= 1)
#pragma unroll
        for (int i = 0; i < 16; ++i) { const int j = i ^ stride; if (j > i) ced(k[i], k[j]); }
}
__device__ __forceinline__ void top16_of(int (&a)[16], const int (&b)[16]) {
#pragma unroll
    for (int i = 0; i < 16; ++i) a[i] = kmax(a[i], b[15 - i]);
    merge16_desc(a);
}
__device__ __forceinline__ void top16_tile(const f32x16& acc, int kt, int hh, int (&top)[16]) {
    int g[16];
#pragma unroll
    for (int i = 0; i < 16; ++i) { const int idx = 32 * kt + (i & 3) + 8 * (i >> 2) + 4 * hh; g[i] = (__float_as_int(acc[i]) & ~127) | idx; }
    sort16_desc(g);
    if (kt == 0) {
#pragma unroll
        for (int i = 0; i < 16; ++i) top[i] = g[i];
    } else top16_of(top, g);
}
__device__ __forceinline__ void ph_route(const Ctx& c, const bf16* qry, const bf16* SK, unsigned* eidx, float* gate) {
    const int lane = c.lane, col = lane & 31, hh = lane >> 5;
    pg8::StaticOrder S; S.init(T_, 2048, c.G, (int)blockIdx.x); pg8::Unit u;
    for (int ui = 0; S.next(ui, u); ++ui) {
        const int h = u.pn, t0 = u.pm * 256 + 32 * c.wave;
        int top[2][16];
#pragma unroll
        for (int p = 0; p < 2; ++p) {
            bf16x8 bq[8];
            const bf16* qrow = qry + (size_t)(t0 + col) * 2048 + h * 256 + p * 128 + 8 * hh;
#pragma unroll
            for (int s = 0; s < 8; ++s) bq[s] = *(const bf16x8*)(qrow + 16 * s);
            const bf16* krow = SK + ((size_t)(h * 2 + p) * 128 + col) * 128 + 8 * hh;
#pragma unroll
            for (int kt = 0; kt < 4; ++kt) {
                f32x16 acc;
                const bf16* kr = krow + (size_t)kt * 32 * 128; asm volatile("" : "+v"(kr));
#pragma unroll
                for (int i = 0; i < 16; ++i) acc[i] = 0.f;
#pragma unroll
                for (int s = 0; s < 8; ++s) { const bf16x8 ka = *(const bf16x8*)(kr + 16 * s); acc = __builtin_amdgcn_mfma_f32_32x32x16_bf16(ka, bq[s], acc, 0, 0, 0); }
                top16_tile(acc, kt, hh, top[p]);
            }
            { int g[16];
#pragma unroll
              for (int i = 0; i < 16; ++i) g[i] = __shfl_xor(top[p][i], 32);
              top16_of(top[p], g); }
        }
        float f1[16], f2[16]; int i1[16], i2[16];
#pragma unroll
        for (int i = 0; i < 16; ++i) { f1[i] = __int_as_float(top[0][i]); i1[i] = (top[0][i] & 127) << 7; f2[i] = __int_as_float(top[1][i]); i2[i] = top[1][i] & 127; }
#define CK(a, b) ((__float_as_int(f1[a] + f2[b]) & ~0x3fff) | i1[a] | i2[b])
        int k0[16], k1[16], k2[16];
#pragma unroll
        for (int b = 0; b < 16; ++b) k0[b] = CK(0, b);
#pragma unroll
        for (int b = 0; b < 8; ++b) { k1[b] = CK(1, b); k1[8 + b] = CK(15 - b, 0); }
        merge16_desc(k1);
        k2[0] = CK(2, 0); k2[1] = CK(2, 1); k2[2] = CK(2, 2); k2[3] = CK(2, 3); k2[4] = CK(2, 4); k2[5] = CK(3, 0); k2[6] = CK(3, 1); k2[7] = CK(3, 2); k2[8] = CK(3, 3);
        k2[9] = CK(4, 0); k2[10] = CK(4, 1); k2[11] = CK(4, 2); k2[12] = CK(5, 0); k2[13] = CK(5, 1); k2[14] = CK(6, 0); k2[15] = CK(6, 1);
        sort16_desc(k2);
        k2[15] = kmax(k2[15], CK(7, 0)); k2[14] = kmax(k2[14], CK(7, 1));
        merge16_desc(k2);
        top16_of(k0, k1);
        top16_of(k0, k2);
#undef CK
        int p0[16];
#pragma unroll
        for (int i = 0; i < 16; ++i) { p0[i] = k0[i] & 0x3fff; k0[i] &= ~0x3fff; }
        float e[16]; float den = 0.f; const float m = __int_as_float(k0[0]);
#pragma unroll
        for (int i = 0; i < 16; ++i) { e[i] = __builtin_amdgcn_exp2f((__int_as_float(k0[i]) - m) * 1.4426950408889634f); den += e[i]; }
        const float inv = 1.f / den;
        float4 og[2];
        og[0].x = (hh ? e[8] : e[0]) * inv; og[0].y = (hh ? e[9] : e[1]) * inv; og[0].z = (hh ? e[10] : e[2]) * inv; og[0].w = (hh ? e[11] : e[3]) * inv;
        og[1].x = (hh ? e[12] : e[4]) * inv; og[1].y = (hh ? e[13] : e[5]) * inv; og[1].z = (hh ? e[14] : e[6]) * inv; og[1].w = (hh ? e[15] : e[7]) * inv;
        const size_t ob = (size_t)(t0 + col) * 128 + h * 16 + hh * 8;
        *(float4*)(gate + ob) = og[0]; *(float4*)(gate + ob + 4) = og[1];
        { uint4 o;
            o.x = (unsigned)(hh ? p0[4] : p0[0]) | ((unsigned)(hh ? p0[12] : p0[8]) << 16); o.y = (unsigned)(hh ? p0[5] : p0[1]) | ((unsigned)(hh ? p0[13] : p0[9]) << 16);
            o.z = (unsigned)(hh ? p0[6] : p0[2]) | ((unsigned)(hh ? p0[14] : p0[10]) << 16); o.w = (unsigned)(hh ? p0[7] : p0[3]) | ((unsigned)(hh ? p0[15] : p0[11]) << 16);
            *(uint4*)(eidx + ((size_t)(t0 + col) * 8 + h) * 8 + 4 * hh) = o; }
    }
}
typedef __bf16 v2bf __attribute__((ext_vector_type(2)));
__device__ __forceinline__ float dot2bf(unsigned a, unsigned b, float c) { return __builtin_amdgcn_fdot2_f32_bf16(__builtin_bit_cast(v2bf, a), __builtin_bit_cast(v2bf, b), c, false); }
template <int CTRL> __device__ __forceinline__ float dppf(float v) { return __int_as_float(__builtin_amdgcn_mov_dpp(__float_as_int(v), CTRL, 0xF, 0xF, true)); }
__device__ __forceinline__ float sum8(float v) { v += dppf<0xB1>(v); v += dppf<0x4E>(v); v += dppf<0x141>(v); return v; }
struct SliceMap { int j, sw, nsw; };
__device__ __forceinline__ SliceMap slice_map(const Ctx& c, unsigned* bar) {
    volatile LAS unsigned* st = (volatile LAS unsigned*)(c.ldsl + MISC_OFF);
    if (c.tid == 0) { unsigned even = (c.G % 8 == 0) ? 1u : 0u;
        for (unsigned j = 0; j < 16; ++j) { const unsigned cnt = xb_ld(&bar[XB_XCNT(j)]); if (cnt != (j < 8 ? (unsigned)c.G / 8u : 0u)) even = 0u; }
        st[4] = even; }
    __syncthreads();
    SliceMap m; m.nsw = c.G;
    if (st[4]) { m.j = (int)st[2]; m.sw = (int)st[3] * NWAVES + c.wave; }
    else { const bool sl = (c.G % 8) == 0; m.j = sl ? (int)(blockIdx.x & 7) : (c.gw & 7); m.sw = sl ? (int)(blockIdx.x >> 3) * NWAVES + c.wave : (c.gw >> 3); }
    m.j = __builtin_amdgcn_readfirstlane(m.j); m.sw = __builtin_amdgcn_readfirstlane(m.sw);
    __syncthreads();
    return m;
}
typedef float f32x2 __attribute__((ext_vector_type(2)));
template <int S> __device__ __forceinline__ unsigned bcast8(unsigned v, bool inq0) {
    const unsigned q = (unsigned)__builtin_amdgcn_mov_dpp((int)v, (S & 3) * 0x55, 0xF, 0xF, true);
    const unsigned r = (unsigned)__builtin_amdgcn_mov_dpp((int)q, 0x141, 0xF, 0xF, true);
    return ((S < 4) == inq0) ? q : r;
}
template <int HF> __device__ __forceinline__ void gather8(u32x4 (&w)[8], const unsigned char* wslice, unsigned moff, unsigned idw, bool inq0) {
#define G8ROW(R) { const unsigned b = bcast8<R>(idw, inq0); const unsigned id = HF ? (b >> 16) : (b & 0xffffu); w[R] = *(const u32x4*)(wslice + ((id << 7) + moff)); }
    G8ROW(0) G8ROW(1) G8ROW(2) G8ROW(3) G8ROW(4) G8ROW(5) G8ROW(6) G8ROW(7)
#undef G8ROW
}
template <int CTRL> __device__ __forceinline__ int dppi(int v) { return __builtin_amdgcn_mov_dpp(v, CTRL, 0xF, 0xF, true); }
__device__ __forceinline__ int g1_half(const u32x4 (&w)[8], const u32x4 xq, int m) {
    int d[8];
#pragma unroll
    for (int i = 0; i < 8; ++i) {
        int v = __builtin_amdgcn_sdot4((int)w[i].x, (int)xq.x, 0, false); v = __builtin_amdgcn_sdot4((int)w[i].y, (int)xq.y, v, false);
        v = __builtin_amdgcn_sdot4((int)w[i].z, (int)xq.z, v, false); d[i] = __builtin_amdgcn_sdot4((int)w[i].w, (int)xq.w, v, false);
    }
    const bool lo = m < 4, b1 = (m & 2) != 0, b0 = (m & 1) != 0;
    int e[4], f[2];
#pragma unroll
    for (int i = 0; i < 4; ++i) e[i] = (lo ? d[i] : d[i + 4]) + dppi<0x141>(lo ? d[i + 4] : d[i]);
#pragma unroll
    for (int i = 0; i < 2; ++i) f[i] = (b1 ? e[i + 2] : e[i]) + dppi<0x4E>(b1 ? e[i] : e[i + 2]);
    return (b0 ? f[1] : f[0]) + dppi<0xB1>(b0 ? f[0] : f[1]);
}
#define TOK(i) (t0 + (i) * ns)
#define IDX(t) (*(const unsigned*)((const unsigned char*)(eidx + (size_t)(t) * 64) + loff))
__device__ __forceinline__ void ph_g1(const Ctx& c, unsigned* bar, const unsigned char* xq, const float* sx, const unsigned char* Wd, const unsigned* eidx, bf16* apart) {
    const int lane = c.lane, g = lane >> 3, m = lane & 7; const bool inq0 = m < 4; const SliceMap sm = slice_map(c, bar);
    const int j = sm.j, ns = sm.nsw, t0 = sm.sw;
    const unsigned char* wsl = Wd + (size_t)j * (16384 * 128); const unsigned moff = 16u * m, loff = 4u * lane, soff = 2u * (16 * g + m);
    const unsigned char* xs = xq + 128 * j; bf16* as_ = apart + (size_t)j * T_ * 128;
#define XLD(t) (*(const u32x4*)(xs + (size_t)(t) * D_ + moff))
#define AST(t, o0, o1) do { const float sc_ = sx[t]; unsigned char* ap_ = (unsigned char*)(as_ + (size_t)(t) * 128) + soff; *(bf16*)ap_ = (bf16)f2bf((float)(o0) * sc_); *(bf16*)(ap_ + 16) = (bf16)f2bf((float)(o1) * sc_); } while (0)
    u32x4 W0[8], W1[8], W2[8], W3[8]; unsigned n1A = 0, n1B = 0, n2A = 0, n2B = 0; u32x4 xpA, xpB, xnA, xnB;
    if (TOK(0) < T_) { n2A = IDX(TOK(0)); xpA = XLD(TOK(0)); }
    if (TOK(1) < T_) { n2B = IDX(TOK(1)); xpB = XLD(TOK(1)); }
    if (TOK(0) < T_) { gather8<0>(W0, wsl, moff, n2A, inq0); gather8<1>(W1, wsl, moff, n2A, inq0); }
    if (TOK(1) < T_) { gather8<0>(W2, wsl, moff, n2B, inq0); gather8<1>(W3, wsl, moff, n2B, inq0); }
    if (TOK(2) < T_) n1A = IDX(TOK(2));
    if (TOK(3) < T_) n1B = IDX(TOK(3));
    const int NT = (T_ - t0 + ns - 1) / ns;
    int i = 0;
    for (; i + 5 < NT; i += 2) {
        const int tA = TOK(i), tB = TOK(i + 1), tA1 = TOK(i + 2), tB1 = TOK(i + 3), tA2 = TOK(i + 4), tB2 = TOK(i + 5);
        n2A = IDX(tA2); n2B = IDX(tB2); xnA = XLD(tA1); xnB = XLD(tB1);
        { const int o0 = g1_half(W0, xpA, m); gather8<0>(W0, wsl, moff, n1A, inq0);
          const int o1 = g1_half(W1, xpA, m); gather8<1>(W1, wsl, moff, n1A, inq0);
          AST(tA, o0, o1); }
        { const int o0 = g1_half(W2, xpB, m); gather8<0>(W2, wsl, moff, n1B, inq0);
          const int o1 = g1_half(W3, xpB, m); gather8<1>(W3, wsl, moff, n1B, inq0);
          AST(tB, o0, o1); }
        n1A = n2A; n1B = n2B; xpA = xnA; xpB = xnB;
    }
    for (; i < NT; i += 2) {
        const int tA = TOK(i), tB = TOK(i + 1), tA1 = TOK(i + 2), tB1 = TOK(i + 3), tA2 = TOK(i + 4), tB2 = TOK(i + 5);
        if (tA2 < T_) n2A = IDX(tA2);
        if (tB2 < T_) n2B = IDX(tB2);
        if (tA1 < T_) xnA = XLD(tA1);
        if (tB1 < T_) xnB = XLD(tB1);
        { const int o0 = g1_half(W0, xpA, m); if (tA1 < T_) gather8<0>(W0, wsl, moff, n1A, inq0);
          const int o1 = g1_half(W1, xpA, m); if (tA1 < T_) gather8<1>(W1, wsl, moff, n1A, inq0);
          AST(tA, o0, o1); }
        if (tB < T_) {
          const int o0 = g1_half(W2, xpB, m); if (tB1 < T_) gather8<0>(W2, wsl, moff, n1B, inq0);
          const int o1 = g1_half(W3, xpB, m); if (tB1 < T_) gather8<1>(W3, wsl, moff, n1B, inq0);
          AST(tB, o0, o1); }
        n1A = n2A; n1B = n2B; xpA = xnA; xpB = xnB;
    }
#undef XLD
#undef AST
}
__device__ __forceinline__ void ph_afin(const Ctx& c, const bf16* apart, const float* gate, const unsigned* eidx, const float* scd, const float* scu, unsigned char* aq, float* sa) {
    for (int it = blockIdx.x * NTHREADS + c.tid; it < T_ * 16; it += c.G * NTHREADS) {
        const int t = it >> 4, g = (it >> 1) & 7, m0 = (it & 1) * 4; const size_t k0 = (size_t)t * 128 + 16 * g + m0;
        float4 sl = {0.f, 0.f, 0.f, 0.f}, sh = {0.f, 0.f, 0.f, 0.f};
#pragma unroll
        for (int j = 0; j < 8; ++j) { const uint2 a0 = *(const uint2*)(apart + (size_t)j * T_ * 128 + k0), a1 = *(const uint2*)(apart + (size_t)j * T_ * 128 + k0 + 8);
            sl.x += __uint_as_float(a0.x << 16); sl.y += __uint_as_float(a0.x & 0xffff0000u); sl.z += __uint_as_float(a0.y << 16); sl.w += __uint_as_float(a0.y & 0xffff0000u);
            sh.x += __uint_as_float(a1.x << 16); sh.y += __uint_as_float(a1.x & 0xffff0000u); sh.z += __uint_as_float(a1.y << 16); sh.w += __uint_as_float(a1.y & 0xffff0000u); }
        const float4 gl = *(const float4*)(gate + k0), gh = *(const float4*)(gate + k0 + 8);
        const uint4 ep = *(const uint4*)(eidx + ((size_t)t * 8 + g) * 8 + m0);
        const unsigned ew[4] = {ep.x, ep.y, ep.z, ep.w}; const float lo[4] = {sl.x, sl.y, sl.z, sl.w}, hi[4] = {sh.x, sh.y, sh.z, sh.w}, gl4[4] = {gl.x, gl.y, gl.z, gl.w}, gh4[4] = {gh.x, gh.y, gh.z, gh.w};
        float al[4], ah[4]; float am = 0.f;
#pragma unroll
        for (int q = 0; q < 4; ++q) { const int e0 = ew[q] & 0xffff, e1 = ew[q] >> 16;
            const float u0 = lo[q] * scd[e0], u1 = hi[q] * scd[e1];
            al[q] = 0.5f * u0 * (1.f + erff(u0 * 0.7071067811865476f)) * gl4[q] * scu[e0]; ah[q] = 0.5f * u1 * (1.f + erff(u1 * 0.7071067811865476f)) * gh4[q] * scu[e1];
            am = fmaxf(am, fmaxf(fabsf(al[q]), fabsf(ah[q]))); }
        am = fmaxf(am, dppf<0xB1>(am)); am = fmaxf(am, dppf<0x4E>(am)); am = fmaxf(am, dppf<0x141>(am)); am = fmaxf(am, dppf<0x140>(am));
        am = fmaxf(am, 1e-30f); const float inv = 127.f / am;
        const unsigned pl = (unsigned)((__float2int_rn(al[0] * inv) & 0xff) | ((__float2int_rn(al[1] * inv) & 0xff) << 8) | ((__float2int_rn(al[2] * inv) & 0xff) << 16) | (__float2int_rn(al[3] * inv) << 24));
        const unsigned ph = (unsigned)((__float2int_rn(ah[0] * inv) & 0xff) | ((__float2int_rn(ah[1] * inv) & 0xff) << 8) | ((__float2int_rn(ah[2] * inv) & 0xff) << 16) | (__float2int_rn(ah[3] * inv) << 24));
        *(unsigned*)(aq + k0) = pl; *(unsigned*)(aq + k0 + 8) = ph;
        if ((it & 15) == 0) sa[t] = am * (1.f / 127.f);
    }
}
template <int R0> __device__ __forceinline__ void g2_set(int (&acc)[16], const u32x4 (&w)[8], unsigned ap) {
    const unsigned r0[4] = {w[R0].x, w[R0].y, w[R0].z, w[R0].w}, r1[4] = {w[R0 + 1].x, w[R0 + 1].y, w[R0 + 1].z, w[R0 + 1].w};
    const unsigned r2[4] = {w[R0 + 2].x, w[R0 + 2].y, w[R0 + 2].z, w[R0 + 2].w}, r3[4] = {w[R0 + 3].x, w[R0 + 3].y, w[R0 + 3].z, w[R0 + 3].w};
#pragma unroll
    for (int cq = 0; cq < 4; ++cq) {
        const unsigned t0 = __builtin_amdgcn_perm(r1[cq], r0[cq], 0x05010400u), t1 = __builtin_amdgcn_perm(r1[cq], r0[cq], 0x07030602u);
        const unsigned t2 = __builtin_amdgcn_perm(r3[cq], r2[cq], 0x05010400u), t3 = __builtin_amdgcn_perm(r3[cq], r2[cq], 0x07030602u);
        const unsigned o0 = __builtin_amdgcn_perm(t2, t0, 0x05040100u), o1 = __builtin_amdgcn_perm(t2, t0, 0x07060302u), o2 = __builtin_amdgcn_perm(t3, t1, 0x05040100u), o3 = __builtin_amdgcn_perm(t3, t1, 0x07060302u);
        acc[4 * cq + 0] = __builtin_amdgcn_sdot4((int)o0, (int)ap, acc[4 * cq + 0], false); acc[4 * cq + 1] = __builtin_amdgcn_sdot4((int)o1, (int)ap, acc[4 * cq + 1], false);
        acc[4 * cq + 2] = __builtin_amdgcn_sdot4((int)o2, (int)ap, acc[4 * cq + 2], false); acc[4 * cq + 3] = __builtin_amdgcn_sdot4((int)o3, (int)ap, acc[4 * cq + 3], false);
    }
}
template <int HF> __device__ __forceinline__ void g2_half(int (&acc)[16], const u32x4 (&w)[8], unsigned aw, bool inq0) {
    g2_set<0>(acc, w, bcast8<2 * HF>(aw, inq0)); g2_set<4>(acc, w, bcast8<2 * HF + 1>(aw, inq0));
}
__device__ __forceinline__ void g2_store(int (&acc)[16], int lane, float sa, bf16* fp) {
    int v8[8], v4[4];
#pragma unroll
    for (int i = 0; i < 8; ++i) { const auto r = __builtin_amdgcn_permlane32_swap((unsigned)acc[i], (unsigned)acc[i + 8], false, false); v8[i] = (int)r[0] + (int)r[1]; }
#pragma unroll
    for (int i = 0; i < 4; ++i) { const auto r = __builtin_amdgcn_permlane16_swap((unsigned)v8[i], (unsigned)v8[i + 4], false, false); v4[i] = (int)r[0] + (int)r[1]; }
    const bool up = (lane & 8) != 0;
    const int k0 = up ? v4[2] : v4[0], k1 = up ? v4[3] : v4[1], s0 = up ? v4[0] : v4[2], s1 = up ? v4[1] : v4[3];
    const int f0 = k0 + dppi<0x128>(s0), f1 = k1 + dppi<0x128>(s1);
    const int feat = ((lane >> 5) & 1) * 8 + ((lane >> 4) & 1) * 4 + ((lane >> 3) & 1) * 2;
    *(unsigned*)(fp + feat) = cvtpk((float)f0 * sa, (float)f1 * sa);
}
__device__ __forceinline__ void ph_g2(const Ctx& c, unsigned* bar, const unsigned char* Wu, const unsigned* eidx, const unsigned char* aq, const float* sa, bf16* ffn) {
    const int lane = c.lane, g = lane >> 3, m = lane & 7; const bool inq0 = m < 4; const SliceMap sm = slice_map(c, bar);
    const int j = sm.j, ns = sm.nsw, t0 = sm.sw;
    const unsigned char* wsl = Wu + (size_t)j * (16384 * 128); const unsigned moff = 16u * m, loff = 4u * lane, aoff = 16u * g + 4u * (m & 3), foff = 32u * m;
    bf16* fs = ffn + 128 * j;
#define ALD(t) (*(const unsigned*)(aq + (size_t)(t) * 128 + aoff))
#define FST(t, acc) g2_store(acc, lane, sa[t], (bf16*)((unsigned char*)(fs + (size_t)(t) * D_) + foff))
    u32x4 W0[8], W1[8], W2[8], W3[8]; unsigned n1A = 0, n1B = 0, n2A = 0, n2B = 0, apA = 0, apB = 0, anA = 0, anB = 0;
    if (TOK(0) < T_) { n2A = IDX(TOK(0)); apA = ALD(TOK(0)); }
    if (TOK(1) < T_) { n2B = IDX(TOK(1)); apB = ALD(TOK(1)); }
    if (TOK(0) < T_) { gather8<0>(W0, wsl, moff, n2A, inq0); gather8<1>(W1, wsl, moff, n2A, inq0); }
    if (TOK(1) < T_) { gather8<0>(W2, wsl, moff, n2B, inq0); gather8<1>(W3, wsl, moff, n2B, inq0); }
    if (TOK(2) < T_) n1A = IDX(TOK(2));
    if (TOK(3) < T_) n1B = IDX(TOK(3));
    const int NT = (T_ - t0 + ns - 1) / ns;
    int i = 0;
    for (; i + 5 < NT; i += 2) {
        const int tA = TOK(i), tB = TOK(i + 1), tA1 = TOK(i + 2), tB1 = TOK(i + 3), tA2 = TOK(i + 4), tB2 = TOK(i + 5);
        n2A = IDX(tA2); n2B = IDX(tB2); anA = ALD(tA1); anB = ALD(tB1);
        { int acc[16];
#pragma unroll
          for (int r = 0; r < 16; ++r) acc[r] = 0;
          g2_half<0>(acc, W0, apA, inq0); gather8<0>(W0, wsl, moff, n1A, inq0);
          g2_half<1>(acc, W1, apA, inq0); gather8<1>(W1, wsl, moff, n1A, inq0);
          FST(tA, acc); }
        { int acc[16];
#pragma unroll
          for (int r = 0; r < 16; ++r) acc[r] = 0;
          g2_half<0>(acc, W2, apB, inq0); gather8<0>(W2, wsl, moff, n1B, inq0);
          g2_half<1>(acc, W3, apB, inq0); gather8<1>(W3, wsl, moff, n1B, inq0);
          FST(tB, acc); }
        n1A = n2A; n1B = n2B; apA = anA; apB = anB;
    }
    for (; i < NT; i += 2) {
        const int tA = TOK(i), tB = TOK(i + 1), tA1 = TOK(i + 2), tB1 = TOK(i + 3), tA2 = TOK(i + 4), tB2 = TOK(i + 5);
        if (tA2 < T_) n2A = IDX(tA2);
        if (tB2 < T_) n2B = IDX(tB2);
        if (tA1 < T_) anA = ALD(tA1);
        if (tB1 < T_) anB = ALD(tB1);
        { int acc[16];
#pragma unroll
          for (int r = 0; r < 16; ++r) acc[r] = 0;
          g2_half<0>(acc, W0, apA, inq0); if (tA1 < T_) gather8<0>(W0, wsl, moff, n1A, inq0);
          g2_half<1>(acc, W1, apA, inq0); if (tA1 < T_) gather8<1>(W1, wsl, moff, n1A, inq0);
          FST(tA, acc); }
        if (tB < T_) { int acc[16];
#pragma unroll
          for (int r = 0; r < 16; ++r) acc[r] = 0;
          g2_half<0>(acc, W2, apB, inq0); if (tB1 < T_) gather8<0>(W2, wsl, moff, n1B, inq0);
          g2_half<1>(acc, W3, apB, inq0); if (tB1 < T_) gather8<1>(W3, wsl, moff, n1B, inq0);
          FST(tB, acc); }
        n1A = n2A; n1B = n2B; apA = anA; apB = anB;
    }
#undef ALD
#undef FST
}
#undef IDX
#undef TOK
__device__ __forceinline__ void ph_ln2(const Ctx& c, const bf16* hb  , const float2* st1, const float* g1, const float* b1, const bf16* ffn, float* out, const float* g, const float* bb) {
    constexpr int RB = 4;
    for (int row0 = c.gw * RB; row0 < T_; row0 += c.NGW * RB) {
        uint2 hv[RB][4], fv[RB][4];
#pragma unroll
        for (int r = 0; r < RB; ++r) { const uint2* hp = (const uint2*)(hb + (size_t)(row0 + r) * D_) + c.lane; const uint2* fp = (const uint2*)(ffn + (size_t)(row0 + r) * D_) + c.lane;
#pragma unroll
            for (int j = 0; j < 4; ++j) { hv[r][j] = hp[64 * j]; fv[r][j] = fp[64 * j]; } }
        float4 g1v[4], b1v[4];
#pragma unroll
        for (int j = 0; j < 4; ++j) { const int cc = (64 * j + c.lane) * 4; g1v[j] = *(const float4*)(g1 + cc); b1v[j] = *(const float4*)(b1 + cc);
            g1v[j].x *= ALPHA; g1v[j].y *= ALPHA; g1v[j].z *= ALPHA; g1v[j].w *= ALPHA; b1v[j].x *= ALPHA; b1v[j].y *= ALPHA; b1v[j].z *= ALPHA; b1v[j].w *= ALPHA; }
#pragma unroll
        for (int r = 0; r < RB; ++r) {
            float4 v[4]; float s = 0.f; const float2 ms = st1[row0 + r];
#pragma unroll
            for (int j = 0; j < 4; ++j) { const uint2 h = hv[r][j], f = fv[r][j];
                v[j].x = (__uint_as_float(h.x << 16) - ms.x) * ms.y * g1v[j].x + b1v[j].x + __uint_as_float(f.x << 16); v[j].y = (__uint_as_float(h.x & 0xffff0000u) - ms.x) * ms.y * g1v[j].y + b1v[j].y + __uint_as_float(f.x & 0xffff0000u);
                v[j].z = (__uint_as_float(h.y << 16) - ms.x) * ms.y * g1v[j].z + b1v[j].z + __uint_as_float(f.y << 16); v[j].w = (__uint_as_float(h.y & 0xffff0000u) - ms.x) * ms.y * g1v[j].w + b1v[j].w + __uint_as_float(f.y & 0xffff0000u);
                s += v[j].x + v[j].y + v[j].z + v[j].w; }
            const float mu = wave_sum(s) * (1.f / D_); float q = 0.f;
#pragma unroll
            for (int j = 0; j < 4; ++j) { v[j].x -= mu; v[j].y -= mu; v[j].z -= mu; v[j].w -= mu; q += v[j].x * v[j].x + v[j].y * v[j].y + v[j].z * v[j].z + v[j].w * v[j].w; }
            const float rstd = 1.f / sqrtf(wave_sum(q) * (1.f / D_) + LN_EPS);
            float4* op = (float4*)(out + (size_t)(row0 + r) * D_) + c.lane;
#pragma unroll
            for (int j = 0; j < 4; ++j) { const int cc = (64 * j + c.lane) * 4; const float4 gg = *(const float4*)(g + cc), b4 = *(const float4*)(bb + cc);
                float4 o; o.x = v[j].x * rstd * gg.x + b4.x; o.y = v[j].y * rstd * gg.y + b4.y; o.z = v[j].z * rstd * gg.z + b4.z; o.w = v[j].w * rstd * gg.w + b4.w;
                __builtin_nontemporal_store(o.x, &op[64 * j].x); __builtin_nontemporal_store(o.y, &op[64 * j].y); __builtin_nontemporal_store(o.z, &op[64 * j].z); __builtin_nontemporal_store(o.w, &op[64 * j].w); }
        }
    }
}
constexpr int NPH = 12;
__global__ void __launch_bounds__(NTHREADS, 2) mega(Args a) {
    extern __shared__ __attribute__((aligned(16))) unsigned char lds[];
    Ctx c; c.tid = threadIdx.x; c.lane = c.tid & 63; c.wave = __builtin_amdgcn_readfirstlane(c.tid >> 6); c.G = gridDim.x; c.gw = blockIdx.x * NWAVES + c.wave; c.NGW = c.G * NWAVES; c.lds = lds; c.ldsl = (LAS unsigned char*)lds;
    { const int bx = blockIdx.x; const int vcu = (c.G % 8 == 0) ? (bx % 8) * (c.G / 8) + bx / 8 : bx; c.gwx = vcu * NWAVES + c.wave; }
    unsigned char* ws = a.ws;
#define WoutT ((bf16*)(ws + WS_WOUT))
#define ipre ((float*)(ws + WS_GATE))
#define logf ((float*)(ws + WS_GATE) + (size_t)T_ * 4)
#define proj ((bf16*)(ws + WS_PROJ))
#define qry ((bf16*)(ws + WS_QRY))
#define mq ((bf16*)(ws + WS_MQ))
#define mk ((bf16*)(ws + WS_MK))
#define concat ((bf16*)(ws + WS_CONCAT))
#define xb ((bf16*)(ws + WS_XB))
    const int lo = a.ph_lo, hi = a.ph_hi;
#define IN(k) (lo <= (k) && (k) < hi)
    if (c.tid < 8) ((LAS unsigned*)(c.ldsl + MISC_OFF))[c.tid] = 0u;
    __syncthreads();
    XcdBarrier xbar; xbar.bar = (unsigned*)(ws + WS_BAR); xbar.x = xb_xcc_id(); xbar.st = (volatile LAS unsigned*)(c.ldsl + MISC_OFF);
    if (c.tid == 0) { const unsigned rank = xb_add(&xbar.bar[XB_XCNT(xbar.x)], 1u); xbar.st[2] = xbar.x; xbar.st[3] = rank; }
#define SEAM(k) do { if (IN(k) && IN((k) + 1)) xcd_barrier(xbar); } while (0)
#ifndef REP_PHASE
#define REP_PHASE -1
#endif
#define PH(id, ...) do { __VA_ARGS__; if (REP_PHASE == (id)) { xcd_barrier(xbar); __VA_ARGS__; } } while (0)
    if (IN(0)) { PH(0, { ph_prologue(c, a); }); } SEAM(0);
    if (IN(1)) { PH(1, { pg8::Gemm g{(const pg8::bf16_t*)(ws + WS_XB), (const pg8::bf16_t*)(ws + WS_WIN), T_, NPROJ, D_ / 2}; pg8::StaticOrder S; S.init(T_, NPROJ, c.G, (int)blockIdx.x);
        pg8::EpiI8Bf16 E{proj, NPROJ, (const float*)(ws + WS_SXA), (const float*)(ws + WS_SWN)};
        pg8::gemm_phase<pg8::EpiI8Bf16, pg8::StaticOrder, true, true>((PG8_LAS unsigned char*)lds, g, S, E); }); } SEAM(1);
    if (IN(2)) { PH(20, { ph_m1(c, a, proj, ipre, logf, mq, mk, (unsigned char*)a.out); __syncthreads(); }); PH(21, { ph_attn(c, proj, ws, (unsigned char*)a.out); }); } SEAM(2);
    if (IN(3)) { PH(30, { ph_attn_merge(c, ws, (const unsigned char*)a.out, concat); }); PH(31, { ph_m3(c, a, proj, ipre, logf, mq, mk, (const unsigned char*)a.out, concat); }); } SEAM(3);
    if (IN(4)) { PH(4, { pg8::Gemm g{concat, WoutT, T_, D_, D_}; pg8::StaticOrder S; S.init(T_, D_, c.G, (int)blockIdx.x);
        pg8::EpiResBf16 E{a.in[0], (bf16*)(ws + WS_Y1), ALPHA};
        pg8::gemm_phase<pg8::EpiResBf16, pg8::StaticOrder, true, true>((PG8_LAS unsigned char*)lds, g, S, E); }); } SEAM(4);
    if (IN(5)) { PH(5, { ph_ln1(c, (const bf16*)(ws + WS_Y1), a.in[10], a.in[11], (float2*)(ws + WS_ST1), (unsigned*)(ws + WS_XQ), (float*)(ws + WS_SX)); }); } SEAM(5);
    if (IN(6)) { PH(6, { pg8::Gemm g{(const pg8::bf16_t*)(ws + WS_XQ), (const pg8::bf16_t*)(ws + WS_WQ), T_, 2048, D_ / 2}; pg8::StaticOrder S; S.init(T_, 2048, c.G, (int)blockIdx.x);
        pg8::EpiI8Bf16 E{qry, 2048, (const float*)(ws + WS_SX), (const float*)(ws + WS_SWQ)};
        pg8::gemm_phase<pg8::EpiI8Bf16, pg8::StaticOrder, true, true>((PG8_LAS unsigned char*)lds, g, S, E);
        asm volatile("s_waitcnt vmcnt(0)" ::: "memory"); __syncthreads();
        ph_route(c, qry, (const bf16*)(ws + WS_SK), (unsigned*)(ws + WS_EIDX), (float*)(ws + WS_GATEV)); }); } SEAM(6);
    if (IN(8)) { PH(8, { ph_g1(c, xbar.bar, (const unsigned char*)(ws + WS_XQ), (const float*)(ws + WS_SX), (const unsigned char*)(ws + WS_WD), (const unsigned*)(ws + WS_EIDX), (bf16*)(ws + WS_APART)); }); } SEAM(8);
    if (IN(9)) { PH(9, { ph_afin(c, (const bf16*)(ws + WS_APART), (const float*)(ws + WS_GATEV), (const unsigned*)(ws + WS_EIDX), (const float*)(ws + WS_SCD), (const float*)(ws + WS_SCU), (unsigned char*)(ws + WS_AFIN), (float*)(ws + WS_SA)); }); } SEAM(9);
    if (IN(10)) { PH(10, { ph_g2(c, xbar.bar, (const unsigned char*)(ws + WS_WU), (const unsigned*)(ws + WS_EIDX), (const unsigned char*)(ws + WS_AFIN), (const float*)(ws + WS_SA), (bf16*)(ws + WS_FFN)); }); } SEAM(10);
    if (IN(11)) { PH(11, { ph_ln2(c, (const bf16*)(ws + WS_Y1), (const float2*)(ws + WS_ST1), a.in[10], a.in[11], (const bf16*)(ws + WS_FFN), a.out, a.in[16], a.in[17]); }); }
#undef PH
#undef WoutT
#undef ipre
#undef logf
#undef proj
#undef qry
#undef mq
#undef mk
#undef concat
#undef xb
#undef IN
#undef SEAM
}

#ifndef MK_PER_PHASE
#define MK_PER_PHASE 0
#endif
extern "C" void kernel_launch(void* const* d_in, const int* in_sizes, int n_in, void* d_out, int out_size, void* d_ws, size_t ws_size, hipStream_t stream) {
    static int grid = 0;
    if (grid == 0) {
        if (n_in != 18 || out_size != T_ * D_ || ws_size < WS_END) { fprintf(stderr, "kernel_launch: unexpected sizes n_in %d out %d ws %zu\n", n_in, out_size, ws_size); grid = -1; return; }
        int dev = 0, cus = 0, per_cu = 0;
        if (hipGetDevice(&dev) != hipSuccess || hipDeviceGetAttribute(&cus, hipDeviceAttributeMultiprocessorCount, dev) != hipSuccess) { fprintf(stderr, "kernel_launch: device query failed\n"); grid = -1; return; }
        if (hipFuncSetAttribute((const void*)mega, hipFuncAttributeMaxDynamicSharedMemorySize, LDS_BYTES) != hipSuccess) { fprintf(stderr, "kernel_launch: hipFuncSetAttribute failed\n"); grid = -1; return; }
        if (hipOccupancyMaxActiveBlocksPerMultiprocessor(&per_cu, (const void*)mega, NTHREADS, LDS_BYTES) != hipSuccess || per_cu < 1) { fprintf(stderr, "kernel_launch: occupancy query failed (%d)\n", per_cu); (void)hipGetLastError(); grid = -1; return; }
        grid = cus * per_cu;
        fprintf(stderr, "kernel_launch: %d CUs x %d workgroups = grid %d\n", cus, per_cu, grid);
    }
    if (grid < 0) return;
    if (hipMemsetAsync((char*)d_ws + WS_BAR, 0, 49152, stream) != hipSuccess) { fprintf(stderr, "kernel_launch: memset of the barrier words failed\n"); return; }
    Args a{};
    for (int i = 0; i < 18; ++i) a.in[i] = (const float*)d_in[i];
    a.out = (float*)d_out; a.ws = (unsigned char*)d_ws;
#if MK_PER_PHASE
    for (int p = 0; p < NPH; ++p) { a.ph_lo = p; a.ph_hi = p + 1; hipLaunchKernelGGL(mega, dim3(grid), dim3(NTHREADS), LDS_BYTES, stream, a); }
#else
    a.ph_lo = 0; a.ph_hi = NPH;
    void* params[] = {&a};
    const hipError_t e = hipLaunchCooperativeKernel((const void*)mega, dim3(grid), dim3(NTHREADS), params, LDS_BYTES, stream);
    if (e != hipSuccess) fprintf(stderr, "kernel_launch: cooperative launch failed: %s (grid %d)\n", hipGetErrorString(e), grid);
#endif
}
```

```cpp
#include <hip/hip_runtime.h>
#include <cstdio>
#include <cstdint>
#include <cmath>
namespace pg8 {
#define PG8_LAS __attribute__((address_space(3)))
typedef unsigned short bf16_t;
typedef short bf16x8 __attribute__((ext_vector_type(8)));
typedef float f32x4 __attribute__((ext_vector_type(4)));
typedef unsigned u32x4 __attribute__((ext_vector_type(4)));
typedef int i32x4 __attribute__((ext_vector_type(4)));
constexpr int BM = 256, BK = 64, HALF = 128, HTB = HALF * BK * 2  , STAGE_BYTES = 8 * HTB, NXCD = 8, WGM = 8;

__host__ __device__ __forceinline__ int lds_byte(int r, int c) { const int st = (r >> 4) * 2 + (c >> 5), rr = r & 15, cc = c & 31, ob = rr * 64 + cc * 2; return st * 1024 + (ob ^ (((ob >> 9) & 1) << 5)); }
__host__ __device__ __forceinline__ void stage_rc(int b, int& R, int& C) { const int st = b / 1024, sb = b % 1024, swz = sb ^ (((sb >> 9) & 1) << 5); R = (st >> 1) * 16 + swz / 64; C = (st & 1) * 32 + (swz % 64) / 2; }
__host__ __device__ __forceinline__ int perm32(int rho) { const int n = rho >> 4, i = rho & 15; return 8 * (i >> 2) + 4 * n + (i & 3); }

struct Unit { int pm, pn; };
struct Gemm { const bf16_t* A; const bf16_t* Bt; int M, N, K; };

struct StaticOrder {
    int nM, nN, nwg, G, c;
    __host__ __device__ void init(int M, int N, int G_, int c_) { nM = M / BM; nN = N / BM; nwg = nM * nN; G = G_; c = c_; }
    __host__ __device__ bool next(int i, Unit& u) const {
        const long L = (long)i * G + c; if (L >= nwg) return false;
        int wgid = (int)L; { const int q = nwg / NXCD, r = nwg % NXCD, xcd = wgid % NXCD, off = wgid / NXCD; wgid = (xcd < r ? xcd * (q + 1) : r * (q + 1) + (xcd - r) * q) + off; }
        const int nig = WGM * nN, gid = wgid / nig, fm = gid * WGM, gsz = (nM - fm) < WGM ? (nM - fm) : WGM;
        u.pm = fm + ((wgid % nig) % gsz); u.pn = (wgid % nig) / gsz; return true;
    }
    __device__ __forceinline__ void a_ready(const Unit&) const {}
    __device__ __forceinline__ void done(const Unit&) const {}
};

__device__ __forceinline__ unsigned cvt_pk_bf16(float lo, float hi) { unsigned r; asm volatile("v_cvt_pk_bf16_f32 %0, %1, %2" : "=v"(r) : "v"(lo), "v"(hi)); return r; }
typedef float f32x2 __attribute__((ext_vector_type(2)));
__device__ __forceinline__ f32x2 gelu_pk(f32x2 v) {
    const f32x2 av = __builtin_elementwise_abs(v), d = av * 0.2316418882f + 1.0f;
    f32x2 t; t.x = __builtin_amdgcn_rcpf(d.x); t.y = __builtin_amdgcn_rcpf(d.y);
    f32x2 q = t * 0.5307027145f + (-0.7265760135f); q = q * t + 0.7107068705f; q = q * t + (-0.142248368f); q = q * t + 0.127414796f; q = q * t;
    const f32x2 s = (v * v) * (-0.72134752044f);
    f32x2 e; e.x = __builtin_amdgcn_exp2f(s.x); e.y = __builtin_amdgcn_exp2f(s.y);
    const f32x2 m = v * (q * e), r = v - m;
    f32x2 o; o.x = v.x < 0.f ? m.x : r.x; o.y = v.y < 0.f ? m.y : r.y; return o;
}

template <int ACT  > struct EpiBf16 {
    static constexpr bool PERM = true, AFTER_DRAIN = false, I8 = false; static_assert(ACT == 0 || ACT == 1, "EpiBf16: ACT is 0 (none) or 1 (gelu_pk)");
    bf16_t* O; int ldc; const float* bias; int split_cols; size_t split_stride; float scale0;
    __device__ __forceinline__ void operator()(const f32x4 (&acc)[2][2][4][2], const Unit& u, int wr, int wc, int fr, int fq) const {
        const int row0 = u.pm * BM + wr * 64 + fr; int colt = u.pn * BM; bf16_t* base = O;
        float sc = 1.f; if (split_cols) { const int t = colt / split_cols; base += (size_t)t * split_stride; colt -= t * split_cols; if (t == 0) sc = scale0; }
        const int col0 = colt + wc * 32 + 8 * fq, bcol0 = u.pn * BM + wc * 32 + 8 * fq;
        f32x4 bv[2][2];
#pragma unroll
        for (int bj = 0; bj < 2; ++bj)
#pragma unroll
            for (int n = 0; n < 2; ++n) bv[bj][n] = bias ? *(const f32x4*)(bias + bcol0 + bj * HALF + 4 * n) : (f32x4){0.f, 0.f, 0.f, 0.f};
#pragma unroll
        for (int ai = 0; ai < 2; ++ai)
#pragma unroll
            for (int m = 0; m < 4; ++m) { bf16_t* rowp = base + (size_t)(row0 + ai * HALF + m * 16) * ldc + col0;
#pragma unroll
                for (int bj = 0; bj < 2; ++bj) { f32x4 v0 = acc[ai][bj][m][0] + bv[bj][0], v1 = acc[ai][bj][m][1] + bv[bj][1];
                    if (ACT == 1) { f32x2 a = gelu_pk((f32x2){v0[0], v0[1]}), b = gelu_pk((f32x2){v0[2], v0[3]}), c = gelu_pk((f32x2){v1[0], v1[1]}), d = gelu_pk((f32x2){v1[2], v1[3]});
                        v0 = (f32x4){a.x, a.y, b.x, b.y}; v1 = (f32x4){c.x, c.y, d.x, d.y}; }
                    v0 = v0 * sc; v1 = v1 * sc; u32x4 w; w.x = cvt_pk_bf16(v0[0], v0[1]); w.y = cvt_pk_bf16(v0[2], v0[3]); w.z = cvt_pk_bf16(v1[0], v1[1]); w.w = cvt_pk_bf16(v1[2], v1[3]);
                    *(u32x4*)(rowp + bj * HALF) = w; } }
    }
};
struct EpiResBf16 {
    static constexpr bool PERM = true, AFTER_DRAIN = false, I8 = false;
    const float* xres; bf16_t* out; float alpha;
    __device__ __forceinline__ void operator()(const f32x4 (&acc)[2][2][4][2], const Unit& u, int wr, int wc, int fr, int fq) const {
        const int col0 = u.pn * BM + wc * 32 + 8 * fq;
#pragma unroll
        for (int ai = 0; ai < 2; ++ai)
#pragma unroll
            for (int m = 0; m < 4; ++m) { const size_t off = (size_t)(u.pm * BM + ai * HALF + wr * 64 + m * 16 + fr) * 1024 + col0;
#pragma unroll
                for (int bj = 0; bj < 2; ++bj) { const f32x4 x0 = *(const f32x4*)(xres + off + bj * HALF), x1 = *(const f32x4*)(xres + off + bj * HALF + 4);
                    const f32x4 v0 = x0 * alpha + acc[ai][bj][m][0], v1 = x1 * alpha + acc[ai][bj][m][1];
                    u32x4 w; w.x = cvt_pk_bf16(v0[0], v0[1]); w.y = cvt_pk_bf16(v0[2], v0[3]); w.z = cvt_pk_bf16(v1[0], v1[1]); w.w = cvt_pk_bf16(v1[2], v1[3]);
                    *(u32x4*)(out + off + bj * HALF) = w; } }
    }
};
struct EpiI8Bf16 {
    static constexpr bool PERM = true, AFTER_DRAIN = false, I8 = true;
    bf16_t* O; int ldc; const float* sa; const float* sb;
    __device__ __forceinline__ void operator()(const i32x4 (&acc)[2][2][4][2], const Unit& u, int wr, int wc, int fr, int fq) const {
        const int row0 = u.pm * BM + wr * 64 + fr, col0 = u.pn * BM + wc * 32 + 8 * fq;
        f32x4 sbv[2][2];
#pragma unroll
        for (int bj = 0; bj < 2; ++bj)
#pragma unroll
            for (int n = 0; n < 2; ++n) sbv[bj][n] = *(const f32x4*)(sb + col0 + bj * HALF + 4 * n);
#pragma unroll
        for (int ai = 0; ai < 2; ++ai)
#pragma unroll
            for (int m = 0; m < 4; ++m) { const int r = row0 + ai * HALF + m * 16; const float sr = sa[r]; bf16_t* rowp = O + (size_t)r * ldc + col0;
#pragma unroll
                for (int bj = 0; bj < 2; ++bj) { const i32x4 a0 = acc[ai][bj][m][0], a1 = acc[ai][bj][m][1];
                    const f32x4 v0 = (f32x4){(float)a0[0], (float)a0[1], (float)a0[2], (float)a0[3]} * sbv[bj][0] * sr, v1 = (f32x4){(float)a1[0], (float)a1[1], (float)a1[2], (float)a1[3]} * sbv[bj][1] * sr;
                    u32x4 w; w.x = cvt_pk_bf16(v0[0], v0[1]); w.y = cvt_pk_bf16(v0[2], v0[3]); w.z = cvt_pk_bf16(v1[0], v1[1]); w.w = cvt_pk_bf16(v1[2], v1[3]);
                    *(u32x4*)(rowp + bj * HALF) = w; } }
    }
};
__device__ __forceinline__ f32x4 mma16(bf16x8 a, bf16x8 b, f32x4 c) { return __builtin_amdgcn_mfma_f32_16x16x32_bf16(a, b, c, 0, 0, 0); }
__device__ __forceinline__ i32x4 mma16(bf16x8 a, bf16x8 b, i32x4 c) { return __builtin_amdgcn_mfma_i32_16x16x64_i8(__builtin_bit_cast(i32x4, a), __builtin_bit_cast(i32x4, b), c, 0, 0, 0); }
template <bool I8> struct AccT { typedef f32x4 type; };
template <> struct AccT<true> { typedef i32x4 type; };
template <class Epi, class Sched, bool ALIGN_EPI = false, bool SP2 = false>
__device__ __forceinline__ void gemm_phase(PG8_LAS unsigned char* lds, const Gemm g, const Sched& S, const Epi& E) {
    const int tid = threadIdx.x, wid = __builtin_amdgcn_readfirstlane(tid >> 6), lane = tid & 63, wr = wid >> 2, wc = wid & 3, fr = lane & 15, fq = lane >> 4;
    const int K = g.K, nt = K / BK;
    unsigned voffA[2], voffB[2];
#pragma unroll
    for (int i = 0; i < 2; ++i) { int R, C; stage_rc(tid * 16 + i * 8192, R, C); const int Rb = Epi::PERM ? ((R & ~31) + perm32(R & 31)) : R;
        voffA[i] = (unsigned)(R * K + C) * 2u; voffB[i] = (unsigned)(Rb * K + C) * 2u; }
    const size_t kstep = (size_t)(BK * 2);
    const size_t hstep = (size_t)HALF * K * 2;
    const size_t tstep = 2 * hstep;
    const unsigned ldsw = (unsigned)wid * 1024u;
    const int aoff = lds_byte(wr * 64 + fr, fq * 8), boff = lds_byte(wc * 32 + fr, fq * 8);
#define PG8_SA(b, h) (((b) * 2 + (h)) * HTB)
#define PG8_SB(b, h) ((4 + (b) * 2 + (h)) * HTB)
#define PG8_STAGE(bufoff, gbase, voff) do { _Pragma("unroll") for (int _i = 0; _i < 2; ++_i) \
        __builtin_amdgcn_global_load_lds((const unsigned*)((const char*)(gbase) + (voff)[_i]), (PG8_LAS unsigned*)(lds + (bufoff) + ldsw + _i * 8192), 16, 0, 0); } while (0)
#define PG8_LDA(dst, b, h) do { _Pragma("unroll") for (int m = 0; m < 4; ++m) _Pragma("unroll") for (int k = 0; k < 2; ++k) dst[m][k] = *(const PG8_LAS bf16x8*)(lds + PG8_SA(b, h) + aoff + m * 2048 + k * 1024); } while (0)
#define PG8_LDB(dst, b, h) do { _Pragma("unroll") for (int n = 0; n < 2; ++n) _Pragma("unroll") for (int k = 0; k < 2; ++k) dst[n][k] = *(const PG8_LAS bf16x8*)(lds + PG8_SB(b, h) + boff + n * 2048 + k * 1024); } while (0)
#define PG8_MMA(ai, bj, At, Bt) do { __builtin_amdgcn_s_setprio(1); _Pragma("unroll") for (int m = 0; m < 4; ++m) _Pragma("unroll") for (int n = 0; n < 2; ++n) _Pragma("unroll") for (int k = 0; k < 2; ++k) \
        acc[ai][bj][m][n] = mma16(Bt[n][k], At[m][k], acc[ai][bj][m][n]); __builtin_amdgcn_s_setprio(0); } while (0)
#define PG8_WAIT_V(n) asm volatile("s_waitcnt vmcnt(" #n ")" ::: "memory")
#define PG8_WAIT_L(n) asm volatile("s_waitcnt lgkmcnt(" #n ")" ::: "memory")
#define PG8_BAR __builtin_amdgcn_s_barrier()
#define PG8_SCHED __builtin_amdgcn_sched_barrier(0)
    Unit cur, nxt; int ui = 0;
    if (!S.next(0, cur)) return;
    typedef typename AccT<Epi::I8>::type acc_t; const acc_t acc_zero = {0, 0, 0, 0};
    acc_t acc[2][2][4][2];
#pragma unroll
    for (int a = 0; a < 2; ++a)
#pragma unroll
        for (int b = 0; b < 2; ++b)
#pragma unroll
            for (int m = 0; m < 4; ++m)
#pragma unroll
                for (int n = 0; n < 2; ++n) acc[a][b][m][n] = acc_zero;
    bf16x8 At[4][2], B0[2][2], B1[2][2];
    const char* cA = (const char*)g.A + (size_t)cur.pm * tstep; const char* cB = (const char*)g.Bt + (size_t)cur.pn * tstep;
    S.a_ready(cur);
    if constexpr (SP2) {
        PG8_STAGE(PG8_SB(0, 0), cB, voffB); PG8_STAGE(PG8_SB(0, 1), cB + hstep, voffB); PG8_STAGE(PG8_SA(0, 0), cA, voffA); PG8_STAGE(PG8_SA(0, 1), cA + hstep, voffA);
        if (wr == 1) PG8_BAR;
        PG8_WAIT_V(2); PG8_BAR;
        PG8_STAGE(PG8_SB(1, 0), cB + kstep, voffB); PG8_STAGE(PG8_SA(1, 0), cA + kstep, voffA); PG8_STAGE(PG8_SB(1, 1), cB + hstep + kstep, voffB);
        PG8_WAIT_V(6); PG8_BAR;
    } else {
        PG8_STAGE(PG8_SB(0, 0), cB, voffB); PG8_STAGE(PG8_SA(0, 0), cA, voffA); PG8_STAGE(PG8_SB(0, 1), cB + hstep, voffB); PG8_STAGE(PG8_SA(0, 1), cA + hstep, voffA);
        if (wr == 1) PG8_BAR;
        PG8_WAIT_V(4); PG8_BAR;
        PG8_STAGE(PG8_SB(1, 0), cB + kstep, voffB); PG8_STAGE(PG8_SA(1, 0), cA + kstep, voffA); PG8_STAGE(PG8_SB(1, 1), cB + hstep + kstep, voffB);
        PG8_WAIT_V(6); PG8_BAR;
    }
    for (;;) {
        const bool has_next = S.next(ui + 1, nxt);
        const char* nA = has_next ? (const char*)g.A + (size_t)nxt.pm * tstep : cA; const char* nB = has_next ? (const char*)g.Bt + (size_t)nxt.pn * tstep : cB;
        for (int t = 0; t < nt; t += 2) {
            const bool last = (t == nt - 2);
            const char* a1 = cA + (size_t)(t + 1) * kstep;
            const char* a2 = last ? nA : cA + (size_t)(t + 2) * kstep; const char* b2 = last ? nB : cB + (size_t)(t + 2) * kstep;
            const char* a3 = a2 + kstep; const char* b3 = b2 + kstep;
            if (last && has_next) S.a_ready(nxt);
            if constexpr (SP2) {
            PG8_LDB(B0, 0, 0); PG8_LDB(B1, 0, 1); PG8_SCHED; PG8_LDA(At, 0, 0); PG8_STAGE(PG8_SA(1, 1), a1 + hstep, voffA);
            PG8_WAIT_V(8); PG8_WAIT_L(0); PG8_BAR; PG8_MMA(0, 0, At, B0); PG8_MMA(0, 1, At, B1); PG8_BAR; PG8_SCHED;
            PG8_LDA(At, 0, 1); PG8_STAGE(PG8_SB(0, 0), b2, voffB); PG8_STAGE(PG8_SB(0, 1), b2 + hstep, voffB); PG8_STAGE(PG8_SA(0, 0), a2, voffA);
            PG8_WAIT_V(8); PG8_WAIT_L(0); PG8_BAR; PG8_MMA(1, 0, At, B0); PG8_MMA(1, 1, At, B1); PG8_BAR; PG8_SCHED;
            PG8_LDB(B0, 1, 0); PG8_LDB(B1, 1, 1); PG8_SCHED; PG8_LDA(At, 1, 0); PG8_STAGE(PG8_SA(0, 1), a2 + hstep, voffA);
            PG8_WAIT_V(8); PG8_WAIT_L(0); PG8_BAR; PG8_MMA(0, 0, At, B0); PG8_MMA(0, 1, At, B1); PG8_BAR; PG8_SCHED;
            PG8_LDA(At, 1, 1); PG8_STAGE(PG8_SB(1, 0), b3, voffB); PG8_STAGE(PG8_SB(1, 1), b3 + hstep, voffB); PG8_STAGE(PG8_SA(1, 0), a3, voffA);
            PG8_WAIT_V(8); PG8_WAIT_L(0); PG8_BAR; PG8_MMA(1, 0, At, B0); PG8_MMA(1, 1, At, B1); PG8_BAR; PG8_SCHED;
            } else {
            PG8_LDB(B0, 0, 0); PG8_SCHED; PG8_LDA(At, 0, 0); PG8_STAGE(PG8_SA(1, 1), a1 + hstep, voffA);
            PG8_WAIT_L(8); PG8_BAR; PG8_WAIT_L(0); PG8_MMA(0, 0, At, B0); PG8_BAR; PG8_SCHED;
            PG8_LDB(B1, 0, 1); PG8_STAGE(PG8_SB(0, 0), b2, voffB);
            PG8_BAR; PG8_WAIT_L(0); PG8_MMA(0, 1, At, B1); PG8_BAR;
            PG8_LDA(At, 0, 1); PG8_STAGE(PG8_SA(0, 0), a2, voffA);
            PG8_BAR; PG8_WAIT_L(0); PG8_MMA(1, 0, At, B0); PG8_BAR; PG8_SCHED;
            PG8_STAGE(PG8_SB(0, 1), b2 + hstep, voffB);
            PG8_WAIT_V(6); PG8_BAR; PG8_MMA(1, 1, At, B1); PG8_BAR;
            PG8_LDB(B0, 1, 0); PG8_SCHED; PG8_LDA(At, 1, 0); PG8_STAGE(PG8_SA(0, 1), a2 + hstep, voffA);
            PG8_WAIT_L(8); PG8_BAR; PG8_WAIT_L(0); PG8_MMA(0, 0, At, B0); PG8_BAR; PG8_SCHED;
            PG8_LDB(B1, 1, 1); PG8_STAGE(PG8_SB(1, 0), b3, voffB);
            PG8_BAR; PG8_WAIT_L(0); PG8_MMA(0, 1, At, B1); PG8_BAR;
            PG8_LDA(At, 1, 1); PG8_STAGE(PG8_SA(1, 0), a3, voffA);
            PG8_BAR; PG8_WAIT_L(0); PG8_MMA(1, 0, At, B0); PG8_BAR; PG8_SCHED;
            PG8_STAGE(PG8_SB(1, 1), b3 + hstep, voffB);
            PG8_WAIT_V(6); PG8_BAR; PG8_MMA(1, 1, At, B1); PG8_BAR;
            }
        }
        if constexpr (ALIGN_EPI) { if (wr == 0) PG8_BAR; }
        if constexpr (!Epi::AFTER_DRAIN) { E(acc, cur, wr, wc, fr, fq); S.done(cur); }
        if (!has_next) break;
#pragma unroll
        for (int a = 0; a < 2; ++a)
#pragma unroll
            for (int b = 0; b < 2; ++b)
#pragma unroll
                for (int m = 0; m < 4; ++m)
#pragma unroll
                    for (int n = 0; n < 2; ++n) acc[a][b][m][n] = acc_zero;
        cur = nxt; cA = nA; cB = nB; ++ui;
        if constexpr (ALIGN_EPI) { if (wr == 1) PG8_BAR; }
    }
    PG8_WAIT_V(0);
    if constexpr (!ALIGN_EPI) { if (wr == 0) PG8_BAR; }
    PG8_BAR;
    if constexpr (Epi::AFTER_DRAIN) { E.fused(acc, cur, wr, wc, fr, fq, lds, wid, lane); S.done(cur); }
#undef PG8_SA
#undef PG8_SB
#undef PG8_STAGE
#undef PG8_LDA
#undef PG8_LDB
#undef PG8_MMA
#undef PG8_WAIT_V
#undef PG8_WAIT_L
#undef PG8_BAR
#undef PG8_SCHED
}
}
typedef unsigned short bf16;
#define LAS __attribute__((address_space(3)))
constexpr int B_ = 16, S_ = 2048, D_ = 1024, T_ = B_ * S_;
constexpr int INC = 3080, NPROJ = 3072;
constexpr int C_QA = 0, C_KA = 512, C_VA = 1024, C_XM = 1536, C_VM = 2048, C_OM = 2560;
constexpr float ALPHA = 1.189207115002721f;
constexpr float LN_EPS = 1e-5f;
constexpr size_t MiB = 1u << 20;
constexpr int NWAVES = 8, NTHREADS = 512;
constexpr int LDS_BYTES = 163840;

constexpr size_t WS_WIN = 1 * MiB;
constexpr size_t WS_SWN = 768 * 1024, WS_SXA = 800 * 1024;
constexpr size_t WS_WOUT = 7 * MiB;
constexpr size_t WS_WQ = 9 * MiB;
constexpr size_t WS_SWQ = 780 * 1024;
constexpr size_t WS_GATE = 13 * MiB;
constexpr size_t WS_PROJ = 16 * MiB;
constexpr size_t WS_QRY = 16 * MiB;
constexpr size_t WS_Y1 = 336 * MiB;
constexpr size_t WS_ST1 = 305 * MiB;
constexpr size_t WS_MQ = 208 * MiB, WS_MK = 240 * MiB;
constexpr size_t WS_CONCAT = 272 * MiB;
constexpr size_t WS_XB = 336 * MiB;
constexpr size_t WS_SK = 15 * MiB + 512 * 1024;
constexpr size_t WS_EIDX = 144 * MiB, WS_GATEV = 160 * MiB;
constexpr size_t WS_AFIN = 176 * MiB;
constexpr size_t WS_SA = 192 * MiB;
constexpr size_t WS_FFN = 208 * MiB;
constexpr size_t WS_APART = 208 * MiB;
constexpr size_t WS_XQ = 272 * MiB, WS_SX = 304 * MiB;
constexpr size_t WS_WD = 400 * MiB, WS_WU = 432 * MiB;
constexpr size_t WS_SCD = 640 * 1024, WS_SCU = 704 * 1024;
constexpr size_t WS_PO01 = 336 * MiB;
constexpr size_t WS_WMT = 0;
constexpr size_t OUT_PO2 = 0, OUT_PML = 32 * MiB;
constexpr size_t WS_END = 464 * MiB;
typedef short bf16x8 __attribute__((ext_vector_type(8)));
typedef float f32x16 __attribute__((ext_vector_type(16)));

__device__ __forceinline__ float bf2f(bf16 v) { return __uint_as_float((unsigned)v << 16); }
__device__ __forceinline__ unsigned f2bf(float f) { unsigned u = __float_as_uint(f); return (u + 0x7fffu + ((u >> 16) & 1u)) >> 16; }
__device__ __forceinline__ unsigned pk2(float lo, float hi) { return f2bf(lo) | (f2bf(hi) << 16); }
#define WAVE_FENCE() asm volatile("s_waitcnt lgkmcnt(0)" ::: "memory")
template <int CTRL> __device__ __forceinline__ float dppf_(float v) { return __int_as_float(__builtin_amdgcn_mov_dpp(__float_as_int(v), CTRL, 0xF, 0xF, true)); }
__device__ __forceinline__ float wave_sum(float v) {
    v += dppf_<0xB1>(v); v += dppf_<0x4E>(v); v += dppf_<0x141>(v); v += dppf_<0x140>(v);
    { const auto r = __builtin_amdgcn_permlane16_swap(__float_as_uint(v), __float_as_uint(v), false, false); v = __uint_as_float(r[0]) + __uint_as_float(r[1]); }
    { const auto r = __builtin_amdgcn_permlane32_swap(__float_as_uint(v), __float_as_uint(v), false, false); v = __uint_as_float(r[0]) + __uint_as_float(r[1]); }
    return v;
}
__device__ __forceinline__ float wave_max(float v) {
    v = fmaxf(v, dppf_<0xB1>(v)); v = fmaxf(v, dppf_<0x4E>(v)); v = fmaxf(v, dppf_<0x141>(v)); v = fmaxf(v, dppf_<0x140>(v));
    { const auto r = __builtin_amdgcn_permlane16_swap(__float_as_uint(v), __float_as_uint(v), false, false); v = fmaxf(__uint_as_float(r[0]), __uint_as_float(r[1])); }
    { const auto r = __builtin_amdgcn_permlane32_swap(__float_as_uint(v), __float_as_uint(v), false, false); v = fmaxf(__uint_as_float(r[0]), __uint_as_float(r[1])); }
    return v;
}
#define RLX_AGENT __ATOMIC_RELAXED, __HIP_MEMORY_SCOPE_AGENT
#define XB_TMO      128
#define XB_XCNT(j)  (256  + 64 * (j))
#define XB_XSUB(j)  (1280 + 64 * (j))
#define XB_XGEN(j)  (2304 + 64 * (j))
#define XB_TOP      3328
#define XB_TOPGEN   3392
#define XCD_BAR_WORDS 3456
#define XB_SPIN_CAP (1u << 18)

__device__ __forceinline__ unsigned xb_ld(unsigned* p)              { return __hip_atomic_load(p, __ATOMIC_RELAXED, __HIP_MEMORY_SCOPE_AGENT); }
__device__ __forceinline__ unsigned xb_add(unsigned* p, unsigned v) { return __hip_atomic_fetch_add(p, v, __ATOMIC_RELAXED, __HIP_MEMORY_SCOPE_AGENT); }
__device__ __forceinline__ unsigned xb_xcc_id() { return (unsigned)__builtin_amdgcn_s_getreg((3 << 11) | 20) & 0xFu; }
#define XB_SPIN(cond, bar) do { unsigned _sp = 0; while (cond) { __builtin_amdgcn_s_sleep(1); \
    if ((++_sp & 255u) == 0u) { if (xb_ld(&(bar)[XB_TMO])) break; if (_sp > XB_SPIN_CAP) { atomicAdd(&(bar)[XB_TMO], 1u); break; } } } } while (0)

struct XcdBarrier {
    unsigned* bar; unsigned x;
    volatile LAS unsigned* st;
};

__device__ __forceinline__ XcdBarrier xcd_barrier_post(unsigned* bar, volatile LAS unsigned* st) {
    XcdBarrier b; b.bar = bar; b.x = xb_xcc_id(); b.st = st;
    if (threadIdx.x == 0) (void)xb_add(&bar[XB_XCNT(b.x)], 1u);
    return b;
}
__device__ __forceinline__ void xcd_barrier_complete(unsigned* bar, unsigned x, unsigned& nloc, unsigned& nx) {
    const unsigned G = gridDim.x * gridDim.y * gridDim.z;
    unsigned sum, cnt, mine, sp = 0u;
    for (;;) {
        sum = 0u; cnt = 0u; mine = 0u;
#pragma unroll
        for (unsigned j = 0; j < 16; ++j) { const unsigned c = xb_ld(&bar[XB_XCNT(j)]); sum += c; cnt += (c > 0u) ? 1u : 0u; mine = (j == x) ? c : mine; }
        if (sum == G) break;
        __builtin_amdgcn_s_sleep(1);
        if ((++sp & 255u) == 0u) { if (xb_ld(&bar[XB_TMO])) break; if (sp > XB_SPIN_CAP) { atomicAdd(&bar[XB_TMO], 1u); break; } }
    }
    nloc = mine > 0u ? mine : 1u; nx = cnt > 0u ? cnt : 1u;
}

__device__ __forceinline__ void xcd_barrier(const XcdBarrier& b) {
    asm volatile("s_waitcnt vmcnt(0)" ::: "memory");
    __syncthreads();
    if (threadIdx.x == 0) {
        unsigned* bar = b.bar;
        __builtin_amdgcn_s_waitcnt(0);
        unsigned nloc = b.st[0], nx = b.st[1];
        if (nloc == 0u) { xcd_barrier_complete(bar, b.x, nloc, nx); b.st[0] = nloc; b.st[1] = nx; }
        const unsigned old = xb_add(&bar[XB_XSUB(b.x)], 1u);
        const unsigned gen = old / nloc;
        if (old + 1u == (gen + 1u) * nloc) {
            __builtin_amdgcn_fence(__ATOMIC_RELEASE, "agent");
            asm volatile("s_waitcnt vmcnt(0)" ::: "memory");
            const unsigned og = xb_add(&bar[XB_TOP], 1u);
            const unsigned tg = og / nx;
            if (og + 1u == (tg + 1u) * nx) xb_add(&bar[XB_TOPGEN], 1u);
            else XB_SPIN(xb_ld(&bar[XB_TOPGEN]) == tg, bar);
            __builtin_amdgcn_fence(__ATOMIC_ACQUIRE, "agent");
            xb_add(&bar[XB_XGEN(b.x)], 1u);
            asm volatile("s_waitcnt vmcnt(0)" ::: "memory");
        } else {
            XB_SPIN(xb_ld(&bar[XB_XGEN(b.x)]) == gen, bar);
            __builtin_amdgcn_fence(__ATOMIC_ACQUIRE, "agent");
            asm volatile("s_waitcnt vmcnt(0)" ::: "memory");
        }
    }
    __syncthreads();
}

constexpr size_t WS_BAR = 512 * 1024;
constexpr size_t WS_CMX = 512 * 1024 + 16384;
constexpr int MISC_OFF = 163840 - 64;
struct Args { const float* in[18]; float* out; unsigned char* ws; int ph_lo, ph_hi; };
struct Ctx { int tid, lane, wave, G, gw, NGW, gwx; unsigned char* lds; LAS unsigned char* ldsl; };

__device__ __forceinline__ void transpose_item(const float* W, int ldw, int K, int nblk, bf16* WT, float* scr, int item, int lane) {
    const int kb = item / nblk, nb = item % nblk, k0 = 64 * kb, n0 = 32 * nb;
#pragma unroll 8
    for (int i = 0; i < 32; ++i) { const int kk = 2 * i + (lane >> 5); scr[kk * 33 + (lane & 31)] = W[(size_t)(k0 + kk) * ldw + n0 + (lane & 31)]; }
    WAVE_FENCE();
    const int c = lane & 7;
#pragma unroll
    for (int j = 0; j < 4; ++j) { const int n = (lane >> 3) + 8 * j; const float* s = scr + (8 * c) * 33 + n;
        uint4 o; o.x = pk2(s[0 * 33], s[1 * 33]); o.y = pk2(s[2 * 33], s[3 * 33]); o.z = pk2(s[4 * 33], s[5 * 33]); o.w = pk2(s[6 * 33], s[7 * 33]);
        *(uint4*)(WT + (size_t)(n0 + n) * K + k0 + 8 * c) = o; }
    WAVE_FENCE();
}
__device__ __forceinline__ void ph_prologue(const Ctx& c, const Args& a) {
    const float* x = a.in[0]; const float* w_in = a.in[1]; const float* b_ig = a.in[6]; const float* b_fg = a.in[7];
    bf16* WoutT = (bf16*)(a.ws + WS_WOUT); unsigned* xq8 = (unsigned*)(a.ws + WS_XB); float* sxa = (float*)(a.ws + WS_SXA);
    float* ipre = (float*)(a.ws + WS_GATE); float* logf = ipre + (size_t)T_ * 4;
    float* scr = (float*)(c.lds + c.wave * 8448); float* wgs = (float*)(c.lds + 69632);
    for (int i = c.tid; i < 8192; i += NTHREADS) wgs[i] = w_in[(size_t)(i >> 3) * INC + NPROJ + (i & 7)];
    constexpr int I_IN = 16 * 96, I_OUT = 16 * 32, I_Q = 16 * 64;
    unsigned* cmx = (unsigned*)(a.ws + WS_CMX); unsigned* ccnt = cmx + NPROJ + 2048;
    for (int it = c.gw; it < I_IN + I_Q; it += c.NGW) {
        const bool isq = it >= I_IN; const int r = isq ? it - I_IN : it, nblk = isq ? 64 : 96, ldw = isq ? 2048 : INC; const float* W = isq ? a.in[12] : w_in;
        const int kb = r / nblk, nb = r % nblk, k0 = 64 * kb, n0 = 32 * nb, cl = c.lane & 31, kh = c.lane >> 5; float am = 0.f;
#pragma unroll 8
        for (int i = 0; i < 32; ++i) am = fmaxf(am, fabsf(W[(size_t)(k0 + 2 * i + kh) * ldw + n0 + cl]));
        am = fmaxf(am, __shfl_xor(am, 32));
        unsigned prev = 0u;
        if (c.lane < 32) prev = atomicMax(cmx + (isq ? NPROJ : 0) + n0 + cl, __float_as_uint(am));
        asm volatile("s_waitcnt vmcnt(0)" : "+v"(prev) :: "memory");
        if (c.lane == 0) __hip_atomic_fetch_add(ccnt + (isq ? 96 : 0) + nb, 1u, __ATOMIC_RELAXED, __HIP_MEMORY_SCOPE_AGENT);
    }
    for (int it = c.gw; it < I_OUT; it += c.NGW) transpose_item(a.in[9], D_, D_, 32, WoutT, scr, it, c.lane);
    for (int it = c.gw; it < 64; it += c.NGW) {
        const int mat = it >> 5, h = (it >> 3) & 3, r = it & 7;
        transpose_item(a.in[4 + mat] + (size_t)h * 128 * 128, 128, 128, 4, (bf16*)(a.ws + WS_WMT) + (size_t)(mat * 4 + h) * 128 * 128, scr, r, c.lane);
    }
    { const float4* sk = (const float4*)a.in[13]; uint2* skb = (uint2*)(a.ws + WS_SK);
      for (int i = blockIdx.x * NTHREADS + c.tid; i < 8 * 2 * 128 * 128 / 4; i += c.G * NTHREADS) { const float4 v = sk[i]; uint2 o; o.x = pk2(v.x, v.y); o.y = pk2(v.z, v.w); skb[i] = o; } }
    __syncthreads();
    for (int rowb = c.gw * 4; rowb < T_; rowb += c.NGW * 4) {
      float4 xx[4][4];
#pragma unroll
      for (int rr = 0; rr < 4; ++rr) { const float4* xr = (const float4*)(x + (size_t)(rowb + rr) * D_) + c.lane;
#pragma unroll
          for (int j = 0; j < 4; ++j) xx[rr][j] = xr[64 * j]; }
      float g[4][8];
#pragma unroll
      for (int rr = 0; rr < 4; ++rr)
#pragma unroll
          for (int i = 0; i < 8; ++i) g[rr][i] = 0.f;
#pragma unroll
      for (int j = 0; j < 4; ++j) {
          const int k = (64 * j + c.lane) * 4;
#pragma unroll
          for (int i = 0; i < 4; ++i) { const float4 w0 = *(const float4*)(wgs + (k + i) * 8), w1 = *(const float4*)(wgs + (k + i) * 8 + 4);
#pragma unroll
              for (int rr = 0; rr < 4; ++rr) { const float4 v = xx[rr][j]; const float xv = (i == 0) ? v.x : (i == 1) ? v.y : (i == 2) ? v.z : v.w;
                  g[rr][0] += xv * w0.x; g[rr][1] += xv * w0.y; g[rr][2] += xv * w0.z; g[rr][3] += xv * w0.w; g[rr][4] += xv * w1.x; g[rr][5] += xv * w1.y; g[rr][6] += xv * w1.z; g[rr][7] += xv * w1.w; } }
      }
#pragma unroll
      for (int rr = 0; rr < 4; ++rr) {
          float am = 0.f;
#pragma unroll
          for (int j = 0; j < 4; ++j) { const float4 v = xx[rr][j]; am = fmaxf(am, fmaxf(fmaxf(fabsf(v.x), fabsf(v.y)), fmaxf(fabsf(v.z), fabsf(v.w)))); }
          am = fmaxf(wave_max(am), 1e-30f); const float inv = 127.f / am;
          if (c.lane == 0) sxa[rowb + rr] = am * (1.f / 127.f);
#pragma unroll
          for (int j = 0; j < 4; ++j) { const float4 v = xx[rr][j];
              xq8[(size_t)(rowb + rr) * 256 + 64 * j + c.lane] = (unsigned)((__float2int_rn(v.x * inv) & 0xff) | ((__float2int_rn(v.y * inv) & 0xff) << 8) | ((__float2int_rn(v.z * inv) & 0xff) << 16) | (__float2int_rn(v.w * inv) << 24)); }
      }
#pragma unroll
      for (int rr = 0; rr < 4; ++rr) {
        const int row = rowb + rr;
#pragma unroll
        for (int i = 0; i < 8; ++i) g[rr][i] = wave_sum(g[rr][i]);
        if (c.lane < 8) {
            float gv = g[rr][0];
#pragma unroll
            for (int i = 1; i < 8; ++i) gv = (c.lane == i) ? g[rr][i] : gv;
            if (c.lane < 4) ipre[(size_t)row * 4 + c.lane] = gv + b_ig[c.lane];
            else { const float z = gv + b_fg[c.lane - 4]; logf[(size_t)row * 4 + c.lane - 4] = fminf(z, 0.f) - log1pf(expf(-fabsf(z))); }
        }
      }
    }
    for (int it = c.gw; it < I_IN + I_Q; it += c.NGW) {
        const bool isq = it >= I_IN; const int r = isq ? it - I_IN : it, nblk = isq ? 64 : 96, ldw = isq ? 2048 : INC; const float* W = isq ? a.in[12] : w_in;
        const int kb = r / nblk, nb = r % nblk, k0 = 64 * kb, n0 = 32 * nb, cl = c.lane & 31, kh = c.lane >> 5;
        { unsigned spins = 0; while (__hip_atomic_load(ccnt + (isq ? 96 : 0) + nb, __ATOMIC_RELAXED, __HIP_MEMORY_SCOPE_AGENT) < 16u && ++spins < (1u << 22)) __builtin_amdgcn_s_sleep(2); }
        const float am = fmaxf(__uint_as_float(__hip_atomic_load(cmx + (isq ? NPROJ : 0) + n0 + cl, __ATOMIC_RELAXED, __HIP_MEMORY_SCOPE_AGENT)), 1e-30f), inv = 127.f / am;
        if (kb == 0 && c.lane < 32) ((float*)(a.ws + (isq ? WS_SWQ : WS_SWN)))[n0 + cl] = am * (1.f / 127.f);
        unsigned char* W8 = a.ws + (isq ? WS_WQ : WS_WIN);
#pragma unroll 8
        for (int i = 0; i < 32; ++i) { const int kk = 2 * i + kh; scr[kk * 33 + cl] = W[(size_t)(k0 + kk) * ldw + n0 + cl] * inv; }
        WAVE_FENCE();
        const int c8 = c.lane & 7;
#pragma unroll
        for (int j = 0; j < 4; ++j) { const int n = (c.lane >> 3) + 8 * j; const float* sp = scr + (8 * c8) * 33 + n;
            uint2 o; o.x = (unsigned)((__float2int_rn(sp[0]) & 0xff) | ((__float2int_rn(sp[33]) & 0xff) << 8) | ((__float2int_rn(sp[66]) & 0xff) << 16) | (__float2int_rn(sp[99]) << 24));
            o.y = (unsigned)((__float2int_rn(sp[132]) & 0xff) | ((__float2int_rn(sp[165]) & 0xff) << 8) | ((__float2int_rn(sp[198]) & 0xff) << 16) | (__float2int_rn(sp[231]) << 24));
            *(uint2*)(W8 + (size_t)(n0 + n) * D_ + k0 + 8 * c8) = o; }
        WAVE_FENCE();
    }
}

__device__ __forceinline__ void quant_table_rows(const Ctx& c, const Args& a, int r0) {
      float4 vv[4][4];
#pragma unroll
      for (int rr = 0; rr < 4; ++rr) { const int r = r0 + rr; const float4* src = (const float4*)(a.in[14 + (r >> 14)] + (size_t)(r & 16383) * D_) + c.lane;
#pragma unroll
          for (int j = 0; j < 4; ++j) vv[rr][j] = src[64 * j]; }
#pragma unroll
      for (int rr = 0; rr < 4; ++rr) {
        const int r = r0 + rr, tb = r >> 14, e = r & 16383;
        float4 v[4]; float mx = 0.f;
#pragma unroll
        for (int j = 0; j < 4; ++j) { v[j] = vv[rr][j]; mx = fmaxf(mx, fmaxf(fmaxf(fabsf(v[j].x), fabsf(v[j].y)), fmaxf(fabsf(v[j].z), fabsf(v[j].w)))); }
        mx = fmaxf(wave_max(mx), 1e-30f);
        const float inv = 127.f / mx;
        if (c.lane == 0) ((float*)(a.ws + (tb ? WS_SCU : WS_SCD)))[e] = mx * (1.f / 127.f);
        unsigned* dst = (unsigned*)(a.ws + (tb ? WS_WU : WS_WD));
#pragma unroll
        for (int j = 0; j < 4; ++j) { const int p = (__float2int_rn(v[j].x * inv) & 0xff) | ((__float2int_rn(v[j].y * inv) & 0xff) << 8) | ((__float2int_rn(v[j].z * inv) & 0xff) << 16) | (__float2int_rn(v[j].w * inv) << 24);
            dst[(size_t)(2 * j + (c.lane >> 5)) * (16384 * 32) + (size_t)e * 32 + (c.lane & 31)] = (unsigned)p; }
      }
}
typedef short s16x4 __attribute__((ext_vector_type(4)));
typedef unsigned u32x4 __attribute__((ext_vector_type(4)));
typedef unsigned u32x2 __attribute__((ext_vector_type(2)));
typedef float f32x4 __attribute__((ext_vector_type(4)));
typedef float f32x2_t __attribute__((ext_vector_type(2))); typedef __bf16 bf16x2_t __attribute__((ext_vector_type(2)));
__device__ __forceinline__ unsigned cvtpk(float lo, float hi) { const f32x2_t v = {lo, hi}; const bf16x2_t b = __builtin_convertvector(v, bf16x2_t); return __builtin_bit_cast(unsigned, b); }
__device__ __forceinline__ bf16x8 pack8(const f32x16& p, int b0) {
    union { unsigned u[4]; bf16x8 v; } x;
    x.u[0] = cvtpk(p[b0 + 0], p[b0 + 1]); x.u[1] = cvtpk(p[b0 + 2], p[b0 + 3]); x.u[2] = cvtpk(p[b0 + 4], p[b0 + 5]); x.u[3] = cvtpk(p[b0 + 6], p[b0 + 7]); return x.v;
}
__device__ __forceinline__ s16x4 tr_read(LAS unsigned char* p) { return __builtin_amdgcn_ds_read_tr16_b64_v4i16((LAS s16x4*)p); }
constexpr int AT_VP = 192, AT_OP = 144;
template <int T0> __device__ __forceinline__ void attn_task(LAS unsigned char* vl, const bf16* proj, unsigned char* ws, unsigned char* ob, int lane, int br, int b, int h, int d, int r, int m0) {
    const int col = lane & 31, hh = lane >> 5, i16 = lane & 15, grp = lane >> 4;
    const float CS = 0.125f * 1.4426950408889634f;
    const bf16* base = proj + (size_t)b * S_ * NPROJ + h * 64 + 8 * hh;
    const int tq = (m0 + col) * d + r;
    bf16x8 bq[4];
#pragma unroll
    for (int s = 0; s < 4; ++s) bq[s] = *(const bf16x8*)(base + (size_t)tq * NPROJ + C_QA + 16 * s);
    bf16x8 ka[5][4];
#pragma unroll
    for (int tau = T0; tau < 5; ++tau) { const bf16* kp = base + (size_t)((m0 - 128 + 32 * tau + col) * d + r) * NPROJ + C_KA;
#pragma unroll
        for (int s = 0; s < 4; ++s) ka[tau][s] = *(const bf16x8*)(kp + 16 * s); }
    f32x16 sc[5];
#pragma unroll
    for (int tau = T0; tau < 5; ++tau) {
        f32x16 acc;
#pragma unroll
        for (int i = 0; i < 16; ++i) acc[i] = 0.f;
#pragma unroll
        for (int s = 0; s < 4; ++s) acc = __builtin_amdgcn_mfma_f32_32x32x16_bf16(ka[tau][s], bq[s], acc, 0, 0, 0);
#pragma unroll
        for (int i = 0; i < 16; ++i) { const int cr = (i & 3) + 8 * (i >> 2) + 4 * hh;
            const bool ok = (tau == 0) ? (cr >= col) : ((tau == 4) ? (cr <= col) : true);
            sc[tau][i] = ok ? acc[i] * CS : -INFINITY; }
    }
    u32x4 vv[5][4];
#pragma unroll
    for (int tau = T0; tau < 5; ++tau)
#pragma unroll
        for (int q = 0; q < 4; ++q) { const int id = lane + 64 * q, row = id >> 3, ch = id & 7;
            vv[tau][q] = *(const u32x4*)(proj + (size_t)(b * S_ + (m0 - 128 + 32 * tau + row) * d + r) * NPROJ + C_VA + h * 64 + 8 * ch); }
    float mx = -INFINITY;
#pragma unroll
    for (int tau = T0; tau < 5; ++tau)
#pragma unroll
        for (int i = 0; i < 16; ++i) mx = fmaxf(mx, sc[tau][i]);
    mx = fmaxf(mx, __shfl_xor(mx, 32));
    float l = 0.f;
#pragma unroll
    for (int tau = T0; tau < 5; ++tau)
#pragma unroll
        for (int i = 0; i < 16; ++i) { const float p = __builtin_amdgcn_exp2f(sc[tau][i] - mx); sc[tau][i] = p; l += p; }
    l += __shfl_xor(l, 32);
    f32x16 o[2];
#pragma unroll
    for (int i = 0; i < 16; ++i) { o[0][i] = 0.f; o[1][i] = 0.f; }
#pragma unroll
    for (int tau = T0; tau < 5; ++tau) {
#pragma unroll
        for (int q = 0; q < 4; ++q) { const int id = lane + 64 * q, row = id >> 3, ch = id & 7; *(LAS u32x4*)(vl + row * AT_VP + ch * 16) = vv[tau][q]; }
        WAVE_FENCE();
        const bf16x8 pb0 = pack8(sc[tau], 0), pb1 = pack8(sc[tau], 8);
#pragma unroll
        for (int dt = 0; dt < 2; ++dt)
#pragma unroll
            for (int ks = 0; ks < 2; ++ks) {
                LAS unsigned char* ap = vl + (16 * ks + 4 * hh + (i16 >> 2)) * AT_VP + (32 * dt + 16 * (grp & 1) + 4 * (i16 & 3)) * 2;
                const s16x4 lo = tr_read(ap), hi = tr_read(ap + 8 * AT_VP);
                const bf16x8 av = {lo[0], lo[1], lo[2], lo[3], hi[0], hi[1], hi[2], hi[3]};
                o[dt] = __builtin_amdgcn_mfma_f32_32x32x16_bf16(av, ks ? pb1 : pb0, o[dt], 0, 0, 0);
            }
        WAVE_FENCE();
    }
#pragma unroll
    for (int dt = 0; dt < 2; ++dt)
#pragma unroll
        for (int q4 = 0; q4 < 4; ++q4) { u32x2 w; w.x = cvtpk(o[dt][4 * q4], o[dt][4 * q4 + 1]); w.y = cvtpk(o[dt][4 * q4 + 2], o[dt][4 * q4 + 3]);
            *(LAS u32x2*)(vl + col * AT_OP + (32 * dt + 8 * q4 + 4 * hh) * 2) = w; }
    WAVE_FENCE();
    bf16* pO = (br < 2) ? (bf16*)(ws + WS_PO01 + (size_t)br * 32 * MiB) : (bf16*)(ob + OUT_PO2);
#pragma unroll
    for (int q = 0; q < 4; ++q) { const int id = lane + 64 * q, row = id >> 3, ch = id & 7;
        const u32x4 v = *(LAS u32x4*)(vl + row * AT_OP + ch * 16);
        *(u32x4*)(pO + ((size_t)(b * S_ + (m0 + row) * d + r) * 8 + h) * 64 + 8 * ch) = v; }
    if (hh == 0) ((float2*)(ob + OUT_PML))[((size_t)br * T_ + b * S_ + tq) * 8 + h] = make_float2(mx, l);
    WAVE_FENCE();
}
__device__ __forceinline__ void ph_attn(const Ctx& c, const bf16* proj, unsigned char* ws, unsigned char* ob, unsigned* aq) {
    LAS unsigned char* vl = c.ldsl + c.wave * 6144;
    const int x0 = blockIdx.x & 7;
    for (int qi = 0; qi < 8; ++qi) {
        unsigned* cnt = aq + ((x0 + qi) & 7) * 64; const int tbase = ((x0 + qi) & 7) * 3072;
        unsigned tkv = 0u;
        if (c.lane == 0) tkv = xb_add(cnt, 1u);
        for (;;) {
            const int tk = __builtin_amdgcn_readfirstlane((int)tkv);
            if (tk >= 3072) break;
            if (c.lane == 0) tkv = xb_add(cnt, 1u);
            const int task = tbase + tk;
            const int bh = task / 192, rem = task % 192, br = rem >> 6, rq = rem & 63;
            const int dsh = 2 * br, d = 1 << dsh, nqsh = 6 - dsh;
            const int r = rq >> nqsh, m0 = (rq & ((1 << nqsh) - 1)) * 32, b = bh >> 3, h = bh & 7;
            switch (m0 >= 128 ? 0 : (128 - m0) >> 5) {
                case 0: attn_task<0>(vl, proj, ws, ob, c.lane, br, b, h, d, r, m0); break;
                case 1: attn_task<1>(vl, proj, ws, ob, c.lane, br, b, h, d, r, m0); break;
                case 2: attn_task<2>(vl, proj, ws, ob, c.lane, br, b, h, d, r, m0); break;
                case 3: attn_task<3>(vl, proj, ws, ob, c.lane, br, b, h, d, r, m0); break;
                default: attn_task<4>(vl, proj, ws, ob, c.lane, br, b, h, d, r, m0); break;
            }
        }
    }
}
__device__ __forceinline__ void ph_attn_merge(const Ctx& c, const unsigned char* ws, const unsigned char* ob, bf16* concat) {
    const int lane = c.lane, h = lane >> 3, c8 = lane & 7;
    const float2* pML = (const float2*)(ob + OUT_PML);
    constexpr int TB = 4;
    for (int t0 = c.gw * TB; t0 < T_; t0 += c.NGW * TB) {
        uint4 v[TB][3]; float2 ml[TB][3];
#pragma unroll
        for (int i = 0; i < TB; ++i)
#pragma unroll
            for (int br = 0; br < 3; ++br) { const bf16* pO = (br < 2) ? (const bf16*)(ws + WS_PO01 + (size_t)br * 32 * MiB) : (const bf16*)(ob + OUT_PO2);
                v[i][br] = *(const uint4*)(pO + ((size_t)(t0 + i) * 8 + h) * 64 + 8 * c8); ml[i][br] = pML[((size_t)br * T_ + t0 + i) * 8 + h]; }
#pragma unroll
        for (int i = 0; i < TB; ++i) {
            const float M = fmaxf(ml[i][0].x, fmaxf(ml[i][1].x, ml[i][2].x));
            const float w0 = __builtin_amdgcn_exp2f(ml[i][0].x - M), w1 = __builtin_amdgcn_exp2f(ml[i][1].x - M), w2 = __builtin_amdgcn_exp2f(ml[i][2].x - M);
            const float inv = 1.f / (ml[i][0].y * w0 + ml[i][1].y * w1 + ml[i][2].y * w2);
            const unsigned* a0 = (const unsigned*)&v[i][0]; const unsigned* a1 = (const unsigned*)&v[i][1]; const unsigned* a2 = (const unsigned*)&v[i][2];
            uint4 o; unsigned* op = (unsigned*)&o;
#pragma unroll
            for (int e = 0; e < 4; ++e) {
                const float lo = (w0 * __uint_as_float(a0[e] << 16) + w1 * __uint_as_float(a1[e] << 16) + w2 * __uint_as_float(a2[e] << 16)) * inv;
                const float hi = (w0 * __uint_as_float(a0[e] & 0xffff0000u) + w1 * __uint_as_float(a1[e] & 0xffff0000u) + w2 * __uint_as_float(a2[e] & 0xffff0000u)) * inv;
                op[e] = pk2(lo, hi);
            }
            *(uint4*)(concat + (size_t)(t0 + i) * D_ + h * 64 + 8 * c8) = o;
        }
    }
}
constexpr int ML_XP = 272, ML_VP = 320;
constexpr size_t WS_MFLAG = WS_BAR + 40960;
constexpr size_t WS_AQ = WS_BAR + 45056;
struct GateRaw { float lf0, lf1, ip0, ip1; };
__device__ __forceinline__ GateRaw gate_load(const float* ipre, const float* logf, int bt0, int h, int lane) {
    GateRaw r; r.lf0 = logf[(size_t)(bt0 + 2 * lane) * 4 + h]; r.lf1 = logf[(size_t)(bt0 + 2 * lane + 1) * 4 + h];
    r.ip0 = ipre[(size_t)(bt0 + 2 * lane) * 4 + h]; r.ip1 = ipre[(size_t)(bt0 + 2 * lane + 1) * 4 + h]; return r;
}
__device__ __forceinline__ bf16x8 tr_pair(LAS unsigned char* p, int hi_off) { const s16x4 lo = tr_read(p), hi = tr_read(p + hi_off); return (bf16x8){lo[0], lo[1], lo[2], lo[3], hi[0], hi[1], hi[2], hi[3]}; }

__device__ __forceinline__ void ph_mprod(const Ctx& c, const Args& a, const bf16* proj, bf16* mq, bf16* mk, unsigned* flag, int j, int NP) {
    const float* conv_w = a.in[2]; const float* conv_b = a.in[3];
    const bf16* WmT = (const bf16*)(a.ws + WS_WMT);
    LAS unsigned char* XC = c.ldsl;
    const int tid = c.tid, lane = c.lane, wave = c.wave, col = lane & 31, hh = lane >> 5;
    int qr = (j * NWAVES + wave) * 4; const int qstep = NP * NWAVES * 4;
    for (int u = j; u < 1024; u += NP) {
        const int cc = u >> 6, bh = u & 63, b = bh >> 2, h = bh & 3, bt0 = b * S_ + cc * 128;
        {
            const int ch = tid & 127, ts = (tid >> 7) * 32, cidx = h * 128 + ch;
            const float w0 = conv_w[cidx], w1 = conv_w[512 + cidx], w2 = conv_w[1024 + cidx], w3 = conv_w[1536 + cidx], cb = conv_b[cidx];
            const bf16* xp = proj + (size_t)bt0 * NPROJ + C_XM + cidx;
            const int tseq = cc * 128 + ts;
            float xv[35];
#pragma unroll
            for (int i = 0; i < 3; ++i) { const bool ok = tseq - 3 + i >= 0; const float v = bf2f(xp[(ptrdiff_t)(ok ? ts - 3 + i : ts) * NPROJ]); xv[i] = ok ? v : 0.f; }
#pragma unroll
            for (int i = 0; i < 32; ++i) xv[3 + i] = bf2f(xp[(size_t)(ts + i) * NPROJ]);
#pragma unroll
            for (int i = 0; i < 32; ++i) {
                const float acc = cb + w0 * xv[i] + w1 * xv[i + 1] + w2 * xv[i + 2] + w3 * xv[i + 3];
                *(LAS bf16*)(XC + (ts + i) * ML_XP + ch * 2) = (bf16)f2bf(acc / (1.f + expf(-acc)));
            }
        }
        __syncthreads();
        {
            const int tokt = wave & 3, mat = wave >> 2, tok = 32 * tokt + col;
            bf16x8 xf[8];
#pragma unroll
            for (int s2 = 0; s2 < 8; ++s2) xf[s2] = *(LAS bf16x8*)(XC + tok * ML_XP + (16 * s2 + 8 * hh) * 2);
            const bf16* WT = WmT + (size_t)(mat * 4 + h) * 128 * 128 + (size_t)col * 128 + 8 * hh;
            bf16* og = (mat ? mk : mq) + (size_t)(bt0 + tok) * 512 + h * 128;
            const float sc = mat ? 1.f : 0.08838834764831845f;
#pragma unroll
            for (int ft = 0; ft < 4; ++ft) {
                const bf16* wp = WT + (size_t)ft * 32 * 128; asm volatile("" : "+v"(wp));
                f32x16 acc;
#pragma unroll
                for (int i = 0; i < 16; ++i) acc[i] = 0.f;
#pragma unroll
                for (int s2 = 0; s2 < 8; ++s2) { const bf16x8 af = *(const bf16x8*)(wp + 16 * s2); acc = __builtin_amdgcn_mfma_f32_32x32x16_bf16(af, xf[s2], acc, 0, 0, 0); }
#pragma unroll
                for (int q4 = 0; q4 < 4; ++q4) {
                    const int f0 = 32 * ft + 8 * q4 + 4 * hh;
                    const unsigned long long w = (unsigned long long)cvtpk(acc[4 * q4] * sc, acc[4 * q4 + 1] * sc) | ((unsigned long long)cvtpk(acc[4 * q4 + 2] * sc, acc[4 * q4 + 3] * sc) << 32);
                    __hip_atomic_store((unsigned long long*)(og + f0), w, __ATOMIC_RELAXED, __HIP_MEMORY_SCOPE_AGENT);
                }
            }
        }
        asm volatile("s_waitcnt vmcnt(0)" ::: "memory");
        __syncthreads();
        if (tid == 0) __hip_atomic_store(&flag[u], 1u, __ATOMIC_RELAXED, __HIP_MEMORY_SCOPE_AGENT);
        if (qr < 2 * 16384) { quant_table_rows(c, a, qr); qr += qstep; }
    }
    for (; qr < 2 * 16384; qr += qstep) quant_table_rows(c, a, qr);
}

constexpr int MS_VS = 0, MS_KW = 40960, MS_KS = 81920, MS_CS = 116736, MS_TAB = 151552;
__device__ __forceinline__ void ph_mseq(const Ctx& c, const Args& a, const bf16* proj, const float* ipre, const float* logf, const bf16* mq, const bf16* mk, unsigned* flag, unsigned* bar, bf16* concat, int bh) {
    LAS unsigned char* VS = c.ldsl + MS_VS; LAS unsigned char* KW = c.ldsl + MS_KW; LAS unsigned char* KS = c.ldsl + MS_KS; LAS unsigned char* CS = c.ldsl + MS_CS;
    LAS float* utab = (LAS float*)(c.ldsl + MS_TAB); LAS float* mxt = utab + 128; LAS float* wit = utab + 256; LAS float* ednt = utab + 384; LAS float* wkt = utab + 512; LAS float* nvec = utab + 640;
    LAS float* nrm = utab + 768;
    LAS float* nred = utab + 1280;
    LAS float* scal = utab + 1792;
    LAS float* mhg = utab + 1796;
    const int tid = c.tid, lane = c.lane, wave = c.wave, col = lane & 31, hh = lane >> 5, i16 = lane & 15, grp = lane >> 4;
    const int b = bh >> 2, h = bh & 3;
    const int vh = wave >> 2, tt = vh ? 3 - (wave & 3) : (wave & 3), t = 32 * tt + col;
    const int uvt = wave >> 1, ukt0 = 2 * (wave & 1);
    f32x16 st0, st1;
#pragma unroll
    for (int i = 0; i < 16; ++i) { st0[i] = 0.f; st1[i] = 0.f; }
    float nreg = 0.f, mc = 0.f;
    for (int i = tid; i < 34816 / 16; i += NTHREADS) *(LAS u32x4*)(CS + i * 16) = (u32x4){0u, 0u, 0u, 0u};
    if (tid < 128) { nvec[tid] = 0.f; mhg[tid] = a.in[8][h * 128 + tid]; }
    GateRaw gr = gate_load(ipre, logf, b * S_, h, lane);
    for (int cc = 0; cc < 16; ++cc) {
        const int bt0 = b * S_ + cc * 128;
        if (tid == 0) {
            XB_SPIN(xb_ld(&flag[cc * 64 + bh]) == 0u, bar);
            __builtin_amdgcn_fence(__ATOMIC_ACQUIRE, "agent");
            asm volatile("s_waitcnt vmcnt(0)" ::: "memory");
        }
        __syncthreads();
        bf16x8 bq[8];
        { const bf16* qp = mq + (size_t)(bt0 + t) * 512 + h * 128 + 8 * hh;
#pragma unroll
          for (int s2 = 0; s2 < 8; ++s2) bq[s2] = *(const bf16x8*)(qp + 16 * s2); }
        u32x4 kr[4], vr[4];
#pragma unroll
        for (int q = 0; q < 4; ++q) { const int id = tid + 512 * q, row = id >> 4, ch = id & 15;
            kr[q] = *(const u32x4*)(mk + (size_t)(bt0 + row) * 512 + h * 128 + 8 * ch);
            vr[q] = *(const u32x4*)(proj + (size_t)(bt0 + row) * NPROJ + C_VM + h * 128 + 8 * ch); }
        if (wave == 1) {
            float incl = gr.lf0 + gr.lf1;
#pragma unroll
            for (int o = 1; o < 64; o <<= 1) { const float n = __shfl_up(incl, o); if (lane >= o) incl += n; }
            const float bc1 = incl, bc0 = incl - gr.lf1, u0 = gr.ip0 - bc0, u1 = gr.ip1 - bc1;
            const float umax = wave_max(fmaxf(u0, u1)), bL = __shfl(incl, 63);
            float incm = fmaxf(u0, u1);
#pragma unroll
            for (int o = 1; o < 64; o <<= 1) { const float n = __shfl_up(incm, o); if (lane >= o) incm = fmaxf(incm, n); }
            float exm = __shfl_up(incm, 1); if (lane == 0) exm = -INFINITY;
            const float M0 = fmaxf(mc, fmaxf(exm, u0)), M1 = fmaxf(mc, incm);
            utab[2 * lane] = u0; utab[2 * lane + 1] = u1; mxt[2 * lane] = M0; mxt[2 * lane + 1] = M1;
            wit[2 * lane] = expf(mc - M0); wit[2 * lane + 1] = expf(mc - M1); ednt[2 * lane] = expf(-(bc0 + M0)); ednt[2 * lane + 1] = expf(-(bc1 + M1));
            const float mnew = fmaxf(bL + mc, bL + umax);
            wkt[2 * lane] = expf(u0 + bL - mnew); wkt[2 * lane + 1] = expf(u1 + bL - mnew);
            if (lane == 0) scal[0] = expf(bL + mc - mnew);
            mc = mnew;
            if (cc < 15) gr = gate_load(ipre, logf, bt0 + 128, h, lane);
        }
#pragma unroll
        for (int q = 0; q < 4; ++q) { const int id = tid + 512 * q, row = id >> 4, ch = id & 15;
            *(LAS u32x4*)(KS + row * ML_XP + ch * 16) = kr[q]; *(LAS u32x4*)(VS + row * ML_VP + ch * 16) = vr[q]; }
        __syncthreads();
#pragma unroll
        for (int q = 0; q < 4; ++q) { const int id = tid + 512 * q, row = id >> 4, ch = id & 15; const float w = wkt[row];
            u32x4 o;
            o.x = cvtpk(__uint_as_float(kr[q].x << 16) * w, __uint_as_float(kr[q].x & 0xffff0000u) * w); o.y = cvtpk(__uint_as_float(kr[q].y << 16) * w, __uint_as_float(kr[q].y & 0xffff0000u) * w);
            o.z = cvtpk(__uint_as_float(kr[q].z << 16) * w, __uint_as_float(kr[q].z & 0xffff0000u) * w); o.w = cvtpk(__uint_as_float(kr[q].w << 16) * w, __uint_as_float(kr[q].w & 0xffff0000u) * w);
            *(LAS u32x4*)(KW + row * ML_VP + ch * 16) = o; }
        { const int k = tid & 127, part = tid >> 7; float sacc = 0.f;
          for (int s2 = 0; s2 < 32; ++s2) sacc += wkt[32 * part + s2] * bf2f(*(LAS bf16*)(KS + (32 * part + s2) * ML_XP + k * 2));
          nred[part * 128 + k] = sacc; }
        const float Mt = mxt[t], wint = wit[t], edn = ednt[t];
        f32x16 acc[2];
#pragma unroll
        for (int vtl = 0; vtl < 2; ++vtl) {
#pragma unroll
            for (int i = 0; i < 16; ++i) acc[vtl][i] = 0.f;
#pragma unroll
            for (int s2 = 0; s2 < 8; ++s2) { const bf16x8 af = *(LAS bf16x8*)(CS + (64 * vh + 32 * vtl + col) * ML_XP + (16 * s2 + 8 * hh) * 2); acc[vtl] = __builtin_amdgcn_mfma_f32_32x32x16_bf16(af, bq[s2], acc[vtl], 0, 0, 0); }
#pragma unroll
            for (int i = 0; i < 16; ++i) acc[vtl][i] *= wint;
        }
        float qn = 0.f;
#pragma unroll
        for (int s2 = 0; s2 < 8; ++s2) {
            const f32x4 n0 = *(LAS f32x4*)(nvec + 16 * s2 + 8 * hh), n1 = *(LAS f32x4*)(nvec + 16 * s2 + 8 * hh + 4);
            const unsigned* qw = (const unsigned*)&bq[s2];
            qn += __uint_as_float(qw[0] << 16) * n0[0] + __uint_as_float(qw[0] & 0xffff0000u) * n0[1] + __uint_as_float(qw[1] << 16) * n0[2] + __uint_as_float(qw[1] & 0xffff0000u) * n0[3];
            qn += __uint_as_float(qw[2] << 16) * n1[0] + __uint_as_float(qw[2] & 0xffff0000u) * n1[1] + __uint_as_float(qw[3] << 16) * n1[2] + __uint_as_float(qw[3] & 0xffff0000u) * n1[3];
        }
        qn += __shfl_xor(qn, 32);
        float dsum = 0.f;
        for (int st = 0; st <= tt; ++st) {
            f32x16 sT;
#pragma unroll
            for (int i = 0; i < 16; ++i) sT[i] = 0.f;
#pragma unroll
            for (int s2 = 0; s2 < 8; ++s2) { const bf16x8 kf = *(LAS bf16x8*)(KS + (32 * st + col) * ML_XP + (16 * s2 + 8 * hh) * 2); sT = __builtin_amdgcn_mfma_f32_32x32x16_bf16(kf, bq[s2], sT, 0, 0, 0); }
            f32x16 p;
#pragma unroll
            for (int q4 = 0; q4 < 4; ++q4) {
                const f32x4 uu = *(LAS f32x4*)(utab + 32 * st + 8 * q4 + 4 * hh);
#pragma unroll
                for (int e = 0; e < 4; ++e) { const int cr = 8 * q4 + 4 * hh + e; const bool ok = (st < tt) || (cr <= col);
                    const float pv = ok ? expf(uu[e] - Mt) * sT[4 * q4 + e] : 0.f; p[4 * q4 + e] = pv; dsum += pv; }
            }
            const bf16x8 pb0 = pack8(p, 0), pb1 = pack8(p, 8);
#pragma unroll
            for (int vtl = 0; vtl < 2; ++vtl)
#pragma unroll
                for (int ks = 0; ks < 2; ++ks) {
                    const bf16x8 av = tr_pair(VS + (32 * st + 16 * ks + 4 * hh + (i16 >> 2)) * ML_VP + (64 * vh + 32 * vtl + 16 * (grp & 1) + 4 * (i16 & 3)) * 2, 8 * ML_VP);
                    acc[vtl] = __builtin_amdgcn_mfma_f32_32x32x16_bf16(av, ks ? pb1 : pb0, acc[vtl], 0, 0, 0);
                }
        }
        dsum += __shfl_xor(dsum, 32);
        const float den = wint * qn + dsum, inv = 1.f / fmaxf(fabsf(den), edn);
        float s1 = 0.f, s2q = 0.f;
#pragma unroll
        for (int vtl = 0; vtl < 2; ++vtl)
#pragma unroll
            for (int i = 0; i < 16; ++i) { const float hv = acc[vtl][i] * inv; acc[vtl][i] = hv; s1 += hv; s2q += hv * hv; }
        s1 += __shfl_xor(s1, 32); s2q += __shfl_xor(s2q, 32);
        if (hh == 0) { nrm[(vh * 128 + t) * 2] = s1; nrm[(vh * 128 + t) * 2 + 1] = s2q; }
        __syncthreads();
        const float av0 = scal[0];
        const bf16* omp = proj + (size_t)(bt0 + t) * NPROJ + C_OM + h * 128 + 64 * vh + 4 * hh;
        u32x2 ow[2][4];
#pragma unroll
        for (int vtl = 0; vtl < 2; ++vtl)
#pragma unroll
            for (int q4 = 0; q4 < 4; ++q4) ow[vtl][q4] = *(const u32x2*)(omp + 32 * vtl + 8 * q4);
        {
#pragma unroll
            for (int i = 0; i < 16; ++i) { st0[i] *= av0; st1[i] *= av0; }
            const int roff = (8 * hh + (i16 >> 2)) * ML_VP + (16 * (grp & 1) + 4 * (i16 & 3)) * 2;
#pragma unroll
            for (int s8 = 0; s8 < 8; ++s8) {
                const bf16x8 bv = tr_pair(VS + s8 * 16 * ML_VP + roff + uvt * 64, 4 * ML_VP);
                const bf16x8 a0 = tr_pair(KW + s8 * 16 * ML_VP + roff + ukt0 * 64, 4 * ML_VP), a1 = tr_pair(KW + s8 * 16 * ML_VP + roff + (ukt0 + 1) * 64, 4 * ML_VP);
                st0 = __builtin_amdgcn_mfma_f32_32x32x16_bf16(a0, bv, st0, 0, 0, 0); st1 = __builtin_amdgcn_mfma_f32_32x32x16_bf16(a1, bv, st1, 0, 0, 0);
            }
#pragma unroll
            for (int q4 = 0; q4 < 4; ++q4) {
                u32x2 w0; w0.x = cvtpk(st0[4 * q4], st0[4 * q4 + 1]); w0.y = cvtpk(st0[4 * q4 + 2], st0[4 * q4 + 3]);
                u32x2 w1; w1.x = cvtpk(st1[4 * q4], st1[4 * q4 + 1]); w1.y = cvtpk(st1[4 * q4 + 2], st1[4 * q4 + 3]);
                *(LAS u32x2*)(CS + (32 * uvt + col) * ML_XP + (32 * ukt0 + 8 * q4 + 4 * hh) * 2) = w0;
                *(LAS u32x2*)(CS + (32 * uvt + col) * ML_XP + (32 * (ukt0 + 1) + 8 * q4 + 4 * hh) * 2) = w1;
            }
        }
        if (tid < 128) { nreg = av0 * nreg + nred[tid] + nred[128 + tid] + nred[256 + tid] + nred[384 + tid]; nvec[tid] = nreg; }
        s1 += nrm[((vh ^ 1) * 128 + t) * 2]; s2q += nrm[((vh ^ 1) * 128 + t) * 2 + 1];
        const float mu = s1 * (1.f / 128.f), var = fmaxf(s2q * (1.f / 128.f) - mu * mu, 0.f), rstd = 1.f / sqrtf(var + LN_EPS);
        bf16* op = concat + (size_t)(bt0 + t) * D_ + 512 + h * 128 + 64 * vh + 4 * hh;
#pragma unroll
        for (int vtl = 0; vtl < 2; ++vtl)
#pragma unroll
            for (int q4 = 0; q4 < 4; ++q4) {
                const f32x4 gg = *(LAS f32x4*)(mhg + 64 * vh + 32 * vtl + 8 * q4 + 4 * hh);
                const u32x2 o2 = ow[vtl][q4];
                const float o0 = __uint_as_float(o2.x << 16), o1 = __uint_as_float(o2.x & 0xffff0000u), o2f = __uint_as_float(o2.y << 16), o3 = __uint_as_float(o2.y & 0xffff0000u);
                const float r0 = (acc[vtl][4 * q4] - mu) * rstd * gg[0] / (1.f + expf(-o0)), r1 = (acc[vtl][4 * q4 + 1] - mu) * rstd * gg[1] / (1.f + expf(-o1));
                const float r2 = (acc[vtl][4 * q4 + 2] - mu) * rstd * gg[2] / (1.f + expf(-o2f)), r3 = (acc[vtl][4 * q4 + 3] - mu) * rstd * gg[3] / (1.f + expf(-o3));
                u32x2 w; w.x = cvtpk(r0, r1); w.y = cvtpk(r2, r3);
                *(u32x2*)(op + 32 * vtl + 8 * q4) = w;
            }
    }
    __syncthreads();
}
__device__ __forceinline__ void ph_ln1(const Ctx& c, const bf16* y1, const float* g, const float* bb, float2* st1, unsigned* xq, float* sx) {
    constexpr int RB = 4;
    for (int row0 = c.gw * RB; row0 < T_; row0 += c.NGW * RB) {
      uint2 yv[RB][4];
#pragma unroll
      for (int r = 0; r < RB; ++r) { const uint2* p = (const uint2*)(y1 + (size_t)(row0 + r) * D_) + c.lane;
#pragma unroll
          for (int j = 0; j < 4; ++j) yv[r][j] = p[64 * j]; }
#pragma unroll
      for (int r = 0; r < RB; ++r) {
        const int row = row0 + r; float4 v[4]; float s = 0.f;
#pragma unroll
        for (int j = 0; j < 4; ++j) { const uint2 w = yv[r][j]; v[j].x = __uint_as_float(w.x << 16); v[j].y = __uint_as_float(w.x & 0xffff0000u); v[j].z = __uint_as_float(w.y << 16); v[j].w = __uint_as_float(w.y & 0xffff0000u);
            s += v[j].x + v[j].y + v[j].z + v[j].w; }
        const float mu = wave_sum(s) * (1.f / D_); float q = 0.f;
#pragma unroll
        for (int j = 0; j < 4; ++j) { v[j].x -= mu; v[j].y -= mu; v[j].z -= mu; v[j].w -= mu; q += v[j].x * v[j].x + v[j].y * v[j].y + v[j].z * v[j].z + v[j].w * v[j].w; }
        const float rstd = 1.f / sqrtf(wave_sum(q) * (1.f / D_) + LN_EPS);
        float4 ov[4]; float am = 0.f;
#pragma unroll
        for (int j = 0; j < 4; ++j) { const int cc = (64 * j + c.lane) * 4; const float4 gg = *(const float4*)(g + cc), b4 = *(const float4*)(bb + cc);
            float4 o; o.x = v[j].x * rstd * gg.x + b4.x; o.y = v[j].y * rstd * gg.y + b4.y; o.z = v[j].z * rstd * gg.z + b4.z; o.w = v[j].w * rstd * gg.w + b4.w;
            ov[j] = o; am = fmaxf(am, fmaxf(fmaxf(fabsf(o.x), fabsf(o.y)), fmaxf(fabsf(o.z), fabsf(o.w)))); }
        am = fmaxf(wave_max(am), 1e-30f); const float inv = 127.f / am;
        if (c.lane == 0) { sx[row] = am * (1.f / 127.f); st1[row] = make_float2(mu, rstd); }
#pragma unroll
        for (int j = 0; j < 4; ++j) xq[(size_t)row * 256 + 64 * j + c.lane] = (unsigned)((__float2int_rn(ov[j].x * inv) & 0xff) | ((__float2int_rn(ov[j].y * inv) & 0xff) << 8) | ((__float2int_rn(ov[j].z * inv) & 0xff) << 16) | (__float2int_rn(ov[j].w * inv) << 24));
      }
    }
}
__device__ __forceinline__ int kmax(int a, int b) { int r; asm("v_max_f32 %0, %1, %2" : "=v"(r) : "v"(a), "v"(b)); return r; }
__device__ __forceinline__ int kmin(int a, int b) { int r; asm("v_min_f32 %0, %1, %2" : "=v"(r) : "v"(a), "v"(b)); return r; }
__device__ __forceinline__ void ced(int& a, int& b) { const int hi = kmax(a, b), lo = kmin(a, b); a = hi; b = lo; }
__device__ __forceinline__ void sort16_desc(int (&k)[16]) {
    ced(k[0], k[1]); ced(k[2], k[3]); ced(k[4], k[5]); ced(k[6], k[7]); ced(k[8], k[9]); ced(k[10], k[11]); ced(k[12], k[13]); ced(k[14], k[15]);
    ced(k[0], k[2]); ced(k[1], k[3]); ced(k[4], k[6]); ced(k[5], k[7]); ced(k[8], k[10]); ced(k[9], k[11]); ced(k[12], k[14]); ced(k[13], k[15]);
    ced(k[1], k[2]); ced(k[5], k[6]); ced(k[0], k[4]); ced(k[3], k[7]); ced(k[9], k[10]); ced(k[13], k[14]); ced(k[8], k[12]); ced(k[11], k[15]);
    ced(k[2], k[6]); ced(k[1], k[5]); ced(k[10], k[14]); ced(k[9], k[13]); ced(k[0], k[8]); ced(k[7], k[15]);
    ced(k[2], k[4]); ced(k[3], k[5]); ced(k[10], k[12]); ced(k[11], k[13]);
    ced(k[1], k[2]); ced(k[3], k[4]); ced(k[5], k[6]); ced(k[9], k[10]); ced(k[11], k[12]); ced(k[13], k[14]);
    ced(k[4], k[12]); ced(k[2], k[10]); ced(k[6], k[14]); ced(k[1], k[9]); ced(k[5], k[13]); ced(k[3], k[11]);
    ced(k[4], k[8]); ced(k[6], k[10]); ced(k[5], k[9]); ced(k[7], k[11]);
    ced(k[2], k[4]); ced(k[6], k[8]); ced(k[10], k[12]); ced(k[3], k[5]); ced(k[7], k[9]); ced(k[11], k[13]);
    ced(k[1], k[2]); ced(k[3], k[4]); ced(k[5], k[6]); ced(k[7], k[8]); ced(k[9], k[10]); ced(k[11], k[12]); ced(k[13], k[14]);
}
__device__ __forceinline__ void merge16_desc(int (&k)[16]) {
#pragma unroll
    for (int stride = 8; stride > 0; stride >>= 1)
#pragma unroll
        for (int i = 0; i < 16; ++i) { const int j = i ^ stride; if (j > i) ced(k[i], k[j]); }
}
__device__ __forceinline__ void top16_of(int (&a)[16], const int (&b)[16]) {
#pragma unroll
    for (int i = 0; i < 16; ++i) a[i] = kmax(a[i], b[15 - i]);
    merge16_desc(a);
}
__device__ __forceinline__ void top16_tile(const f32x16& acc, int kt, int hh, int (&top)[16]) {
    int g[16];
#pragma unroll
    for (int i = 0; i < 16; ++i) { const int idx = 32 * kt + (i & 3) + 8 * (i >> 2) + 4 * hh; g[i] = (__float_as_int(acc[i]) & ~127) | idx; }
    sort16_desc(g);
    if (kt == 0) {
#pragma unroll
        for (int i = 0; i < 16; ++i) top[i] = g[i];
    } else top16_of(top, g);
}
__device__ __forceinline__ void ph_route(const Ctx& c, const bf16* qry, const bf16* SK, unsigned* eidx, float* gate) {
    const int lane = c.lane, col = lane & 31, hh = lane >> 5;
    pg8::StaticOrder S; S.init(T_, 2048, c.G, (int)blockIdx.x); pg8::Unit u;
    for (int ui = 0; S.next(ui, u); ++ui) {
        const int h = u.pn, t0 = u.pm * 256 + 32 * c.wave;
        int top[2][16];
#pragma unroll
        for (int p = 0; p < 2; ++p) {
            bf16x8 bq[8];
            const bf16* qrow = qry + (size_t)(t0 + col) * 2048 + h * 256 + p * 128 + 8 * hh;
#pragma unroll
            for (int s = 0; s < 8; ++s) bq[s] = *(const bf16x8*)(qrow + 16 * s);
            const bf16* krow = SK + ((size_t)(h * 2 + p) * 128 + col) * 128 + 8 * hh;
#pragma unroll
            for (int kt = 0; kt < 4; ++kt) {
                f32x16 acc;
                const bf16* kr = krow + (size_t)kt * 32 * 128; asm volatile("" : "+v"(kr));
#pragma unroll
                for (int i = 0; i < 16; ++i) acc[i] = 0.f;
#pragma unroll
                for (int s = 0; s < 8; ++s) { const bf16x8 ka = *(const bf16x8*)(kr + 16 * s); acc = __builtin_amdgcn_mfma_f32_32x32x16_bf16(ka, bq[s], acc, 0, 0, 0); }
                top16_tile(acc, kt, hh, top[p]);
            }
            { int g[16];
#pragma unroll
              for (int i = 0; i < 16; ++i) g[i] = __shfl_xor(top[p][i], 32);
              top16_of(top[p], g); }
        }
        float f1[16], f2[16]; int i1[16], i2[16];
#pragma unroll
        for (int i = 0; i < 16; ++i) { f1[i] = __int_as_float(top[0][i]); i1[i] = (top[0][i] & 127) << 7; f2[i] = __int_as_float(top[1][i]); i2[i] = top[1][i] & 127; }
#define CK(a, b) ((__float_as_int(f1[a] + f2[b]) & ~0x3fff) | i1[a] | i2[b])
        int k0[16], k1[16], k2[16];
#pragma unroll
        for (int b = 0; b < 16; ++b) k0[b] = CK(0, b);
#pragma unroll
        for (int b = 0; b < 8; ++b) { k1[b] = CK(1, b); k1[8 + b] = CK(15 - b, 0); }
        merge16_desc(k1);
        k2[0] = CK(2, 0); k2[1] = CK(2, 1); k2[2] = CK(2, 2); k2[3] = CK(2, 3); k2[4] = CK(2, 4); k2[5] = CK(3, 0); k2[6] = CK(3, 1); k2[7] = CK(3, 2); k2[8] = CK(3, 3);
        k2[9] = CK(4, 0); k2[10] = CK(4, 1); k2[11] = CK(4, 2); k2[12] = CK(5, 0); k2[13] = CK(5, 1); k2[14] = CK(6, 0); k2[15] = CK(6, 1);
        sort16_desc(k2);
        k2[15] = kmax(k2[15], CK(7, 0)); k2[14] = kmax(k2[14], CK(7, 1));
        merge16_desc(k2);
        top16_of(k0, k1);
        top16_of(k0, k2);
#undef CK
        int p0[16];
#pragma unroll
        for (int i = 0; i < 16; ++i) { p0[i] = k0[i] & 0x3fff; k0[i] &= ~0x3fff; }
        float e[16]; float den = 0.f; const float m = __int_as_float(k0[0]);
#pragma unroll
        for (int i = 0; i < 16; ++i) { e[i] = __builtin_amdgcn_exp2f((__int_as_float(k0[i]) - m) * 1.4426950408889634f); den += e[i]; }
        const float inv = 1.f / den;
        float4 og[2];
        og[0].x = (hh ? e[8] : e[0]) * inv; og[0].y = (hh ? e[9] : e[1]) * inv; og[0].z = (hh ? e[10] : e[2]) * inv; og[0].w = (hh ? e[11] : e[3]) * inv;
        og[1].x = (hh ? e[12] : e[4]) * inv; og[1].y = (hh ? e[13] : e[5]) * inv; og[1].z = (hh ? e[14] : e[6]) * inv; og[1].w = (hh ? e[15] : e[7]) * inv;
        const size_t ob = (size_t)(t0 + col) * 128 + h * 16 + hh * 8;
        *(float4*)(gate + ob) = og[0]; *(float4*)(gate + ob + 4) = og[1];
        { uint4 o;
            o.x = (unsigned)(hh ? p0[4] : p0[0]) | ((unsigned)(hh ? p0[12] : p0[8]) << 16); o.y = (unsigned)(hh ? p0[5] : p0[1]) | ((unsigned)(hh ? p0[13] : p0[9]) << 16);
            o.z = (unsigned)(hh ? p0[6] : p0[2]) | ((unsigned)(hh ? p0[14] : p0[10]) << 16); o.w = (unsigned)(hh ? p0[7] : p0[3]) | ((unsigned)(hh ? p0[15] : p0[11]) << 16);
            *(uint4*)(eidx + ((size_t)(t0 + col) * 8 + h) * 8 + 4 * hh) = o; }
    }
}
typedef __bf16 v2bf __attribute__((ext_vector_type(2)));
__device__ __forceinline__ float dot2bf(unsigned a, unsigned b, float c) { return __builtin_amdgcn_fdot2_f32_bf16(__builtin_bit_cast(v2bf, a), __builtin_bit_cast(v2bf, b), c, false); }
template <int CTRL> __device__ __forceinline__ float dppf(float v) { return __int_as_float(__builtin_amdgcn_mov_dpp(__float_as_int(v), CTRL, 0xF, 0xF, true)); }
__device__ __forceinline__ float sum8(float v) { v += dppf<0xB1>(v); v += dppf<0x4E>(v); v += dppf<0x141>(v); return v; }
struct SliceMap { int j, sw, nsw; };
__device__ __forceinline__ SliceMap slice_map(const Ctx& c, unsigned* bar) {
    volatile LAS unsigned* st = (volatile LAS unsigned*)(c.ldsl + MISC_OFF);
    if (c.tid == 0) { unsigned even = (c.G % 8 == 0) ? 1u : 0u;
        for (unsigned j = 0; j < 16; ++j) { const unsigned cnt = xb_ld(&bar[XB_XCNT(j)]); if (cnt != (j < 8 ? (unsigned)c.G / 8u : 0u)) even = 0u; }
        st[4] = even; }
    __syncthreads();
    SliceMap m; m.nsw = c.G;
    if (st[4]) { m.j = (int)st[2]; m.sw = (int)st[3] * NWAVES + c.wave; }
    else { const bool sl = (c.G % 8) == 0; m.j = sl ? (int)(blockIdx.x & 7) : (c.gw & 7); m.sw = sl ? (int)(blockIdx.x >> 3) * NWAVES + c.wave : (c.gw >> 3); }
    m.j = __builtin_amdgcn_readfirstlane(m.j); m.sw = __builtin_amdgcn_readfirstlane(m.sw);
    __syncthreads();
    return m;
}
typedef float f32x2 __attribute__((ext_vector_type(2)));
template <int S> __device__ __forceinline__ unsigned bcast8(unsigned v, bool inq0) {
    const unsigned q = (unsigned)__builtin_amdgcn_mov_dpp((int)v, (S & 3) * 0x55, 0xF, 0xF, true);
    const unsigned r = (unsigned)__builtin_amdgcn_mov_dpp((int)q, 0x141, 0xF, 0xF, true);
    return ((S < 4) == inq0) ? q : r;
}
template <int HF> __device__ __forceinline__ void gather8(u32x4 (&w)[8], const unsigned char* wslice, unsigned moff, unsigned idw, bool inq0) {
#define G8ROW(R) { const unsigned b = bcast8<R>(idw, inq0); const unsigned id = HF ? (b >> 16) : (b & 0xffffu); w[R] = *(const u32x4*)(wslice + ((id << 7) + moff)); }
    G8ROW(0) G8ROW(1) G8ROW(2) G8ROW(3) G8ROW(4) G8ROW(5) G8ROW(6) G8ROW(7)
#undef G8ROW
}
template <int CTRL> __device__ __forceinline__ int dppi(int v) { return __builtin_amdgcn_mov_dpp(v, CTRL, 0xF, 0xF, true); }
__device__ __forceinline__ int g1_half(const u32x4 (&w)[8], const u32x4 xq, int m) {
    int d[8];
#pragma unroll
    for (int i = 0; i < 8; ++i) {
        int v = __builtin_amdgcn_sdot4((int)w[i].x, (int)xq.x, 0, false); v = __builtin_amdgcn_sdot4((int)w[i].y, (int)xq.y, v, false);
        v = __builtin_amdgcn_sdot4((int)w[i].z, (int)xq.z, v, false); d[i] = __builtin_amdgcn_sdot4((int)w[i].w, (int)xq.w, v, false);
    }
    const bool lo = m < 4, b1 = (m & 2) != 0, b0 = (m & 1) != 0;
    int e[4], f[2];
#pragma unroll
    for (int i = 0; i < 4; ++i) e[i] = (lo ? d[i] : d[i + 4]) + dppi<0x141>(lo ? d[i + 4] : d[i]);
#pragma unroll
    for (int i = 0; i < 2; ++i) f[i] = (b1 ? e[i + 2] : e[i]) + dppi<0x4E>(b1 ? e[i] : e[i + 2]);
    return (b0 ? f[1] : f[0]) + dppi<0xB1>(b0 ? f[0] : f[1]);
}
#define TOK(i) (t0 + (i) * ns)
#define IDX(t) (*(const unsigned*)((const unsigned char*)(eidx + (size_t)(t) * 64) + loff))
__device__ __forceinline__ void ph_g1(const Ctx& c, unsigned* bar, const unsigned char* xq, const float* sx, const unsigned char* Wd, const unsigned* eidx, bf16* apart) {
    const int lane = c.lane, g = lane >> 3, m = lane & 7; const bool inq0 = m < 4; const SliceMap sm = slice_map(c, bar);
    const int j = sm.j, ns = sm.nsw, t0 = sm.sw;
    const unsigned char* wsl = Wd + (size_t)j * (16384 * 128); const unsigned moff = 16u * m, loff = 4u * lane, soff = 2u * (16 * g + m);
    const unsigned char* xs = xq + 128 * j; bf16* as_ = apart + (size_t)j * T_ * 128;
#define XLD(t) (*(const u32x4*)(xs + (size_t)(t) * D_ + moff))
#define AST(t, o0, o1) do { const float sc_ = sx[t]; unsigned char* ap_ = (unsigned char*)(as_ + (size_t)(t) * 128) + soff; *(bf16*)ap_ = (bf16)f2bf((float)(o0) * sc_); *(bf16*)(ap_ + 16) = (bf16)f2bf((float)(o1) * sc_); } while (0)
    u32x4 W0[8], W1[8], W2[8], W3[8]; unsigned n1A = 0, n1B = 0, n2A = 0, n2B = 0; u32x4 xpA, xpB, xnA, xnB;
    if (TOK(0) < T_) { n2A = IDX(TOK(0)); xpA = XLD(TOK(0)); }
    if (TOK(1) < T_) { n2B = IDX(TOK(1)); xpB = XLD(TOK(1)); }
    if (TOK(0) < T_) { gather8<0>(W0, wsl, moff, n2A, inq0); gather8<1>(W1, wsl, moff, n2A, inq0); }
    if (TOK(1) < T_) { gather8<0>(W2, wsl, moff, n2B, inq0); gather8<1>(W3, wsl, moff, n2B, inq0); }
    if (TOK(2) < T_) n1A = IDX(TOK(2));
    if (TOK(3) < T_) n1B = IDX(TOK(3));
    const int NT = (T_ - t0 + ns - 1) / ns;
    int i = 0;
    for (; i + 5 < NT; i += 2) {
        const int tA = TOK(i), tB = TOK(i + 1), tA1 = TOK(i + 2), tB1 = TOK(i + 3), tA2 = TOK(i + 4), tB2 = TOK(i + 5);
        n2A = IDX(tA2); n2B = IDX(tB2); xnA = XLD(tA1); xnB = XLD(tB1);
        { const int o0 = g1_half(W0, xpA, m); gather8<0>(W0, wsl, moff, n1A, inq0);
          const int o1 = g1_half(W1, xpA, m); gather8<1>(W1, wsl, moff, n1A, inq0);
          AST(tA, o0, o1); }
        { const int o0 = g1_half(W2, xpB, m); gather8<0>(W2, wsl, moff, n1B, inq0);
          const int o1 = g1_half(W3, xpB, m); gather8<1>(W3, wsl, moff, n1B, inq0);
          AST(tB, o0, o1); }
        n1A = n2A; n1B = n2B; xpA = xnA; xpB = xnB;
    }
    for (; i < NT; i += 2) {
        const int tA = TOK(i), tB = TOK(i + 1), tA1 = TOK(i + 2), tB1 = TOK(i + 3), tA2 = TOK(i + 4), tB2 = TOK(i + 5);
        if (tA2 < T_) n2A = IDX(tA2);
        if (tB2 < T_) n2B = IDX(tB2);
        if (tA1 < T_) xnA = XLD(tA1);
        if (tB1 < T_) xnB = XLD(tB1);
        { const int o0 = g1_half(W0, xpA, m); if (tA1 < T_) gather8<0>(W0, wsl, moff, n1A, inq0);
          const int o1 = g1_half(W1, xpA, m); if (tA1 < T_) gather8<1>(W1, wsl, moff, n1A, inq0);
          AST(tA, o0, o1); }
        if (tB < T_) {
          const int o0 = g1_half(W2, xpB, m); if (tB1 < T_) gather8<0>(W2, wsl, moff, n1B, inq0);
          const int o1 = g1_half(W3, xpB, m); if (tB1 < T_) gather8<1>(W3, wsl, moff, n1B, inq0);
          AST(tB, o0, o1); }
        n1A = n2A; n1B = n2B; xpA = xnA; xpB = xnB;
    }
#undef XLD
#undef AST
}
__device__ __forceinline__ void ph_afin(const Ctx& c, const bf16* apart, const float* gate, const unsigned* eidx, const float* scd, const float* scu, unsigned char* aq, float* sa) {
    for (int it = blockIdx.x * NTHREADS + c.tid; it < T_ * 16; it += c.G * NTHREADS) {
        const int t = it >> 4, g = (it >> 1) & 7, m0 = (it & 1) * 4; const size_t k0 = (size_t)t * 128 + 16 * g + m0;
        float4 sl = {0.f, 0.f, 0.f, 0.f}, sh = {0.f, 0.f, 0.f, 0.f};
#pragma unroll
        for (int j = 0; j < 8; ++j) { const uint2 a0 = *(const uint2*)(apart + (size_t)j * T_ * 128 + k0), a1 = *(const uint2*)(apart + (size_t)j * T_ * 128 + k0 + 8);
            sl.x += __uint_as_float(a0.x << 16); sl.y += __uint_as_float(a0.x & 0xffff0000u); sl.z += __uint_as_float(a0.y << 16); sl.w += __uint_as_float(a0.y & 0xffff0000u);
            sh.x += __uint_as_float(a1.x << 16); sh.y += __uint_as_float(a1.x & 0xffff0000u); sh.z += __uint_as_float(a1.y << 16); sh.w += __uint_as_float(a1.y & 0xffff0000u); }
        const float4 gl = *(const float4*)(gate + k0), gh = *(const float4*)(gate + k0 + 8);
        const uint4 ep = *(const uint4*)(eidx + ((size_t)t * 8 + g) * 8 + m0);
        const unsigned ew[4] = {ep.x, ep.y, ep.z, ep.w}; const float lo[4] = {sl.x, sl.y, sl.z, sl.w}, hi[4] = {sh.x, sh.y, sh.z, sh.w}, gl4[4] = {gl.x, gl.y, gl.z, gl.w}, gh4[4] = {gh.x, gh.y, gh.z, gh.w};
        float al[4], ah[4]; float am = 0.f;
#pragma unroll
        for (int q = 0; q < 4; ++q) { const int e0 = ew[q] & 0xffff, e1 = ew[q] >> 16;
            const float u0 = lo[q] * scd[e0], u1 = hi[q] * scd[e1];
            al[q] = 0.5f * u0 * (1.f + erff(u0 * 0.7071067811865476f)) * gl4[q] * scu[e0]; ah[q] = 0.5f * u1 * (1.f + erff(u1 * 0.7071067811865476f)) * gh4[q] * scu[e1];
            am = fmaxf(am, fmaxf(fabsf(al[q]), fabsf(ah[q]))); }
        am = fmaxf(am, dppf<0xB1>(am)); am = fmaxf(am, dppf<0x4E>(am)); am = fmaxf(am, dppf<0x141>(am)); am = fmaxf(am, dppf<0x140>(am));
        am = fmaxf(am, 1e-30f); const float inv = 127.f / am;
        const unsigned pl = (unsigned)((__float2int_rn(al[0] * inv) & 0xff) | ((__float2int_rn(al[1] * inv) & 0xff) << 8) | ((__float2int_rn(al[2] * inv) & 0xff) << 16) | (__float2int_rn(al[3] * inv) << 24));
        const unsigned ph = (unsigned)((__float2int_rn(ah[0] * inv) & 0xff) | ((__float2int_rn(ah[1] * inv) & 0xff) << 8) | ((__float2int_rn(ah[2] * inv) & 0xff) << 16) | (__float2int_rn(ah[3] * inv) << 24));
        *(unsigned*)(aq + k0) = pl; *(unsigned*)(aq + k0 + 8) = ph;
        if ((it & 15) == 0) sa[t] = am * (1.f / 127.f);
    }
}
template <int R0> __device__ __forceinline__ void g2_set(int (&acc)[16], const u32x4 (&w)[8], unsigned ap) {
    const unsigned r0[4] = {w[R0].x, w[R0].y, w[R0].z, w[R0].w}, r1[4] = {w[R0 + 1].x, w[R0 + 1].y, w[R0 + 1].z, w[R0 + 1].w};
    const unsigned r2[4] = {w[R0 + 2].x, w[R0 + 2].y, w[R0 + 2].z, w[R0 + 2].w}, r3[4] = {w[R0 + 3].x, w[R0 + 3].y, w[R0 + 3].z, w[R0 + 3].w};
#pragma unroll
    for (int cq = 0; cq < 4; ++cq) {
        const unsigned t0 = __builtin_amdgcn_perm(r1[cq], r0[cq], 0x05010400u), t1 = __builtin_amdgcn_perm(r1[cq], r0[cq], 0x07030602u);
        const unsigned t2 = __builtin_amdgcn_perm(r3[cq], r2[cq], 0x05010400u), t3 = __builtin_amdgcn_perm(r3[cq], r2[cq], 0x07030602u);
        const unsigned o0 = __builtin_amdgcn_perm(t2, t0, 0x05040100u), o1 = __builtin_amdgcn_perm(t2, t0, 0x07060302u), o2 = __builtin_amdgcn_perm(t3, t1, 0x05040100u), o3 = __builtin_amdgcn_perm(t3, t1, 0x07060302u);
        acc[4 * cq + 0] = __builtin_amdgcn_sdot4((int)o0, (int)ap, acc[4 * cq + 0], false); acc[4 * cq + 1] = __builtin_amdgcn_sdot4((int)o1, (int)ap, acc[4 * cq + 1], false);
        acc[4 * cq + 2] = __builtin_amdgcn_sdot4((int)o2, (int)ap, acc[4 * cq + 2], false); acc[4 * cq + 3] = __builtin_amdgcn_sdot4((int)o3, (int)ap, acc[4 * cq + 3], false);
    }
}
template <int HF> __device__ __forceinline__ void g2_half(int (&acc)[16], const u32x4 (&w)[8], unsigned aw, bool inq0) {
    g2_set<0>(acc, w, bcast8<2 * HF>(aw, inq0)); g2_set<4>(acc, w, bcast8<2 * HF + 1>(aw, inq0));
}
__device__ __forceinline__ void g2_store(int (&acc)[16], int lane, float sa, bf16* fp) {
    int v8[8], v4[4];
#pragma unroll
    for (int i = 0; i < 8; ++i) { const auto r = __builtin_amdgcn_permlane32_swap((unsigned)acc[i], (unsigned)acc[i + 8], false, false); v8[i] = (int)r[0] + (int)r[1]; }
#pragma unroll
    for (int i = 0; i < 4; ++i) { const auto r = __builtin_amdgcn_permlane16_swap((unsigned)v8[i], (unsigned)v8[i + 4], false, false); v4[i] = (int)r[0] + (int)r[1]; }
    const bool up = (lane & 8) != 0;
    const int k0 = up ? v4[2] : v4[0], k1 = up ? v4[3] : v4[1], s0 = up ? v4[0] : v4[2], s1 = up ? v4[1] : v4[3];
    const int f0 = k0 + dppi<0x128>(s0), f1 = k1 + dppi<0x128>(s1);
    const int feat = ((lane >> 5) & 1) * 8 + ((lane >> 4) & 1) * 4 + ((lane >> 3) & 1) * 2;
    *(unsigned*)(fp + feat) = cvtpk((float)f0 * sa, (float)f1 * sa);
}
__device__ __forceinline__ void ph_g2(const Ctx& c, unsigned* bar, const unsigned char* Wu, const unsigned* eidx, const unsigned char* aq, const float* sa, bf16* ffn) {
    const int lane = c.lane, g = lane >> 3, m = lane & 7; const bool inq0 = m < 4; const SliceMap sm = slice_map(c, bar);
    const int j = sm.j, ns = sm.nsw, t0 = sm.sw;
    const unsigned char* wsl = Wu + (size_t)j * (16384 * 128); const unsigned moff = 16u * m, loff = 4u * lane, aoff = 16u * g + 4u * (m & 3), foff = 32u * m;
    bf16* fs = ffn + 128 * j;
#define ALD(t) (*(const unsigned*)(aq + (size_t)(t) * 128 + aoff))
#define FST(t, acc) g2_store(acc, lane, sa[t], (bf16*)((unsigned char*)(fs + (size_t)(t) * D_) + foff))
    u32x4 W0[8], W1[8], W2[8], W3[8]; unsigned n1A = 0, n1B = 0, n2A = 0, n2B = 0, apA = 0, apB = 0, anA = 0, anB = 0;
    if (TOK(0) < T_) { n2A = IDX(TOK(0)); apA = ALD(TOK(0)); }
    if (TOK(1) < T_) { n2B = IDX(TOK(1)); apB = ALD(TOK(1)); }
    if (TOK(0) < T_) { gather8<0>(W0, wsl, moff, n2A, inq0); gather8<1>(W1, wsl, moff, n2A, inq0); }
    if (TOK(1) < T_) { gather8<0>(W2, wsl, moff, n2B, inq0); gather8<1>(W3, wsl, moff, n2B, inq0); }
    if (TOK(2) < T_) n1A = IDX(TOK(2));
    if (TOK(3) < T_) n1B = IDX(TOK(3));
    const int NT = (T_ - t0 + ns - 1) / ns;
    int i = 0;
    for (; i + 5 < NT; i += 2) {
        const int tA = TOK(i), tB = TOK(i + 1), tA1 = TOK(i + 2), tB1 = TOK(i + 3), tA2 = TOK(i + 4), tB2 = TOK(i + 5);
        n2A = IDX(tA2); n2B = IDX(tB2); anA = ALD(tA1); anB = ALD(tB1);
        { int acc[16];
#pragma unroll
          for (int r = 0; r < 16; ++r) acc[r] = 0;
          g2_half<0>(acc, W0, apA, inq0); gather8<0>(W0, wsl, moff, n1A, inq0);
          g2_half<1>(acc, W1, apA, inq0); gather8<1>(W1, wsl, moff, n1A, inq0);
          FST(tA, acc); }
        { int acc[16];
#pragma unroll
          for (int r = 0; r < 16; ++r) acc[r] = 0;
          g2_half<0>(acc, W2, apB, inq0); gather8<0>(W2, wsl, moff, n1B, inq0);
          g2_half<1>(acc, W3, apB, inq0); gather8<1>(W3, wsl, moff, n1B, inq0);
          FST(tB, acc); }
        n1A = n2A; n1B = n2B; apA = anA; apB = anB;
    }
    for (; i < NT; i += 2) {
        const int tA = TOK(i), tB = TOK(i + 1), tA1 = TOK(i + 2), tB1 = TOK(i + 3), tA2 = TOK(i + 4), tB2 = TOK(i + 5);
        if (tA2 < T_) n2A = IDX(tA2);
        if (tB2 < T_) n2B = IDX(tB2);
        if (tA1 < T_) anA = ALD(tA1);
        if (tB1 < T_) anB = ALD(tB1);
        { int acc[16];
#pragma unroll
          for (int r = 0; r < 16; ++r) acc[r] = 0;
          g2_half<0>(acc, W0, apA, inq0); if (tA1 < T_) gather8<0>(W0, wsl, moff, n1A, inq0);
          g2_half<1>(acc, W1, apA, inq0); if (tA1 < T_) gather8<1>(W1, wsl, moff, n1A, inq0);
          FST(tA, acc); }
        if (tB < T_) { int acc[16];
#pragma unroll
          for (int r = 0; r < 16; ++r) acc[r] = 0;
          g2_half<0>(acc, W2, apB, inq0); if (tB1 < T_) gather8<0>(W2, wsl, moff, n1B, inq0);
          g2_half<1>(acc, W3, apB, inq0); if (tB1 < T_) gather8<1>(W3, wsl, moff, n1B, inq0);
          FST(tB, acc); }
        n1A = n2A; n1B = n2B; apA = anA; apB = anB;
    }
#undef ALD
#undef FST
}
#undef IDX
#undef TOK
__device__ __forceinline__ void ph_ln2(const Ctx& c, const bf16* hb  , const float2* st1, const float* g1, const float* b1, const bf16* ffn, float* out, const float* g, const float* bb) {
    constexpr int RB = 4;
    for (int row0 = c.gw * RB; row0 < T_; row0 += c.NGW * RB) {
        uint2 hv[RB][4], fv[RB][4];
#pragma unroll
        for (int r = 0; r < RB; ++r) { const uint2* hp = (const uint2*)(hb + (size_t)(row0 + r) * D_) + c.lane; const uint2* fp = (const uint2*)(ffn + (size_t)(row0 + r) * D_) + c.lane;
#pragma unroll
            for (int j = 0; j < 4; ++j) { hv[r][j] = hp[64 * j]; fv[r][j] = fp[64 * j]; } }
        float4 g1v[4], b1v[4];
#pragma unroll
        for (int j = 0; j < 4; ++j) { const int cc = (64 * j + c.lane) * 4; g1v[j] = *(const float4*)(g1 + cc); b1v[j] = *(const float4*)(b1 + cc);
            g1v[j].x *= ALPHA; g1v[j].y *= ALPHA; g1v[j].z *= ALPHA; g1v[j].w *= ALPHA; b1v[j].x *= ALPHA; b1v[j].y *= ALPHA; b1v[j].z *= ALPHA; b1v[j].w *= ALPHA; }
#pragma unroll
        for (int r = 0; r < RB; ++r) {
            float4 v[4]; float s = 0.f; const float2 ms = st1[row0 + r];
#pragma unroll
            for (int j = 0; j < 4; ++j) { const uint2 h = hv[r][j], f = fv[r][j];
                v[j].x = (__uint_as_float(h.x << 16) - ms.x) * ms.y * g1v[j].x + b1v[j].x + __uint_as_float(f.x << 16); v[j].y = (__uint_as_float(h.x & 0xffff0000u) - ms.x) * ms.y * g1v[j].y + b1v[j].y + __uint_as_float(f.x & 0xffff0000u);
                v[j].z = (__uint_as_float(h.y << 16) - ms.x) * ms.y * g1v[j].z + b1v[j].z + __uint_as_float(f.y << 16); v[j].w = (__uint_as_float(h.y & 0xffff0000u) - ms.x) * ms.y * g1v[j].w + b1v[j].w + __uint_as_float(f.y & 0xffff0000u);
                s += v[j].x + v[j].y + v[j].z + v[j].w; }
            const float mu = wave_sum(s) * (1.f / D_); float q = 0.f;
#pragma unroll
            for (int j = 0; j < 4; ++j) { v[j].x -= mu; v[j].y -= mu; v[j].z -= mu; v[j].w -= mu; q += v[j].x * v[j].x + v[j].y * v[j].y + v[j].z * v[j].z + v[j].w * v[j].w; }
            const float rstd = 1.f / sqrtf(wave_sum(q) * (1.f / D_) + LN_EPS);
            float4* op = (float4*)(out + (size_t)(row0 + r) * D_) + c.lane;
#pragma unroll
            for (int j = 0; j < 4; ++j) { const int cc = (64 * j + c.lane) * 4; const float4 gg = *(const float4*)(g + cc), b4 = *(const float4*)(bb + cc);
                float4 o; o.x = v[j].x * rstd * gg.x + b4.x; o.y = v[j].y * rstd * gg.y + b4.y; o.z = v[j].z * rstd * gg.z + b4.z; o.w = v[j].w * rstd * gg.w + b4.w;
                __builtin_nontemporal_store(o.x, &op[64 * j].x); __builtin_nontemporal_store(o.y, &op[64 * j].y); __builtin_nontemporal_store(o.z, &op[64 * j].z); __builtin_nontemporal_store(o.w, &op[64 * j].w); }
        }
    }
}
constexpr int NPH = 12;
__global__ void __launch_bounds__(NTHREADS, 2) mega(Args a) {
    extern __shared__ __attribute__((aligned(16))) unsigned char lds[];
    Ctx c; c.tid = threadIdx.x; c.lane = c.tid & 63; c.wave = __builtin_amdgcn_readfirstlane(c.tid >> 6); c.G = gridDim.x; c.gw = blockIdx.x * NWAVES + c.wave; c.NGW = c.G * NWAVES; c.lds = lds; c.ldsl = (LAS unsigned char*)lds;
    { const int bx = blockIdx.x; const int vcu = (c.G % 8 == 0) ? (bx % 8) * (c.G / 8) + bx / 8 : bx; c.gwx = vcu * NWAVES + c.wave; }
    unsigned char* ws = a.ws;
#define WoutT ((bf16*)(ws + WS_WOUT))
#define ipre ((float*)(ws + WS_GATE))
#define logf ((float*)(ws + WS_GATE) + (size_t)T_ * 4)
#define proj ((bf16*)(ws + WS_PROJ))
#define qry ((bf16*)(ws + WS_QRY))
#define mq ((bf16*)(ws + WS_MQ))
#define mk ((bf16*)(ws + WS_MK))
#define concat ((bf16*)(ws + WS_CONCAT))
#define xb ((bf16*)(ws + WS_XB))
    const int lo = a.ph_lo, hi = a.ph_hi;
#define IN(k) (lo <= (k) && (k) < hi)
    if (c.tid < 8) ((LAS unsigned*)(c.ldsl + MISC_OFF))[c.tid] = 0u;
    __syncthreads();
    XcdBarrier xbar; xbar.bar = (unsigned*)(ws + WS_BAR); xbar.x = xb_xcc_id(); xbar.st = (volatile LAS unsigned*)(c.ldsl + MISC_OFF);
    if (c.tid == 0) { const unsigned rank = xb_add(&xbar.bar[XB_XCNT(xbar.x)], 1u); xbar.st[2] = xbar.x; xbar.st[3] = rank; }
#define SEAM(k) do { if (IN(k) && IN((k) + 1)) xcd_barrier(xbar); } while (0)
#ifndef REP_PHASE
#define REP_PHASE -1
#endif
#define PH(id, ...) do { __VA_ARGS__; if (REP_PHASE == (id)) { xcd_barrier(xbar); __VA_ARGS__; } } while (0)
    if (IN(0)) { PH(0, { ph_prologue(c, a); }); } SEAM(0);
    if (IN(1)) { PH(1, { pg8::Gemm g{(const pg8::bf16_t*)(ws + WS_XB), (const pg8::bf16_t*)(ws + WS_WIN), T_, NPROJ, D_ / 2}; pg8::StaticOrder S; S.init(T_, NPROJ, c.G, (int)blockIdx.x);
        pg8::EpiI8Bf16 E{proj, NPROJ, (const float*)(ws + WS_SXA), (const float*)(ws + WS_SWN)};
        pg8::gemm_phase<pg8::EpiI8Bf16, pg8::StaticOrder, true, true>((PG8_LAS unsigned char*)lds, g, S, E); }); } SEAM(1);
    if (IN(2)) { unsigned* mflag = (unsigned*)(ws + WS_MFLAG);
        if (blockIdx.x < 64) ph_mseq(c, a, proj, ipre, logf, mq, mk, mflag, xbar.bar, concat, (int)blockIdx.x);
        else ph_mprod(c, a, proj, mq, mk, mflag, (int)blockIdx.x - 64, c.G - 64);
        __syncthreads();
        ph_attn(c, proj, ws, (unsigned char*)a.out, (unsigned*)(ws + WS_AQ)); } SEAM(2);
    if (IN(3)) { PH(30, { ph_attn_merge(c, ws, (const unsigned char*)a.out, concat); }); } SEAM(3);
    if (IN(4)) { PH(4, { pg8::Gemm g{concat, WoutT, T_, D_, D_}; pg8::StaticOrder S; S.init(T_, D_, c.G, (int)blockIdx.x);
        pg8::EpiResBf16 E{a.in[0], (bf16*)(ws + WS_Y1), ALPHA};
        pg8::gemm_phase<pg8::EpiResBf16, pg8::StaticOrder, true, true>((PG8_LAS unsigned char*)lds, g, S, E); }); } SEAM(4);
    if (IN(5)) { PH(5, { ph_ln1(c, (const bf16*)(ws + WS_Y1), a.in[10], a.in[11], (float2*)(ws + WS_ST1), (unsigned*)(ws + WS_XQ), (float*)(ws + WS_SX)); }); } SEAM(5);
    if (IN(6)) { PH(6, { pg8::Gemm g{(const pg8::bf16_t*)(ws + WS_XQ), (const pg8::bf16_t*)(ws + WS_WQ), T_, 2048, D_ / 2}; pg8::StaticOrder S; S.init(T_, 2048, c.G, (int)blockIdx.x);
        pg8::EpiI8Bf16 E{qry, 2048, (const float*)(ws + WS_SX), (const float*)(ws + WS_SWQ)};
        pg8::gemm_phase<pg8::EpiI8Bf16, pg8::StaticOrder, true, true>((PG8_LAS unsigned char*)lds, g, S, E);
        asm volatile("s_waitcnt vmcnt(0)" ::: "memory"); __syncthreads();
        ph_route(c, qry, (const bf16*)(ws + WS_SK), (unsigned*)(ws + WS_EIDX), (float*)(ws + WS_GATEV)); }); } SEAM(6);
    if (IN(8)) { PH(8, { ph_g1(c, xbar.bar, (const unsigned char*)(ws + WS_XQ), (const float*)(ws + WS_SX), (const unsigned char*)(ws + WS_WD), (const unsigned*)(ws + WS_EIDX), (bf16*)(ws + WS_APART)); }); } SEAM(8);
    if (IN(9)) { PH(9, { ph_afin(c, (const bf16*)(ws + WS_APART), (const float*)(ws + WS_GATEV), (const unsigned*)(ws + WS_EIDX), (const float*)(ws + WS_SCD), (const float*)(ws + WS_SCU), (unsigned char*)(ws + WS_AFIN), (float*)(ws + WS_SA)); }); } SEAM(9);
    if (IN(10)) { PH(10, { ph_g2(c, xbar.bar, (const unsigned char*)(ws + WS_WU), (const unsigned*)(ws + WS_EIDX), (const unsigned char*)(ws + WS_AFIN), (const float*)(ws + WS_SA), (bf16*)(ws + WS_FFN)); }); } SEAM(10);
    if (IN(11)) { PH(11, { ph_ln2(c, (const bf16*)(ws + WS_Y1), (const float2*)(ws + WS_ST1), a.in[10], a.in[11], (const bf16*)(ws + WS_FFN), a.out, a.in[16], a.in[17]); }); }
#undef PH
#undef WoutT
#undef ipre
#undef logf
#undef proj
#undef qry
#undef mq
#undef mk
#undef concat
#undef xb
#undef IN
#undef SEAM
}

#ifndef MK_PER_PHASE
#define MK_PER_PHASE 0
#endif
extern "C" void kernel_launch(void* const* d_in, const int* in_sizes, int n_in, void* d_out, int out_size, void* d_ws, size_t ws_size, hipStream_t stream) {
    static int grid = 0;
    if (grid == 0) {
        if (n_in != 18 || out_size != T_ * D_ || ws_size < WS_END) { fprintf(stderr, "kernel_launch: unexpected sizes n_in %d out %d ws %zu\n", n_in, out_size, ws_size); grid = -1; return; }
        int dev = 0, cus = 0, per_cu = 0;
        if (hipGetDevice(&dev) != hipSuccess || hipDeviceGetAttribute(&cus, hipDeviceAttributeMultiprocessorCount, dev) != hipSuccess) { fprintf(stderr, "kernel_launch: device query failed\n"); grid = -1; return; }
        if (hipFuncSetAttribute((const void*)mega, hipFuncAttributeMaxDynamicSharedMemorySize, LDS_BYTES) != hipSuccess) { fprintf(stderr, "kernel_launch: hipFuncSetAttribute failed\n"); grid = -1; return; }
        if (hipOccupancyMaxActiveBlocksPerMultiprocessor(&per_cu, (const void*)mega, NTHREADS, LDS_BYTES) != hipSuccess || per_cu < 1) { fprintf(stderr, "kernel_launch: occupancy query failed (%d)\n", per_cu); (void)hipGetLastError(); grid = -1; return; }
        grid = cus * per_cu;
        if (grid < 128) { fprintf(stderr, "kernel_launch: grid %d too small for the 64 sequential mLSTM workgroups + producers\n", grid); grid = -1; return; }
        fprintf(stderr, "kernel_launch: %d CUs x %d workgroups = grid %d\n", cus, per_cu, grid);
    }
    if (grid < 0) return;
    if (hipMemsetAsync((char*)d_ws + WS_BAR, 0, 49152, stream) != hipSuccess) { fprintf(stderr, "kernel_launch: memset of the barrier words failed\n"); return; }
    Args a{};
    for (int i = 0; i < 18; ++i) a.in[i] = (const float*)d_in[i];
    a.out = (float*)d_out; a.ws = (unsigned char*)d_ws;
#if MK_PER_PHASE
    for (int p = 0; p < NPH; ++p) { a.ph_lo = p; a.ph_hi = p + 1; hipLaunchKernelGGL(mega, dim3(grid), dim3(NTHREADS), LDS_BYTES, stream, a); }
#else
    a.ph_lo = 0; a.ph_hi = NPH;
    void* params[] = {&a};
    const hipError_t e = hipLaunchCooperativeKernel((const void*)mega, dim3(grid), dim3(NTHREADS), params, LDS_BYTES, stream);
    if (e != hipSuccess) fprintf(stderr, "kernel_launch: cooperative launch failed: %s (grid %d)\n", hipGetErrorString(e), grid);
#endif
}
```
